# Optimizing an MI355X kernel written in HIP

```python
import jax, jax.numpy as jnp
from jax import lax
import numpy as np

D_MODEL = 1024
BATCH = 8
SEQ = 4096
DEPTH = 2

GRID_W = 64
CTX_LEN = 256
N_BRANCH = 4
BR_W = D_MODEL // 4
HEAD_DIM = 64
N_HEADS = BR_W // HEAD_DIM
CHUNK = 128
NA_ROWS = 8
NA_COLS = 16
LORA_W = 64
LORA_A = 64
RW_IN = 3 * BR_W + LORA_W + LORA_A
POOL_WINDOWS = (2, 4, 8, 16)
EPS = 1e-6
GN_EPS = 64e-5
IN_COLS = 10 * BR_W + RW_IN + N_BRANCH * D_MODEL
SEGMENTS = (("gm_u", BR_W), ("gm_v", BR_W), ("gm_g", BR_W),
            ("na_q", BR_W), ("na_k", BR_W), ("na_v", BR_W), ("na_g", BR_W),
            ("rw_in", RW_IN), ("rw_g", BR_W),
            ("pl_p", BR_W), ("pl_g", BR_W),
            ("merge", N_BRANCH * D_MODEL))

kernel_name = "hybrid_gmlp_natten_rwkv7_pool_dit"


def rmsnorm(x, g):
    xf = x.astype(jnp.float32)
    y = xf * lax.rsqrt(jnp.mean(xf * xf, axis=-1, keepdims=True) + EPS)
    return (y * g).astype(x.dtype)


def to_heads(t):
    return t.reshape(t.shape[:-1] + (N_HEADS, HEAD_DIM))


def split_cols(z):
    out = {}
    off = 0
    for name, width in SEGMENTS:
        out[name] = z[..., off:off + width]
        off += width
    return out


def gmlp_mix(u, v, ln_g, ln_b, w_s, b_s):
    B, T, _ = u.shape
    u = jax.nn.gelu(u)
    vh = to_heads(jax.nn.gelu(v)).astype(jnp.float32)
    mu = jnp.mean(vh, axis=-1, keepdims=True)
    var = jnp.mean(jnp.square(vh - mu), axis=-1, keepdims=True)
    vh = ((vh - mu) * lax.rsqrt(var + EPS) * ln_g + ln_b).astype(u.dtype)
    vc = vh.reshape(B, T // CHUNK, CHUNK, N_HEADS, HEAD_DIM)
    mixed = jnp.einsum('gpq,bnqgc->bnpgc', w_s, vc) + b_s.T[None, None, :, :, None]
    return u * mixed.reshape(B, T, BR_W)


def natten_latent(q, k, v, k_ctx, v_ctx, rpb):
    B, T, H, Dh = q.shape
    rows = T // GRID_W
    kr = min(NA_ROWS, rows)
    r_idx = jnp.arange(rows)
    c_idx = jnp.arange(GRID_W)
    r_start = jnp.clip(r_idx - kr // 2, 0, rows - kr)
    c_start = jnp.clip(c_idx - NA_COLS // 2, 0, GRID_W - NA_COLS)
    band_rows = r_start[:, None] + jnp.arange(kr)[None, :]
    qg = q.reshape(B, rows, GRID_W, H, Dh)
    kg = k.reshape(B, rows, GRID_W, H, Dh)[:, band_rows]
    vg = v.reshape(B, rows, GRID_W, H, Dh)[:, band_rows]
    scale = Dh ** -0.5
    s_band = jnp.einsum('brqhd,brikhd->bhrqik', qg, kg).astype(jnp.float32) * scale
    col_ok = (c_idx[None, :] >= c_start[:, None]) & (c_idx[None, :] < c_start[:, None] + NA_COLS)
    dr = band_rows - r_idx[:, None]
    dc = jnp.clip(c_idx[None, :] - c_idx[:, None], -(NA_COLS - 1), NA_COLS - 1)
    bias = rpb[:, dr[:, None, :, None] + (NA_ROWS - 1), dc[None, :, None, :] + (NA_COLS - 1)]
    s_band = jnp.where(col_ok[None, None, None, :, None, :], s_band + bias[None].astype(jnp.float32), -jnp.inf)
    s_ctx = jnp.einsum('brqhd,blhd->bhrql', qg, k_ctx).astype(jnp.float32) * scale
    s_all = jnp.concatenate([s_band.reshape(B, H, rows, GRID_W, kr * GRID_W), s_ctx], axis=-1)
    p = jax.nn.softmax(s_all, axis=-1).astype(v.dtype)
    p_band = p[..., :kr * GRID_W].reshape(B, H, rows, GRID_W, kr, GRID_W)
    p_ctx = p[..., kr * GRID_W:]
    o = jnp.einsum('bhrqik,brikhd->brqhd', p_band, vg) + jnp.einsum('bhrql,blhd->brqhd', p_ctx, v_ctx)
    return o.reshape(B, T, H * Dh)


def ctx_attention(q, k, v):
    B, L, H, Dh = q.shape
    s = jnp.einsum('blhd,bmhd->bhlm', q, k).astype(jnp.float32) * (Dh ** -0.5)
    p = jax.nn.softmax(s, axis=-1).astype(v.dtype)
    return jnp.einsum('bhlm,bmhd->blhd', p, v).reshape(B, L, H * Dh)


def centred_shift_mix(z, mu):
    prev = jnp.pad(z[:, :-1], ((0, 0), (1, 0), (0, 0)))
    nxt = jnp.pad(z[:, 1:], ((0, 0), (0, 1), (0, 0)))
    return z + (0.5 * (prev + nxt) - z) * mu


def wkv7_scan(r, w, k, v, a, b, s0, reverse):
    def step(S, inp):
        r_t, w_t, k_t, v_t, a_t, b_t = inp
        sa = jnp.einsum('bhvk,bhk->bhv', S, a_t)
        S = S * w_t[:, :, None, :] + sa[..., :, None] * b_t[..., None, :] + v_t[..., :, None] * k_t[..., None, :]
        return S, jnp.einsum('bhvk,bhk->bhv', S, r_t)
    xs = tuple(jnp.moveaxis(t, 1, 0) for t in (r, w, k, v, a, b))
    s_fin, ys = lax.scan(step, s0, xs, reverse=reverse)
    return jnp.moveaxis(ys, 0, 1), s_fin


def rwkv_branch(z_in, s0_f, s0_b, lp):
    dt = z_in.dtype
    B, T, _ = z_in.shape
    zf = centred_shift_mix(z_in, lp['rw_mu']).astype(jnp.float32)
    r, k, v, w_lo, a_lo = jnp.split(zf, [BR_W, 2 * BR_W, 3 * BR_W, 3 * BR_W + LORA_W], axis=-1)
    kk = to_heads(k * lp['rw_kk'])
    kk = kk / jnp.maximum(jnp.sqrt(jnp.sum(kk * kk, axis=-1, keepdims=True)), 1e-12)
    rh, vh, kh = to_heads(r), to_heads(v), to_heads(k)
    r_k = lp['rw_rk'].astype(jnp.float32)
    k_a = to_heads(lp['rw_ka'])
    s0 = (s0_f, s0_b)
    ys, finals, bonus = [], [], []
    for d in range(2):
        w = -jax.nn.softplus(-(lp['rw_w0'][d] + jnp.tanh(w_lo) @ lp['rw_w2'][d])) - 0.5
        decay = to_heads(jnp.exp(-jnp.exp(w)))
        a = to_heads(jax.nn.sigmoid(lp['rw_a0'][d] + a_lo @ lp['rw_a2'][d]))
        kd = kh * (1.0 + (a - 1.0) * k_a)
        y, s_fin = wkv7_scan(rh, decay, kd, vh, -kk, kk * a, s0[d], reverse=(d == 1))
        ys.append(y)
        finals.append(s_fin)
        bonus.append(jnp.sum(rh * kd * r_k, axis=-1, keepdims=True) * vh)
    o = ys[0] + ys[1]
    mu = jnp.mean(o, axis=-1, keepdims=True)
    var = jnp.mean(jnp.square(o - mu), axis=-1, keepdims=True)
    o = (o - mu) * lax.rsqrt(var + GN_EPS) * to_heads(lp['rw_gn_g']) + to_heads(lp['rw_gn_b'])
    o = (o + bonus[0] + bonus[1]).reshape(B, T, BR_W).astype(dt)
    return o, finals[0], finals[1]


def centred_mean(x, w):
    B, T, C = x.shape
    cs = jnp.pad(jnp.cumsum(x.astype(jnp.float32), axis=1), ((0, 0), (1, 0), (0, 0)))
    t = jnp.arange(T)
    lo = jnp.clip(t - w // 2, 0, T)
    hi = jnp.clip(t + w - w // 2, 0, T)
    cnt = (hi - lo).astype(jnp.float32)
    return (cs[:, hi] - cs[:, lo]) / cnt[None, :, None]


def pool_mix(p, w_grp, scale):
    B, T, _ = p.shape
    groups = jnp.split(p, len(POOL_WINDOWS), axis=-1)
    d = jnp.stack([centred_mean(g, w) - g.astype(jnp.float32) for g, w in zip(groups, POOL_WINDOWS)], axis=2)
    y = jnp.einsum('btgc,gcd->btgd', d.astype(p.dtype), w_grp).reshape(B, T, BR_W)
    return y * scale


def merge_branches(branches, merge_logits, w_br, w_out):
    gates = jax.nn.sigmoid(merge_logits.astype(jnp.float32)).astype(merge_logits.dtype)
    y = gates[..., :D_MODEL] * (branches[0] @ w_br[0])
    for i in range(1, N_BRANCH):
        y = y + gates[..., i * D_MODEL:(i + 1) * D_MODEL] * (branches[i] @ w_br[i])
    return y @ w_out


def branch_outputs_local(zs, lp):
    gm = gmlp_mix(zs['gm_u'], zs['gm_v'], lp['gm_ln_g'], lp['gm_ln_b'], lp['gm_ws'], lp['gm_bs']) * jax.nn.silu(zs['gm_g'])
    pl = pool_mix(zs['pl_p'], lp['pl_w'], lp['pl_scale']) * jax.nn.silu(zs['pl_g'])
    return gm, pl


def hybrid_layer(x, ctx, c, c_ctx, lp, update_ctx):
    B = x.shape[0]
    mod = jax.nn.silu(c) @ lp['ada_w'] + lp['ada_b']
    shift, scale, gate = jnp.split(mod[:, None, :], 3, axis=-1)
    mod_c = jax.nn.silu(c_ctx) @ lp['ada_w'] + lp['ada_b']
    shift_c, scale_c, gate_c = jnp.split(mod_c, 3, axis=-1)
    h = rmsnorm(x, lp['norm_g']) * (1 + scale) + shift
    hc = rmsnorm(ctx, lp['norm_g']) * (1 + scale_c) + shift_c
    zs = split_cols(h @ lp['w_in'])
    zc = split_cols(hc @ lp['w_in'])

    k_na_c, v_na_c = to_heads(zc['na_k']), to_heads(zc['na_v'])
    s0 = jnp.zeros((B, N_HEADS, HEAD_DIM, HEAD_DIM), jnp.float32)
    rw_c, s_f, s_b = rwkv_branch(zc['rw_in'], s0, s0, lp)

    gm, pl = branch_outputs_local(zs, lp)
    na = natten_latent(to_heads(zs['na_q']), to_heads(zs['na_k']), to_heads(zs['na_v']),
                       k_na_c, v_na_c, lp['na_rpb']) * jax.nn.silu(zs['na_g'])
    rw = rwkv_branch(zs['rw_in'], s_f, s_b, lp)[0] * jax.nn.silu(zs['rw_g'])
    x = x + gate * merge_branches([gm, na, rw, pl], zs['merge'], lp['w_br'], lp['w_out'])

    if update_ctx:
        gm_c, pl_c = branch_outputs_local(zc, lp)
        na_c = ctx_attention(to_heads(zc['na_q']), k_na_c, v_na_c) * jax.nn.silu(zc['na_g'])
        rw_cg = rw_c * jax.nn.silu(zc['rw_g'])
        ctx = ctx + gate_c * merge_branches([gm_c, na_c, rw_cg, pl_c], zc['merge'], lp['w_br'], lp['w_out'])
    return x, ctx


def setup_inputs(seed: int = 0) -> dict:
    key = jax.random.key(seed)
    ks = jax.random.split(key, 32)
    f32 = jnp.float32

    def nrm(k, shape, s):
        return jax.random.normal(k, shape, f32) * s

    L, D, H, N = DEPTH, D_MODEL, N_HEADS, HEAD_DIM
    return {
        "x": nrm(ks[0], (BATCH, SEQ, D), 1.0),
        "c": nrm(ks[1], (BATCH, D), 1.0),
        "ctx": nrm(ks[2], (BATCH, CTX_LEN, D), 1.0),
        "c_ctx": nrm(ks[3], (D,), 1.0),
        "ada_w": nrm(ks[4], (L, D, 3 * D), 0.5 * D ** -0.5),
        "ada_b": nrm(ks[5], (L, 3 * D), 0.02),
        "norm_g": 1.0 + nrm(ks[6], (L, D), 0.05),
        "w_in": nrm(ks[7], (L, D, IN_COLS), D ** -0.5),
        "gm_ln_g": 1.0 + nrm(ks[8], (L, H, N), 0.05),
        "gm_ln_b": nrm(ks[9], (L, H, N), 0.02),
        "gm_ws": nrm(ks[10], (L, H, CHUNK, CHUNK), CHUNK ** -0.5),
        "gm_bs": 1.0 + nrm(ks[11], (L, H, CHUNK), 0.05),
        "na_rpb": nrm(ks[12], (L, H, 2 * NA_ROWS - 1, 2 * NA_COLS - 1), 0.1),
        "rw_mu": jax.random.uniform(ks[13], (L, RW_IN), f32, 0.0, 1.0),
        "rw_w0": jax.random.uniform(ks[14], (L, 2, BR_W), f32, -6.0, -1.0),
        "rw_w2": nrm(ks[15], (L, 2, LORA_W, BR_W), 0.1),
        "rw_a0": nrm(ks[16], (L, 2, BR_W), 0.1),
        "rw_a2": nrm(ks[17], (L, 2, LORA_A, BR_W), 0.1),
        "rw_kk": 0.85 + nrm(ks[18], (L, BR_W), 0.05),
        "rw_ka": 1.0 + nrm(ks[19], (L, BR_W), 0.05),
        "rw_rk": nrm(ks[20], (L, H, N), 0.1),
        "rw_gn_g": 1.0 + nrm(ks[21], (L, BR_W), 0.05),
        "rw_gn_b": nrm(ks[22], (L, BR_W), 0.02),
        "pl_w": nrm(ks[23], (L, H, N, N), N ** -0.5),
        "pl_scale": 1.0 + nrm(ks[24], (L, BR_W), 0.1),
        "w_br": nrm(ks[25], (L, N_BRANCH, BR_W, D), BR_W ** -0.5),
        "w_out": nrm(ks[26], (L, D, D), D ** -0.5),
        "final_g": 1.0 + nrm(ks[27], (D,), 0.05),
    }


def reference(x, c, ctx, c_ctx, ada_w, ada_b, norm_g, w_in, gm_ln_g, gm_ln_b, gm_ws, gm_bs, na_rpb,
              rw_mu, rw_w0, rw_w2, rw_a0, rw_a2, rw_kk, rw_ka, rw_rk, rw_gn_g, rw_gn_b,
              pl_w, pl_scale, w_br, w_out, final_g):
    for l in range(DEPTH):
        lp = {
            'ada_w': ada_w[l], 'ada_b': ada_b[l], 'norm_g': norm_g[l], 'w_in': w_in[l],
            'gm_ln_g': gm_ln_g[l], 'gm_ln_b': gm_ln_b[l], 'gm_ws': gm_ws[l], 'gm_bs': gm_bs[l],
            'na_rpb': na_rpb[l],
            'rw_mu': rw_mu[l], 'rw_w0': rw_w0[l], 'rw_w2': rw_w2[l], 'rw_a0': rw_a0[l], 'rw_a2': rw_a2[l],
            'rw_kk': rw_kk[l], 'rw_ka': rw_ka[l], 'rw_rk': rw_rk[l], 'rw_gn_g': rw_gn_g[l], 'rw_gn_b': rw_gn_b[l],
            'pl_w': pl_w[l], 'pl_scale': pl_scale[l], 'w_br': w_br[l], 'w_out': w_out[l],
        }
        x, ctx = hybrid_layer(x, ctx, c, c_ctx, lp, update_ctx=(l < DEPTH - 1))
    return rmsnorm(x, final_g)
```

```cpp
#include <hip/hip_runtime.h>
#include <hip/hip_cooperative_groups.h>
#include <cstdio>
namespace cg = cooperative_groups;

typedef unsigned short bf16_t;
using bf16x8 = __attribute__((ext_vector_type(8))) short;
using f32x4 = __attribute__((ext_vector_type(4))) float;

constexpr int D = 1024;
constexpr int NB = 8;
constexpr int SEQ = 4096;
constexpr int CTXL = 256;
constexpr int NLAT = NB * SEQ;
constexpr int NCTX = NB * CTXL;
constexpr int NTOK = NLAT + NCTX;
constexpr int INC = 7552;
constexpr int ZW = 3200;
constexpr int Z_GMU = 0, Z_GMV = 256, Z_GMG = 512, Z_NAQ = 768, Z_NAK = 1024, Z_NAG = 1280;
constexpr int Z_RWR = 1536, Z_RWK = 1792, Z_RWV = 2048, Z_RWW = 2304, Z_RWA = 2368, Z_RWG = 2432, Z_PLP = 2688, Z_PLG = 2944;
constexpr int LDS_BYTES = 73728;
constexpr int NTHR = 256;
#ifndef DUP_MASK
#define DUP_MASK 0
#endif

struct Params {
  const float *x, *c, *ctx, *c_ctx, *ada_w, *ada_b, *norm_g, *w_in, *gm_ln_g, *gm_ln_b, *gm_ws, *gm_bs, *na_rpb,
      *rw_mu, *rw_w0, *rw_w2, *rw_a0, *rw_a2, *rw_kk, *rw_ka, *rw_rk, *rw_gn_g, *rw_gn_b, *pl_w, *pl_scale, *w_br, *w_out, *final_g;
  float* out;
  bf16_t *WtIn, *WtBr, *WtOut, *h, *z, *zvT, *zvTc, *br, *vmix;
  float *mod, *yscan, *coef, *ctx1;
  unsigned* ctr;
  unsigned* xbar;
  unsigned* cuinfo;
};

__device__ __forceinline__ bf16_t f2bf(float f) {
  unsigned u = __float_as_uint(f);
  u += 0x7fffu + ((u >> 16) & 1u);
  return (bf16_t)(u >> 16);
}
__device__ __forceinline__ float bf2f(unsigned v) { return __uint_as_float(v << 16); }
__device__ __forceinline__ unsigned pack2(float a, float b) { return (unsigned)f2bf(a) | ((unsigned)f2bf(b) << 16); }
__device__ __forceinline__ float bflo(unsigned w) { return __uint_as_float(w << 16); }
__device__ __forceinline__ float bfhi(unsigned w) { return __uint_as_float(w & 0xffff0000u); }
__device__ __forceinline__ float frcp(float x) { return __builtin_amdgcn_rcpf(x); }
__device__ __forceinline__ float sigm(float x) { return frcp(1.f + __expf(-x)); }
__device__ __forceinline__ float silu_(float x) { return x * frcp(1.f + __expf(-x)); }
__device__ __forceinline__ float gelu_(float x) {
  float u = 1.5957691216f * (x + 0.044715f * x * x * x);
  return x * frcp(1.f + __expf(-u));
}
template <int CTRL>
__device__ __forceinline__ float dppf(float v) {
  return __int_as_float(__builtin_amdgcn_update_dpp(0, __float_as_int(v), CTRL, 0xf, 0xf, false));
}
__device__ __forceinline__ float red16_sum(float v) {
  v += dppf<0xB1>(v); v += dppf<0x4E>(v); v += dppf<0x141>(v); v += dppf<0x140>(v); return v;
}
__device__ __forceinline__ void red16_sum2(float& a, float& b) {
  a += dppf<0xB1>(a); asm volatile("" : "+v"(a));
  b += dppf<0xB1>(b); asm volatile("" : "+v"(b));
  a += dppf<0x4E>(a); asm volatile("" : "+v"(a));
  b += dppf<0x4E>(b); asm volatile("" : "+v"(b));
  a += dppf<0x141>(a); asm volatile("" : "+v"(a));
  b += dppf<0x141>(b); asm volatile("" : "+v"(b));
  a += dppf<0x140>(a); asm volatile("" : "+v"(a));
  b += dppf<0x140>(b); asm volatile("" : "+v"(b));
}
__device__ __forceinline__ float red16_max(float v) {
  v = fmaxf(v, dppf<0xB1>(v)); v = fmaxf(v, dppf<0x4E>(v)); v = fmaxf(v, dppf<0x141>(v)); v = fmaxf(v, dppf<0x140>(v)); return v;
}
__device__ __forceinline__ float red8_sum(float v) {
  v += dppf<0xB1>(v); v += dppf<0x4E>(v); v += dppf<0x141>(v); return v;
}
__device__ __forceinline__ float wave_sum(float v) {
#pragma unroll
  for (int o = 32; o > 0; o >>= 1) v += __shfl_xor(v, o);
  return v;
}
__device__ __forceinline__ int tid_op() {
  int t = threadIdx.x;
  asm volatile("" : "+v"(t));
  return t;
}
__device__ __forceinline__ void lds_barrier() {
  asm volatile("s_waitcnt lgkmcnt(0)" ::: "memory");
  __builtin_amdgcn_s_barrier();
  asm volatile("" ::: "memory");
}
__device__ __forceinline__ f32x4 mfma16(bf16x8 a, bf16x8 b, f32x4 c) {
  return __builtin_amdgcn_mfma_f32_16x16x32_bf16(a, b, c, 0, 0, 0);
}
__device__ __forceinline__ void unpack8(uint4 v, float* f) {
  f[0] = bflo(v.x); f[1] = bfhi(v.x); f[2] = bflo(v.y); f[3] = bfhi(v.y);
  f[4] = bflo(v.z); f[5] = bfhi(v.z); f[6] = bflo(v.w); f[7] = bfhi(v.w);
}

__device__ void transpose_tile(const float* __restrict__ src, int N, bf16_t* __restrict__ dst, int K, int k0, int n0, float* tile) {
  const int t = tid_op();
  const int r = t >> 4, c4 = (t & 15) * 4;
#pragma unroll
  for (int i = 0; i < 4; i++) {
    int k = r + 16 * i;
    float4 v = *(const float4*)(src + (size_t)(k0 + k) * N + n0 + c4);
    tile[k * 65 + c4 + 0] = v.x; tile[k * 65 + c4 + 1] = v.y; tile[k * 65 + c4 + 2] = v.z; tile[k * 65 + c4 + 3] = v.w;
  }
  __syncthreads();
  const int n = t >> 2, ks = (t & 3) * 16;
  unsigned pk[8];
#pragma unroll
  for (int i = 0; i < 8; i++) pk[i] = pack2(tile[(ks + 2 * i) * 65 + n], tile[(ks + 2 * i + 1) * 65 + n]);
  uint4* dp = (uint4*)(dst + (size_t)(n0 + n) * K + k0 + ks);
  dp[0] = make_uint4(pk[0], pk[1], pk[2], pk[3]);
  dp[1] = make_uint4(pk[4], pk[5], pk[6], pk[7]);
  __syncthreads();
}

__device__ void mod_item(const Params& p, int l, int jc, char* smem) {
  float* sil = (float*)smem;
  float* red = sil + 9 * 1024;
  const int t = tid_op();
  for (int i = t; i < 9 * 1024; i += NTHR) {
    int r = i >> 10, k = i & 1023;
    float v = r < 8 ? p.c[r * 1024 + k] : p.c_ctx[k];
    sil[i] = silu_(v);
  }
  __syncthreads();
  const int col = t & 63, q = t >> 6;
  float acc[9];
#pragma unroll
  for (int r = 0; r < 9; r++) acc[r] = 0.f;
  const float* w = p.ada_w + (size_t)l * 1024 * 3072 + jc * 64 + col;
  for (int k = q * 256; k < q * 256 + 256; k++) {
    float wv = w[(size_t)k * 3072];
#pragma unroll
    for (int r = 0; r < 9; r++) acc[r] += sil[r * 1024 + k] * wv;
  }
#pragma unroll
  for (int r = 0; r < 9; r++) red[(q * 9 + r) * 64 + col] = acc[r];
  __syncthreads();
  if (t < 64) {
    float bb = p.ada_b[l * 3072 + jc * 64 + t];
#pragma unroll
    for (int r = 0; r < 9; r++) {
      float s = red[(0 * 9 + r) * 64 + t] + red[(1 * 9 + r) * 64 + t] + red[(2 * 9 + r) * 64 + t] + red[(3 * 9 + r) * 64 + t];
      p.mod[(l * 9 + r) * 3072 + jc * 64 + t] = s + bb;
    }
  }
  __syncthreads();
}

__device__ void phase0(const Params& p, char* smem) {
  if (blockIdx.x == 0 && threadIdx.x < 8) p.ctr[threadIdx.x] = 0u;
  constexpr int PER_L = 2400 + 48;
  for (int it = blockIdx.x; it < 2 * PER_L; it += gridDim.x) {
    int l = it / PER_L, r = it % PER_L;
    if (r < 1888) {
      int kt = r & 15, nt = r >> 4;
      transpose_tile(p.w_in + (size_t)l * 1024 * INC, INC, p.WtIn + (size_t)l * INC * 1024, 1024, kt * 64, nt * 64, (float*)smem);
    } else if (r < 2144) {
      int q = r - 1888; int i = q >> 6; int kt = q & 3, nt = (q >> 2) & 15;
      transpose_tile(p.w_br + ((size_t)l * 4 + i) * 256 * 1024, 1024, p.WtBr + ((size_t)l * 4 + i) * 1024 * 256, 256, kt * 64, nt * 64, (float*)smem);
    } else if (r < 2400) {
      int q = r - 2144; int kt = q & 15, nt = q >> 4;
      transpose_tile(p.w_out + (size_t)l * 1024 * 1024, 1024, p.WtOut + (size_t)l * 1024 * 1024, 1024, kt * 64, nt * 64, (float*)smem);
    } else {
      mod_item(p, l, r - 2400, smem);
    }
  }
}

__device__ void phase_norm(const Params& p, int l, const float* xsrc, const float* csrc) {
  const int t_ = tid_op();
  const int lane = t_ & 63;
  const int gw = blockIdx.x * 4 + (t_ >> 6), nw = gridDim.x * 4;
  const float* g = p.norm_g + l * 1024;
  for (int r = gw; r < NTOK; r += nw) {
    const float* src; int mb;
    if (r < NLAT) { src = xsrc + (size_t)r * 1024; mb = r >> 12; } else { src = csrc + (size_t)(r - NLAT) * 1024; mb = 8; }
    const float* md = p.mod + (l * 9 + mb) * 3072;
    float4 v[4]; float ss = 0.f;
#pragma unroll
    for (int i = 0; i < 4; i++) {
      v[i] = *(const float4*)(src + lane * 4 + 256 * i);
      ss += v[i].x * v[i].x + v[i].y * v[i].y + v[i].z * v[i].z + v[i].w * v[i].w;
    }
    ss = wave_sum(ss);
    float rs = rsqrtf(ss * (1.f / 1024.f) + 1e-6f);
#pragma unroll
    for (int i = 0; i < 4; i++) {
      int col = lane * 4 + 256 * i;
      float4 gg = *(const float4*)(g + col);
      float4 sh = *(const float4*)(md + col);
      float4 sc = *(const float4*)(md + 1024 + col);
      float a0 = v[i].x * rs * gg.x * (1.f + sc.x) + sh.x;
      float a1 = v[i].y * rs * gg.y * (1.f + sc.y) + sh.y;
      float a2 = v[i].z * rs * gg.z * (1.f + sc.z) + sh.z;
      float a3 = v[i].w * rs * gg.w * (1.f + sc.w) + sh.w;
      *(uint2*)(p.h + (size_t)r * 1024 + col) = make_uint2(pack2(a0, a1), pack2(a2, a3));
    }
  }
}

__device__ void phase_final(const Params& p) {
  const int t_ = tid_op();
  const int lane = t_ & 63;
  const int gw = blockIdx.x * 4 + (t_ >> 6), nw = gridDim.x * 4;
  for (int r = gw; r < NLAT; r += nw) {
    float* src = p.out + (size_t)r * 1024;
    float4 v[4]; float ss = 0.f;
#pragma unroll
    for (int i = 0; i < 4; i++) {
      v[i] = *(const float4*)(src + lane * 4 + 256 * i);
      ss += v[i].x * v[i].x + v[i].y * v[i].y + v[i].z * v[i].z + v[i].w * v[i].w;
    }
    ss = wave_sum(ss);
    float rs = rsqrtf(ss * (1.f / 1024.f) + 1e-6f);
#pragma unroll
    for (int i = 0; i < 4; i++) {
      int col = lane * 4 + 256 * i;
      float4 gg = *(const float4*)(p.final_g + col);
      float4 o = make_float4(v[i].x * rs * gg.x, v[i].y * rs * gg.y, v[i].z * rs * gg.z, v[i].w * rs * gg.w);
      *(float4*)(src + col) = o;
    }
  }
}

template <int NT, bool SWAP>
__device__ __forceinline__ void gemm_compute(const bf16_t* a_s, const bf16_t* b_s, int o0, f32x4 (&acc)[4][NT]) {
#pragma unroll
  for (int ks = 0; ks < 2; ks++) {
    const int off = ks == 0 ? o0 : (o0 ^ 32);
    bf16x8 af[4], bfr[NT];
#pragma unroll
    for (int mt = 0; mt < 4; mt++) af[mt] = *(const bf16x8*)(a_s + mt * 16 * 64 + off);
#pragma unroll
    for (int nt = 0; nt < NT; nt++) bfr[nt] = *(const bf16x8*)(b_s + nt * 16 * 64 + off);
#pragma unroll
    for (int mt = 0; mt < 4; mt++)
#pragma unroll
      for (int nt = 0; nt < NT; nt++)
        acc[mt][nt] = SWAP ? mfma16(bfr[nt], af[mt], acc[mt][nt]) : mfma16(af[mt], bfr[nt], acc[mt][nt]);
  }
}

template <int NT, bool SWAP>
__device__ __forceinline__ void gemm_mainloop(const bf16_t* __restrict__ A, int lda, const bf16_t* __restrict__ Bm, int ldb,
                                              int nk, f32x4 (&acc)[4][NT], bf16_t* sm) {
  constexpr int ASZ = 128 * 64, BSZ = NT * 32 * 64;
  bf16_t* sA = sm;
  bf16_t* sB = sm + 2 * ASZ;
  const int t = tid_op(), lane = t & 63, wave = t >> 6, wm = wave >> 1, wn = wave & 1;
  const int lr = t >> 3, lc = (t & 7) * 8;
  const int lcs = ((t & 7) ^ ((lr >> 1) & 7)) * 8;
  const int fr = lane & 15, fq = lane >> 4;
  uint4 p0a0, p0a1, p0a2, p0a3, p0b0, p0b1, p0b2, p0b3;
  uint4 p1a0, p1a1, p1a2, p1a3, p1b0, p1b1, p1b2, p1b3;
  p0b2 = p0b3 = p1b2 = p1b3 = make_uint4(0, 0, 0, 0);
  const bf16_t* Ap = A + (size_t)lr * lda + lc;
  const bf16_t* Bp = Bm + (size_t)lr * ldb + lc;
#define GLD(P, R, I, KT) *(const uint4*)(P + (size_t)(32 * I) * R + (KT) * 64)
#define GLOAD(S, KT)                                                         \
  {                                                                          \
    S##a0 = GLD(Ap, lda, 0, KT); S##a1 = GLD(Ap, lda, 1, KT);                \
    S##a2 = GLD(Ap, lda, 2, KT); S##a3 = GLD(Ap, lda, 3, KT);                \
    S##b0 = GLD(Bp, ldb, 0, KT); S##b1 = GLD(Bp, ldb, 1, KT);                \
    if constexpr (NT == 4) { S##b2 = GLD(Bp, ldb, 2, KT); S##b3 = GLD(Bp, ldb, 3, KT); } \
  }
#define SST(BASE, I) *(uint4*)(BASE + (lr + 32 * I) * 64 + lcs)
#define SWRITE(S, BUF)                                                       \
  {                                                                          \
    SST(sA + (BUF) * ASZ, 0) = S##a0; SST(sA + (BUF) * ASZ, 1) = S##a1;      \
    SST(sA + (BUF) * ASZ, 2) = S##a2; SST(sA + (BUF) * ASZ, 3) = S##a3;      \
    SST(sB + (BUF) * BSZ, 0) = S##b0; SST(sB + (BUF) * BSZ, 1) = S##b1;      \
    if constexpr (NT == 4) { SST(sB + (BUF) * BSZ, 2) = S##b2; SST(sB + (BUF) * BSZ, 3) = S##b3; } \
  }
  const bf16_t* a_s0 = sA + (wm * 64 + fr) * 64;
  const bf16_t* b_s0 = sB + (wn * (NT * 16) + fr) * 64;
  const int o0 = (fq ^ ((fr >> 1) & 7)) * 8;
  GLOAD(p0, 0);
  GLOAD(p1, 1);
  SWRITE(p0, 0);
  __syncthreads();
#pragma unroll 1
  for (int kt = 0; kt < nk; kt += 2) {
    const bool m2 = kt + 2 < nk;
    if (m2) GLOAD(p0, kt + 2);
    gemm_compute<NT, SWAP>(a_s0, b_s0, o0, acc);
    SWRITE(p1, 1);
    __syncthreads();
    if (m2) GLOAD(p1, kt + 3);
    gemm_compute<NT, SWAP>(a_s0 + ASZ, b_s0 + BSZ, o0, acc);
    if (m2) SWRITE(p0, 0);
    __syncthreads();
  }
#undef GLOAD
#undef SWRITE
#undef GLD
#undef SST
}

template <int NT>
__device__ __forceinline__ void zero_acc(f32x4 (&acc)[4][NT]) {
#pragma unroll
  for (int i = 0; i < 4; i++)
#pragma unroll
    for (int j = 0; j < NT; j++) acc[i][j] = f32x4{0.f, 0.f, 0.f, 0.f};
}

struct TileIter {
  int total, TN, per_x, base, lim, nslot, slot;
  __device__ __forceinline__ void init(int TM, int TN_, int vb = -1, int nvb = 0) {
    TN = TN_; total = TM * TN_;
    const int nx = 8;
    if (vb < 0) { vb = blockIdx.x; nvb = gridDim.x; }
    per_x = (total + nx - 1) / nx;
    const int xcd = vb % nx;
    slot = vb / nx;
    nslot = (nvb + nx - 1) / nx;
    base = xcd * per_x;
    lim = min(total, base + per_x);
  }
  __device__ __forceinline__ bool get(int iter, int& m, int& n) const {
    const int T = base + iter * nslot + slot;
    if (T >= lim) return false;
    const int grp = T / (8 * TN), r = T % (8 * TN);
    m = grp * 8 + (r & 7); n = r >> 3;
    return true;
  }
};

__device__ void phase_g1(const Params& p, int l, char* smem, int part, int vb, int nvb) {
  const int t_ = tid_op(); const int lane = t_ & 63, wave = t_ >> 6, wm = wave >> 1, wn = wave & 1, fr = lane & 15, fq = lane >> 4;
  const bf16_t* W = p.WtIn + (size_t)l * INC * 1024;
  constexpr int NTILE_N = 27, NTILE_M = NTOK / 128;
  TileIter ti; ti.init(NTILE_M, part == 0 ? NTILE_N : part == 1 ? 11 : 16, vb, nvb);
  for (int iter = 0;; iter++) {
    int mtile, ntile;
    if (!ti.get(iter, mtile, ntile)) break;
    if (part == 1) ntile += 10; else if (part == 2) ntile = ntile < 10 ? ntile : ntile + 11;
    const int m0 = mtile * 128, n0 = ntile * 128;
    f32x4 acc[4][4];
    zero_acc<4>(acc);
    if (ntile == 10 || ntile == 11) {
      gemm_mainloop<4, false>(p.h + (size_t)m0 * 1024, 1024, W + (size_t)n0 * 1024, 1024, 16, acc, (bf16_t*)smem);
#pragma unroll
      for (int mt = 0; mt < 4; mt++)
#pragma unroll
        for (int nt = 0; nt < 4; nt++) {
          int m = m0 + wm * 64 + mt * 16 + fq * 4;
          int ch = n0 + wn * 64 + nt * 16 + fr - 1280;
          bf16_t* dst;
          if (m0 < NLAT) { int b = m0 >> 12; dst = p.zvT + ((size_t)(b * 256 + ch)) * 4096 + (m - b * 4096); }
          else { int mm = m - NLAT; int b = mm >> 8; dst = p.zvTc + ((size_t)(b * 256 + ch)) * 256 + (mm & 255); }
          *(uint2*)dst = make_uint2(pack2(acc[mt][nt][0], acc[mt][nt][1]), pack2(acc[mt][nt][2], acc[mt][nt][3]));
        }
    } else {
      gemm_mainloop<4, true>(p.h + (size_t)m0 * 1024, 1024, W + (size_t)n0 * 1024, 1024, 16, acc, (bf16_t*)smem);
      const int zoff = n0 < 1280 ? 0 : -256;
#pragma unroll
      for (int mt = 0; mt < 4; mt++)
#pragma unroll
        for (int nt = 0; nt < 4; nt++) {
          int m = m0 + wm * 64 + mt * 16 + fr;
          int n = n0 + wn * 64 + nt * 16 + fq * 4 + zoff;
          *(uint2*)(p.z + (size_t)m * ZW + n) = make_uint2(pack2(acc[mt][nt][0], acc[mt][nt][1]), pack2(acc[mt][nt][2], acc[mt][nt][3]));
        }
    }
  }
}

__device__ void phase_g2(const Params& p, int l, char* smem) {
  const int t_ = tid_op(); const int lane = t_ & 63, wave = t_ >> 6, wm = wave >> 1, wn = wave & 1, fr = lane & 15, fq = lane >> 4;
  const bf16_t* W = p.WtIn + (size_t)l * INC * 1024;
  const bf16_t* Wb = p.WtBr + (size_t)l * 4 * 1024 * 256;
  bf16_t* y = p.z;
  const int ntm = (l == 0 ? NTOK : NLAT) / 128;
  TileIter ti; ti.init(ntm, 16);
  for (int iter = 0;; iter++) {
    int mtile, ntile;
    if (!ti.get(iter, mtile, ntile)) break;
    const int m0 = mtile * 128, n0 = ntile * 64;
    f32x4 yacc[4][2];
    zero_acc<2>(yacc);
#pragma unroll 1
    for (int i = 0; i < 4; i++) {
      f32x4 aL[4][2], aP[4][2];
      zero_acc<2>(aL);
      zero_acc<2>(aP);
      gemm_mainloop<2, true>(p.h + (size_t)m0 * 1024, 1024, W + (size_t)(3456 + i * 1024 + n0) * 1024, 1024, 16, aL, (bf16_t*)smem);
      gemm_mainloop<2, true>(p.br + (size_t)m0 * 1024 + i * 256, 1024, Wb + ((size_t)i * 1024 + n0) * 256, 256, 4, aP, (bf16_t*)smem);
#pragma unroll
      for (int mt = 0; mt < 4; mt++)
#pragma unroll
        for (int nt = 0; nt < 2; nt++)
#pragma unroll
          for (int j = 0; j < 4; j++) yacc[mt][nt][j] += sigm(aL[mt][nt][j]) * aP[mt][nt][j];
    }
#pragma unroll
    for (int mt = 0; mt < 4; mt++)
#pragma unroll
      for (int nt = 0; nt < 2; nt++) {
        int m = m0 + wm * 64 + mt * 16 + fr;
        int n = n0 + wn * 32 + nt * 16 + fq * 4;
        *(uint2*)(y + (size_t)m * 1024 + n) = make_uint2(pack2(yacc[mt][nt][0], yacc[mt][nt][1]), pack2(yacc[mt][nt][2], yacc[mt][nt][3]));
      }
  }
}

__device__ void phase_g3(const Params& p, int l, char* smem) {
  const int t_ = tid_op(); const int lane = t_ & 63, wave = t_ >> 6, wm = wave >> 1, wn = wave & 1, fr = lane & 15, fq = lane >> 4;
  const bf16_t* W = p.WtOut + (size_t)l * 1024 * 1024;
  const bf16_t* y = p.z;
  const int ntm = (l == 0 ? NTOK : NLAT) / 128;
  TileIter ti; ti.init(ntm, 8);
  for (int iter = 0;; iter++) {
    int mtile, ntile;
    if (!ti.get(iter, mtile, ntile)) break;
    const int m0 = mtile * 128, n0 = ntile * 128;
    f32x4 acc[4][4];
    zero_acc<4>(acc);
    gemm_mainloop<4, true>(y + (size_t)m0 * 1024, 1024, W + (size_t)n0 * 1024, 1024, 16, acc, (bf16_t*)smem);
    const float* src; float* dst; int mb;
    if (m0 < NLAT) { src = (l == 0 ? p.x : p.out) + (size_t)m0 * 1024; dst = p.out + (size_t)m0 * 1024; mb = m0 >> 12; }
    else { src = p.ctx + (size_t)(m0 - NLAT) * 1024; dst = p.ctx1 + (size_t)(m0 - NLAT) * 1024; mb = 8; }
    const float* gate = p.mod + (l * 9 + mb) * 3072 + 2048;
#pragma unroll
    for (int mt = 0; mt < 4; mt++)
#pragma unroll
      for (int nt = 0; nt < 4; nt++) {
        int mr = wm * 64 + mt * 16 + fr;
        int n = n0 + wn * 64 + nt * 16 + fq * 4;
        float4 xv = *(const float4*)(src + (size_t)mr * 1024 + n);
        float4 gv = *(const float4*)(gate + n);
        float4 o = make_float4(xv.x + gv.x * acc[mt][nt][0], xv.y + gv.y * acc[mt][nt][1], xv.z + gv.z * acc[mt][nt][2], xv.w + gv.w * acc[mt][nt][3]);
        *(float4*)(dst + (size_t)mr * 1024 + n) = o;
      }
  }
}

__device__ void scan_item(const Params& p, int l, int item, char* smem) {
  const int rq = item & 1, d = (item >> 1) & 1, h = (item >> 2) & 3, b = item >> 4;
  const int t = tid_op(), lane = t & 63, wave = t >> 6, fr = lane & 15, fq = lane >> 4;
  float* Wd = (float*)smem;
  float* Av = Wd + 2048;
  float* Bv = Av + 2048;
  float* Kd = Bv + 2048;
  float* Rr = Kd + 2048;
  float* Vv = Rr + 2048;
  float* Pf = Vv + 1024;
  float* Yb = Pf;
  float* Qf = Pf + 2048;
  float* prm = Qf + 2048;
  bf16_t* wl = (bf16_t*)(prm + 320);
  bf16_t* al = wl + 32 * 72;

  for (int i = t; i < 320; i += NTHR) {
    int which = i >> 6, k = i & 63;
    float v;
    if (which == 0) v = p.rw_w0[(l * 2 + d) * 256 + h * 64 + k];
    else if (which == 1) v = p.rw_a0[(l * 2 + d) * 256 + h * 64 + k];
    else if (which == 2) v = p.rw_ka[l * 256 + h * 64 + k];
    else if (which == 3) v = p.rw_kk[l * 256 + h * 64 + k];
    else v = p.rw_rk[(l * 4 + h) * 64 + k];
    prm[i] = v;
  }
  bf16x8 w2f[2], a2f[2];
  {
    const int n = h * 64 + 16 * wave + fr;
    const float* w2 = p.rw_w2 + (size_t)(l * 2 + d) * 64 * 256 + n;
    const float* a2 = p.rw_a2 + (size_t)(l * 2 + d) * 64 * 256 + n;
#pragma unroll
    for (int ks = 0; ks < 2; ks++)
#pragma unroll
      for (int j = 0; j < 8; j++) {
        int kk = ks * 32 + fq * 8 + j;
        w2f[ks][j] = (short)f2bf(w2[kk * 256]);
        a2f[ks][j] = (short)f2bf(a2[kk * 256]);
      }
  }
  __syncthreads();

  float s0 = 0.f, s1 = 0.f, s2 = 0.f, s3 = 0.f;
  float u0 = 0.f, u1 = 0.f, u2 = 0.f, u3 = 0.f;
  const int kseg = lane & 15, rowl = wave * 8 + (lane >> 4) * 2;
  const int tt1 = t >> 3, oct = t & 7;
  constexpr int NCH_C = CTXL / 32, NCH_L = SEQ / 32, NCH = NCH_C + NCH_L;
  uint4 rcu[5], rpv[5], rnx[5];
  auto load_raw = [&](int gc) {
    const bool isc = gc < NCH_C;
    const int T = isc ? CTXL : SEQ;
    const int nch = isc ? NCH_C : NCH_L;
    const int ci = isc ? gc : gc - NCH_C;
    const int c = d ? nch - 1 - ci : ci;
    const size_t rowbase = isc ? (size_t)NLAT + b * CTXL : (size_t)b * SEQ;
    const int tok = c * 32 + tt1;
    const bf16_t* zr = p.z + (rowbase + tok) * ZW;
    const bool hp = tok > 0, hn = tok < T - 1;
#pragma unroll
    for (int g = 0; g < 5; g++) {
      const int colbase = g == 0 ? Z_RWR + h * 64 : g == 1 ? Z_RWK + h * 64 : g == 2 ? Z_RWV + h * 64 : g == 3 ? Z_RWW : Z_RWA;
      const int col = colbase + oct * 8;
      rcu[g] = *(const uint4*)(zr + col);
      rpv[g] = make_uint4(0, 0, 0, 0);
      rnx[g] = make_uint4(0, 0, 0, 0);
      if (hp) rpv[g] = *(const uint4*)(zr - ZW + col);
      if (hn) rnx[g] = *(const uint4*)(zr + ZW + col);
    }
  };
  float mureg[5][8];
#pragma unroll
  for (int g = 0; g < 5; g++) {
    const int colbase = g == 0 ? Z_RWR + h * 64 : g == 1 ? Z_RWK + h * 64 : g == 2 ? Z_RWV + h * 64 : g == 3 ? Z_RWW : Z_RWA;
    const float* mup = p.rw_mu + l * 896 + (colbase + oct * 8 - Z_RWR);
    float4 m0 = *(const float4*)mup, m1 = *(const float4*)(mup + 4);
    mureg[g][0] = m0.x; mureg[g][1] = m0.y; mureg[g][2] = m0.z; mureg[g][3] = m0.w;
    mureg[g][4] = m1.x; mureg[g][5] = m1.y; mureg[g][6] = m1.z; mureg[g][7] = m1.w;
  }
  load_raw(0);
  __builtin_amdgcn_s_setprio(2);
#pragma unroll 1
  for (int gc = 0; gc < NCH; gc++) {
    const bool isc = gc < NCH_C;
    const int nch = isc ? NCH_C : NCH_L;
    const int ci = isc ? gc : gc - NCH_C;
    const int c = d ? nch - 1 - ci : ci;
    const size_t rowbase = isc ? (size_t)NLAT + b * CTXL : (size_t)b * SEQ;
    const int t0 = c * 32;
    {
      const int tt = tt1;
      const int tok = t0 + tt;
#pragma unroll
      for (int g = 0; g < 5; g++) {
        const int colbase = g == 0 ? Z_RWR + h * 64 : g == 1 ? Z_RWK + h * 64 : g == 2 ? Z_RWV + h * 64 : g == 3 ? Z_RWW : Z_RWA;
        const int col = colbase + oct * 8;
        float fc[8], fp[8], fn[8], mix[8];
        unpack8(rcu[g], fc); unpack8(rpv[g], fp); unpack8(rnx[g], fn);
#pragma unroll
        for (int i = 0; i < 8; i++) mix[i] = fc[i] + (0.5f * (fp[i] + fn[i]) - fc[i]) * mureg[g][i];
        if (g == 0) {
          *(float4*)(Rr + tt * 64 + oct * 8) = make_float4(mix[0], mix[1], mix[2], mix[3]);
          *(float4*)(Rr + tt * 64 + oct * 8 + 4) = make_float4(mix[4], mix[5], mix[6], mix[7]);
        } else if (g == 1) {
          *(float4*)(Kd + tt * 64 + oct * 8) = make_float4(mix[0], mix[1], mix[2], mix[3]);
          *(float4*)(Kd + tt * 64 + oct * 8 + 4) = make_float4(mix[4], mix[5], mix[6], mix[7]);
        } else if (g == 2) {
          if ((oct >> 2) == rq) {
            *(float4*)(Vv + tt * 32 + (oct & 3) * 8) = make_float4(mix[0], mix[1], mix[2], mix[3]);
            *(float4*)(Vv + tt * 32 + (oct & 3) * 8 + 4) = make_float4(mix[4], mix[5], mix[6], mix[7]);
            if (d == 0) {
              *(uint4*)(p.vmix + (rowbase + tok) * 256 + h * 64 + oct * 8) =
                  make_uint4(pack2(mix[0], mix[1]), pack2(mix[2], mix[3]), pack2(mix[4], mix[5]), pack2(mix[6], mix[7]));
            }
          }
        } else if (g == 3) {
          float th[8];
#pragma unroll
          for (int i = 0; i < 8; i++) th[i] = 1.f - 2.f * frcp(1.f + __expf(2.f * mix[i]));
          *(uint4*)(wl + tt * 72 + oct * 8) = make_uint4(pack2(th[0], th[1]), pack2(th[2], th[3]), pack2(th[4], th[5]), pack2(th[6], th[7]));
        } else {
          *(uint4*)(al + tt * 72 + oct * 8) = make_uint4(pack2(mix[0], mix[1]), pack2(mix[2], mix[3]), pack2(mix[4], mix[5]), pack2(mix[6], mix[7]));
        }
      }
    }
    if (gc + 1 < NCH) load_raw(gc + 1);
    lds_barrier();
    {
#pragma unroll
      for (int mt = 0; mt < 2; mt++) {
        f32x4 ap = {0.f, 0.f, 0.f, 0.f}, aq = {0.f, 0.f, 0.f, 0.f};
#pragma unroll
        for (int ks = 0; ks < 2; ks++) {
          bf16x8 fa = *(const bf16x8*)(wl + (mt * 16 + fr) * 72 + ks * 32 + fq * 8);
          bf16x8 fb = *(const bf16x8*)(al + (mt * 16 + fr) * 72 + ks * 32 + fq * 8);
          ap = mfma16(fa, w2f[ks], ap);
          aq = mfma16(fb, a2f[ks], aq);
        }
#pragma unroll
        for (int j = 0; j < 4; j++) {
          Pf[(mt * 16 + fq * 4 + j) * 64 + wave * 16 + fr] = ap[j];
          Qf[(mt * 16 + fq * 4 + j) * 64 + wave * 16 + fr] = aq[j];
        }
      }
    }
    lds_barrier();
    {
      const int tt = tt1;
      float ss = 0.f, cf = 0.f;
      float kkr[8], aa[8], pv[8], qv[8], kv[8], rv[8], dec[8], kdv[8];
      *(float4*)(pv) = *(const float4*)(Pf + tt * 64 + oct * 8); *(float4*)(pv + 4) = *(const float4*)(Pf + tt * 64 + oct * 8 + 4);
      *(float4*)(qv) = *(const float4*)(Qf + tt * 64 + oct * 8); *(float4*)(qv + 4) = *(const float4*)(Qf + tt * 64 + oct * 8 + 4);
      *(float4*)(kv) = *(const float4*)(Kd + tt * 64 + oct * 8); *(float4*)(kv + 4) = *(const float4*)(Kd + tt * 64 + oct * 8 + 4);
      *(float4*)(rv) = *(const float4*)(Rr + tt * 64 + oct * 8); *(float4*)(rv + 4) = *(const float4*)(Rr + tt * 64 + oct * 8 + 4);
#pragma unroll
      for (int i = 0; i < 8; i++) {
        const int k = oct * 8 + i;
        float pp = prm[k] + pv[i];
        dec[i] = __expf(-0.6065306597f * sigm(pp));
        float a = sigm(prm[64 + k] + qv[i]);
        float kr = kv[i];
        kdv[i] = kr * (1.f + (a - 1.f) * prm[128 + k]);
        kkr[i] = kr * prm[192 + k];
        ss += kkr[i] * kkr[i];
        cf += rv[i] * kdv[i] * prm[256 + k];
        aa[i] = a;
      }
      ss = red8_sum(ss);
      cf = red8_sum(cf);
      float inv = frcp(fmaxf(__builtin_amdgcn_sqrtf(ss), 1e-12f));
      float av[8], bv[8];
#pragma unroll
      for (int i = 0; i < 8; i++) { float kk = kkr[i] * inv; av[i] = -kk; bv[i] = kk * aa[i]; }
      *(float4*)(Wd + tt * 64 + oct * 8) = *(float4*)(dec); *(float4*)(Wd + tt * 64 + oct * 8 + 4) = *(float4*)(dec + 4);
      *(float4*)(Kd + tt * 64 + oct * 8) = *(float4*)(kdv); *(float4*)(Kd + tt * 64 + oct * 8 + 4) = *(float4*)(kdv + 4);
      *(float4*)(Av + tt * 64 + oct * 8) = *(float4*)(av); *(float4*)(Av + tt * 64 + oct * 8 + 4) = *(float4*)(av + 4);
      *(float4*)(Bv + tt * 64 + oct * 8) = *(float4*)(bv); *(float4*)(Bv + tt * 64 + oct * 8 + 4) = *(float4*)(bv + 4);
      if (rq == 0 && oct == 0) p.coef[((size_t)d * NTOK + rowbase + t0 + tt) * 4 + h] = cf;
    }
    lds_barrier();
    {
      const int step = d ? -1 : 1;
      int tt = d ? 31 : 0;
      float4 w = *(const float4*)(Wd + tt * 64 + kseg * 4);
      float4 a = *(const float4*)(Av + tt * 64 + kseg * 4);
      float4 bb = *(const float4*)(Bv + tt * 64 + kseg * 4);
      float4 kd = *(const float4*)(Kd + tt * 64 + kseg * 4);
      float4 r = *(const float4*)(Rr + tt * 64 + kseg * 4);
      float2 v = *(const float2*)(Vv + tt * 32 + rowl);
      float ysel0 = 0.f, ysel1 = 0.f;
#pragma unroll 16
      for (int i = 0; i < 32; i++) {
        const int tn = (i < 31) ? tt + step : tt;
        float4 w2 = *(const float4*)(Wd + tn * 64 + kseg * 4);
        float4 a2 = *(const float4*)(Av + tn * 64 + kseg * 4);
        float4 b2 = *(const float4*)(Bv + tn * 64 + kseg * 4);
        float4 k2 = *(const float4*)(Kd + tn * 64 + kseg * 4);
        float4 r2 = *(const float4*)(Rr + tn * 64 + kseg * 4);
        float2 v2 = *(const float2*)(Vv + tn * 32 + rowl);
        float sa = (s0 * a.x + s1 * a.y) + (s2 * a.z + s3 * a.w);
        float ua = (u0 * a.x + u1 * a.y) + (u2 * a.z + u3 * a.w);
        red16_sum2(sa, ua);
        s0 = s0 * w.x + sa * bb.x + v.x * kd.x;
        s1 = s1 * w.y + sa * bb.y + v.x * kd.y;
        s2 = s2 * w.z + sa * bb.z + v.x * kd.z;
        s3 = s3 * w.w + sa * bb.w + v.x * kd.w;
        u0 = u0 * w.x + ua * bb.x + v.y * kd.x;
        u1 = u1 * w.y + ua * bb.y + v.y * kd.y;
        u2 = u2 * w.z + ua * bb.z + v.y * kd.z;
        u3 = u3 * w.w + ua * bb.w + v.y * kd.w;
        float y0 = (s0 * r.x + s1 * r.y) + (s2 * r.z + s3 * r.w);
        float y1 = (u0 * r.x + u1 * r.y) + (u2 * r.z + u3 * r.w);
        red16_sum2(y0, y1);
        ysel0 = ((i & 15) == kseg) ? y0 : ysel0;
        ysel1 = ((i & 15) == kseg) ? y1 : ysel1;
        if ((i & 15) == 15) {
          const int si = (i - 15) + kseg;
          const int ts = d ? 31 - si : si;
          *(float2*)(Yb + ts * 32 + rowl) = make_float2(ysel0, ysel1);
        }
        w = w2; a = a2; bb = b2; kd = k2; r = r2; v = v2; tt = tn;
      }
    }
    lds_barrier();
    {
      const int tt = t >> 3, q4 = t & 7;
      float4 yv = *(const float4*)(Yb + tt * 32 + q4 * 4);
      *(float4*)(p.yscan + ((size_t)d * NTOK + rowbase + t0 + tt) * 256 + h * 64 + rq * 32 + q4 * 4) = yv;
    }
  }
  __builtin_amdgcn_s_setprio(0);
  __syncthreads();
}

__device__ void natten_item(const Params& p, int l, int b, int h, size_t qrow0, int nband, int r, char* smem) {
  const int t = tid_op(), lane = t & 63, wave = t >> 6, fr = lane & 15, fq = lane >> 4;
  float* rpb = (float*)smem;
  bf16_t* Ps = (bf16_t*)(smem + 2048) + wave * 16 * 72;
  for (int i = t; i < 465; i += NTHR) rpb[i] = p.na_rpb[(l * 4 + h) * 465 + i];
  __syncthreads();
  const int qloc = wave * 16;
  bf16x8 qf[2];
#pragma unroll
  for (int ks = 0; ks < 2; ks++) qf[ks] = *(const bf16x8*)(p.z + (qrow0 + qloc + fr) * ZW + Z_NAQ + h * 64 + ks * 32 + fq * 8);
  float mrow[4], lrow[4];
  f32x4 o[4];
#pragma unroll
  for (int j = 0; j < 4; j++) { mrow[j] = -1e30f; lrow[j] = 0.f; o[j] = f32x4{0.f, 0.f, 0.f, 0.f}; }
  const int rstart = min(max(r - 4, 0), 56);
  const int c0w = wave == 0 ? 0 : wave == 1 ? 8 : wave == 2 ? 24 : 32;
#pragma unroll 1
  for (int kt = 0; kt < nband; kt++) {
    const int rr = rstart + kt;
    const size_t krow0 = (size_t)b * SEQ + rr * 64 + c0w;
    const bf16_t* vt = p.zvT + ((size_t)(b * 256 + h * 64)) * 4096 + rr * 64 + c0w;
    f32x4 s[2];
#pragma unroll
    for (int nt = 0; nt < 2; nt++) {
      s[nt] = f32x4{0.f, 0.f, 0.f, 0.f};
#pragma unroll
      for (int ks = 0; ks < 2; ks++) {
        bf16x8 kf = *(const bf16x8*)(p.z + (krow0 + nt * 16 + fr) * ZW + Z_NAK + h * 64 + ks * 32 + fq * 8);
        s[nt] = mfma16(qf[ks], kf, s[nt]);
      }
    }
    float pj[2][4];
#pragma unroll
    for (int j = 0; j < 4; j++) {
      const int q = qloc + fq * 4 + j;
      float mx = -1e30f;
#pragma unroll
      for (int nt = 0; nt < 2; nt++) {
        const int kc = c0w + nt * 16 + fr;
        const int cs = min(max(q - 8, 0), 48);
        const bool ok = (kc >= cs) && (kc < cs + 16);
        const int dc = min(max(kc - q, -15), 15);
        float bias = rpb[(rr - r + 7) * 31 + dc + 15];
        float val = ok ? s[nt][j] * 0.125f + bias : -1e30f;
        pj[nt][j] = val;
        mx = fmaxf(mx, val);
      }
      mx = red16_max(mx);
      const float mnew = fmaxf(mrow[j], mx);
      const float alpha = __expf(mrow[j] - mnew);
      float sum = 0.f;
#pragma unroll
      for (int nt = 0; nt < 2; nt++) { float e = __expf(pj[nt][j] - mnew); pj[nt][j] = e; sum += e; }
      sum = red16_sum(sum);
      lrow[j] = lrow[j] * alpha + sum;
      mrow[j] = mnew;
#pragma unroll
      for (int nt = 0; nt < 4; nt++) o[nt][j] *= alpha;
    }
#pragma unroll
    for (int nt = 0; nt < 2; nt++)
#pragma unroll
      for (int j = 0; j < 4; j++) Ps[(fq * 4 + j) * 72 + nt * 16 + fr] = f2bf(pj[nt][j]);
    __builtin_amdgcn_fence(__ATOMIC_RELEASE, "wavefront");
    __builtin_amdgcn_wave_barrier();
    __builtin_amdgcn_fence(__ATOMIC_ACQUIRE, "wavefront");
    bf16x8 pf = *(const bf16x8*)(Ps + fr * 72 + fq * 8);
#pragma unroll
    for (int nt = 0; nt < 4; nt++) {
      bf16x8 vf = *(const bf16x8*)(vt + (size_t)(nt * 16 + fr) * 4096 + fq * 8);
      o[nt] = mfma16(pf, vf, o[nt]);
    }
    __builtin_amdgcn_fence(__ATOMIC_RELEASE, "wavefront");
    __builtin_amdgcn_wave_barrier();
  }
#pragma unroll 1
  for (int cc = 0; cc < 4; cc++) {
    const size_t krow0 = (size_t)NLAT + b * CTXL + cc * 64;
    const bf16_t* vt = p.zvTc + ((size_t)(b * 256 + h * 64)) * 256 + cc * 64;
    f32x4 s[4];
#pragma unroll
    for (int nt = 0; nt < 4; nt++) {
      s[nt] = f32x4{0.f, 0.f, 0.f, 0.f};
#pragma unroll
      for (int ks = 0; ks < 2; ks++) {
        bf16x8 kf = *(const bf16x8*)(p.z + (krow0 + nt * 16 + fr) * ZW + Z_NAK + h * 64 + ks * 32 + fq * 8);
        s[nt] = mfma16(qf[ks], kf, s[nt]);
      }
    }
    float pj[4][4];
#pragma unroll
    for (int j = 0; j < 4; j++) {
      float mx = -1e30f;
#pragma unroll
      for (int nt = 0; nt < 4; nt++) { float val = s[nt][j] * 0.125f; pj[nt][j] = val; mx = fmaxf(mx, val); }
      mx = red16_max(mx);
      const float mnew = fmaxf(mrow[j], mx);
      const float alpha = __expf(mrow[j] - mnew);
      float sum = 0.f;
#pragma unroll
      for (int nt = 0; nt < 4; nt++) { float e = __expf(pj[nt][j] - mnew); pj[nt][j] = e; sum += e; }
      sum = red16_sum(sum);
      lrow[j] = lrow[j] * alpha + sum;
      mrow[j] = mnew;
#pragma unroll
      for (int nt = 0; nt < 4; nt++) o[nt][j] *= alpha;
    }
#pragma unroll
    for (int nt = 0; nt < 4; nt++)
#pragma unroll
      for (int j = 0; j < 4; j++) Ps[(fq * 4 + j) * 72 + nt * 16 + fr] = f2bf(pj[nt][j]);
    __builtin_amdgcn_fence(__ATOMIC_RELEASE, "wavefront");
    __builtin_amdgcn_wave_barrier();
    __builtin_amdgcn_fence(__ATOMIC_ACQUIRE, "wavefront");
    bf16x8 pf[2];
#pragma unroll
    for (int ks = 0; ks < 2; ks++) pf[ks] = *(const bf16x8*)(Ps + fr * 72 + ks * 32 + fq * 8);
#pragma unroll
    for (int nt = 0; nt < 4; nt++)
#pragma unroll
      for (int ks = 0; ks < 2; ks++) {
        bf16x8 vf = *(const bf16x8*)(vt + (size_t)(nt * 16 + fr) * 256 + ks * 32 + fq * 8);
        o[nt] = mfma16(pf[ks], vf, o[nt]);
      }
    __builtin_amdgcn_fence(__ATOMIC_RELEASE, "wavefront");
    __builtin_amdgcn_wave_barrier();
  }
#pragma unroll
  for (int j = 0; j < 4; j++) {
    const size_t row = qrow0 + qloc + fq * 4 + j;
    const float inv = frcp(lrow[j]);
#pragma unroll
    for (int nt = 0; nt < 4; nt++) {
      const int dcol = nt * 16 + fr;
      float g = silu_(bf2f(p.z[row * ZW + Z_NAG + h * 64 + dcol]));
      p.br[row * 1024 + 256 + h * 64 + dcol] = f2bf(o[nt][j] * inv * g);
    }
  }
  __syncthreads();
}

__device__ void gmlp_item(const Params& p, int l, size_t row0, int g, char* smem) {
  const int t = tid_op(), lane = t & 63, wave = t >> 6, fr = lane & 15, fq = lane >> 4;
  bf16_t* Ws = (bf16_t*)smem;
  bf16_t* VhT = Ws + 128 * 136;
  const float* ws = p.gm_ws + (size_t)(l * 4 + g) * 128 * 128;
#pragma unroll
  for (int i = 0; i < 16; i++) {
    int e = (i * NTHR + t) * 4;
    int pr = e >> 7, q = e & 127;
    float4 v = *(const float4*)(ws + e);
    *(uint2*)(Ws + pr * 136 + q) = make_uint2(pack2(v.x, v.y), pack2(v.z, v.w));
  }
  {
    const int q = t >> 1, half = t & 1;
    const bf16_t* zr = p.z + (row0 + q) * ZW + Z_GMV + g * 64 + half * 32;
    float v[32];
#pragma unroll
    for (int i = 0; i < 4; i++) { uint4 u = *(const uint4*)(zr + i * 8); unpack8(u, v + i * 8); }
    float sum = 0.f;
#pragma unroll
    for (int i = 0; i < 32; i++) { v[i] = gelu_(v[i]); sum += v[i]; }
    sum += dppf<0xB1>(sum);
    const float mu = sum * (1.f / 64.f);
    float vs = 0.f;
#pragma unroll
    for (int i = 0; i < 32; i++) { float dd = v[i] - mu; vs += dd * dd; }
    vs += dppf<0xB1>(vs);
    const float rs = rsqrtf(vs * (1.f / 64.f) + 1e-6f);
    const float* lg = p.gm_ln_g + (l * 4 + g) * 64 + half * 32;
    const float* lb = p.gm_ln_b + (l * 4 + g) * 64 + half * 32;
#pragma unroll
    for (int i = 0; i < 32; i++) VhT[(half * 32 + i) * 136 + q] = f2bf((v[i] - mu) * rs * lg[i] + lb[i]);
  }
  __syncthreads();
  f32x4 acc[2][4];
#pragma unroll
  for (int mt = 0; mt < 2; mt++)
#pragma unroll
    for (int nt = 0; nt < 4; nt++) acc[mt][nt] = f32x4{0.f, 0.f, 0.f, 0.f};
#pragma unroll
  for (int ks = 0; ks < 4; ks++) {
    bf16x8 af[2], bfr[4];
#pragma unroll
    for (int mt = 0; mt < 2; mt++) af[mt] = *(const bf16x8*)(Ws + (wave * 32 + mt * 16 + fr) * 136 + ks * 32 + fq * 8);
#pragma unroll
    for (int nt = 0; nt < 4; nt++) bfr[nt] = *(const bf16x8*)(VhT + (nt * 16 + fr) * 136 + ks * 32 + fq * 8);
#pragma unroll
    for (int mt = 0; mt < 2; mt++)
#pragma unroll
      for (int nt = 0; nt < 4; nt++) acc[mt][nt] = mfma16(bfr[nt], af[mt], acc[mt][nt]);
  }
#pragma unroll
  for (int mt = 0; mt < 2; mt++) {
    const int pr = wave * 32 + mt * 16 + fr;
    const float bs = p.gm_bs[(l * 4 + g) * 128 + pr];
    const bf16_t* zr = p.z + (row0 + pr) * ZW;
#pragma unroll
    for (int nt = 0; nt < 4; nt++) {
      const int c = nt * 16 + fq * 4;
      uint2 uu = *(const uint2*)(zr + Z_GMU + g * 64 + c);
      uint2 gg = *(const uint2*)(zr + Z_GMG + g * 64 + c);
      float o0 = gelu_(bflo(uu.x)) * (acc[mt][nt][0] + bs) * silu_(bflo(gg.x));
      float o1 = gelu_(bfhi(uu.x)) * (acc[mt][nt][1] + bs) * silu_(bfhi(gg.x));
      float o2 = gelu_(bflo(uu.y)) * (acc[mt][nt][2] + bs) * silu_(bflo(gg.y));
      float o3 = gelu_(bfhi(uu.y)) * (acc[mt][nt][3] + bs) * silu_(bfhi(gg.y));
      *(uint2*)(p.br + (row0 + pr) * 1024 + g * 64 + c) = make_uint2(pack2(o0, o1), pack2(o2, o3));
    }
  }
  __syncthreads();
}

__device__ void pool_item(const Params& p, int l, size_t seqrow0, int T, int t0, int g, char* smem) {
  const int t = tid_op(), lane = t & 63, wave = t >> 6, fr = lane & 15, fq = lane >> 4;
  float* Pp = (float*)smem;
  bf16_t* Dd = (bf16_t*)(Pp + 80 * 64);
  bf16_t* WT = Dd + 64 * 72;
  const int hw = 1 << g;
  for (int i = t; i < 80 * 8; i += NTHR) {
    int rr = i >> 3, oc = i & 7;
    int tok = t0 - 8 + rr;
    float f[8];
    if (tok >= 0 && tok < T) { uint4 u = *(const uint4*)(p.z + (seqrow0 + tok) * ZW + Z_PLP + g * 64 + oc * 8); unpack8(u, f); }
    else {
#pragma unroll
      for (int k = 0; k < 8; k++) f[k] = 0.f;
    }
#pragma unroll
    for (int k = 0; k < 8; k++) Pp[rr * 64 + oc * 8 + k] = f[k];
  }
  {
    const float* w = p.pl_w + (size_t)(l * 4 + g) * 64 * 64;
#pragma unroll
    for (int i = 0; i < 16; i++) {
      int e = i * NTHR + t;
      int c = e >> 6, dd = e & 63;
      WT[dd * 72 + c] = f2bf(w[e]);
    }
  }
  __syncthreads();
  {
    const int c = t & 63, tq = t >> 6;
    for (int i = 0; i < 16; i++) {
      const int tl = tq * 16 + i;
      const int tok = t0 + tl;
      const int lo = max(tok - hw, 0), hi = min(tok + hw, T);
      float s = 0.f;
      for (int u = lo; u < hi; u++) s += Pp[(u - t0 + 8) * 64 + c];
      float dv = s / (float)(hi - lo) - Pp[(tl + 8) * 64 + c];
      Dd[tl * 72 + c] = f2bf(dv);
    }
  }
  __syncthreads();
  f32x4 acc[4];
#pragma unroll
  for (int nt = 0; nt < 4; nt++) acc[nt] = f32x4{0.f, 0.f, 0.f, 0.f};
#pragma unroll
  for (int ks = 0; ks < 2; ks++) {
    bf16x8 af = *(const bf16x8*)(Dd + (wave * 16 + fr) * 72 + ks * 32 + fq * 8);
#pragma unroll
    for (int nt = 0; nt < 4; nt++) {
      bf16x8 bw = *(const bf16x8*)(WT + (nt * 16 + fr) * 72 + ks * 32 + fq * 8);
      acc[nt] = mfma16(bw, af, acc[nt]);
    }
  }
  {
    const size_t row = seqrow0 + t0 + wave * 16 + fr;
#pragma unroll
    for (int nt = 0; nt < 4; nt++) {
      const int dd = g * 64 + nt * 16 + fq * 4;
      float4 sc = *(const float4*)(p.pl_scale + l * 256 + dd);
      uint2 gg = *(const uint2*)(p.z + row * ZW + Z_PLG + dd);
      float o0 = acc[nt][0] * sc.x * silu_(bflo(gg.x));
      float o1 = acc[nt][1] * sc.y * silu_(bfhi(gg.x));
      float o2 = acc[nt][2] * sc.z * silu_(bflo(gg.y));
      float o3 = acc[nt][3] * sc.w * silu_(bfhi(gg.y));
      *(uint2*)(p.br + row * 1024 + 768 + dd) = make_uint2(pack2(o0, o1), pack2(o2, o3));
    }
  }
  __syncthreads();
}


constexpr unsigned ROLE_IDLE = 0xFFFF0001u, ROLE_WORK = 0x10000u;
__device__ void publish_cu(const Params& p) {
  if (threadIdx.x == 0 && gridDim.x == 512) {
    unsigned hw = __builtin_amdgcn_s_getreg(63492);
    unsigned xcc = __builtin_amdgcn_s_getreg(63508);
    p.cuinfo[blockIdx.x] = ((xcc & 0xfu) << 16) | (hw & 0xff00u);
  }
}
__device__ void compute_roles(const Params& p, char* smem) {
  const int t = tid_op();
  if (gridDim.x != 512) { if (t == 0) p.cuinfo[1024] = 1u; return; }
  unsigned* keys = (unsigned*)smem;
  unsigned* mate = keys + 512;
  unsigned* prim = mate + 512;
  for (int i = t; i < 512; i += NTHR) keys[i] = p.cuinfo[i];
  __syncthreads();
  int bad = 0;
  for (int i = t; i < 512; i += NTHR) {
    int cnt = 0, m = 0;
    for (int j = 0; j < 512; j++) if (j != i && keys[j] == keys[i]) { cnt++; m = j; }
    if (cnt != 1) bad = 1;
    mate[i] = (unsigned)m;
    prim[i] = (cnt == 1 && i < m) ? 1u : 0u;
  }
  bad = __syncthreads_or(bad);
  for (int i = t; i < 512; i += NTHR) {
    const int pi = prim[i] ? i : (int)mate[i];
    int rank = 0;
    for (int j = 0; j < pi; j++) rank += (int)prim[j];
    unsigned role;
    if (rank < 128) role = prim[i] ? (unsigned)rank : ROLE_IDLE;
    else role = ROLE_WORK + (unsigned)((rank - 128) * 2 + (prim[i] ? 0 : 1));
    p.cuinfo[512 + i] = role;
  }
  if (t == 0) p.cuinfo[1024] = bad ? 1u : 0u;
  __syncthreads();
}

__device__ void worker_barrier(unsigned* cnt, unsigned target) {
  asm volatile("s_waitcnt vmcnt(0)" ::: "memory");
  __syncthreads();
  if (threadIdx.x == 0) {
    __builtin_amdgcn_fence(__ATOMIC_RELEASE, "agent");
    atomicAdd(cnt, 1u);
    while (__hip_atomic_load(cnt, __ATOMIC_RELAXED, __HIP_MEMORY_SCOPE_AGENT) < target) __builtin_amdgcn_s_sleep(2);
    __builtin_amdgcn_fence(__ATOMIC_ACQUIRE, "agent");
    asm volatile("s_waitcnt vmcnt(0)" ::: "memory");
  }
  __syncthreads();
}
__device__ void phase_mix(const Params& p, int l, char* smem, int cslot) {
  __shared__ unsigned s_item;
  if (!(cslot & 4)) for (int it = blockIdx.x; it < 128; it += gridDim.x) scan_item(p, l, it, smem);
  cslot &= 3;
  const int n_na = 2048, n_ca = (l == 0 ? 128 : 0), n_gm = 1024, n_gc = (l == 0 ? 64 : 0), n_pl = 2048, n_pc = (l == 0 ? 128 : 0);
  const int total = n_na + n_ca + n_gm + n_gc + n_pl + n_pc;
  while (true) {
    if (threadIdx.x == 0) s_item = atomicAdd(p.ctr + cslot, 1u);
    __syncthreads();
    int it = (int)s_item;
    __syncthreads();
    if (it >= total) break;
    if (it < n_na) {
      int r = it & 63, h = (it >> 6) & 3, b = it >> 8;
      natten_item(p, l, b, h, (size_t)b * SEQ + r * 64, 8, r, smem);
      continue;
    }
    it -= n_na;
    if (it < n_ca) {
      int qt = it & 3, h = (it >> 2) & 3, b = it >> 4;
      natten_item(p, l, b, h, (size_t)NLAT + b * CTXL + qt * 64, 0, 0, smem);
      continue;
    }
    it -= n_ca;
    if (it < n_gm) {
      int g = it & 3, ch = (it >> 2) & 31, b = it >> 7;
      gmlp_item(p, l, (size_t)b * SEQ + ch * 128, g, smem);
      continue;
    }
    it -= n_gm;
    if (it < n_gc) {
      int g = it & 3, ch = (it >> 2) & 1, b = it >> 3;
      gmlp_item(p, l, (size_t)NLAT + b * CTXL + ch * 128, g, smem);
      continue;
    }
    it -= n_gc;
    if (it < n_pl) {
      int g = it & 3, tl = (it >> 2) & 63, b = it >> 8;
      pool_item(p, l, (size_t)b * SEQ, SEQ, tl * 64, g, smem);
      continue;
    }
    it -= n_pl;
    {
      int g = it & 3, tl = (it >> 2) & 3, b = it >> 4;
      pool_item(p, l, (size_t)NLAT + b * CTXL, CTXL, tl * 64, g, smem);
    }
  }
}

__device__ void phase_rwfin(const Params& p, int l) {
  const int t_ = tid_op();
  const int lane = t_ & 63;
  const int gw = blockIdx.x * 4 + (t_ >> 6), nw = gridDim.x * 4;
  const int nrow = (l == 0 ? NTOK : NLAT);
  const int hh = lane >> 4, c0 = lane * 4;
  float4 gg = *(const float4*)(p.rw_gn_g + l * 256 + c0);
  float4 gb = *(const float4*)(p.rw_gn_b + l * 256 + c0);
  for (int r = gw; r < nrow; r += nw) {
    float4 y0 = *(const float4*)(p.yscan + (size_t)r * 256 + c0);
    float4 y1 = *(const float4*)(p.yscan + ((size_t)NTOK + r) * 256 + c0);
    float o0 = y0.x + y1.x, o1 = y0.y + y1.y, o2 = y0.z + y1.z, o3 = y0.w + y1.w;
    float mu = red16_sum(o0 + o1 + o2 + o3) * (1.f / 64.f);
    float d0 = o0 - mu, d1 = o1 - mu, d2 = o2 - mu, d3 = o3 - mu;
    float var = red16_sum(d0 * d0 + d1 * d1 + d2 * d2 + d3 * d3) * (1.f / 64.f);
    float rs = rsqrtf(var + 64e-5f);
    float cf = p.coef[(size_t)r * 4 + hh] + p.coef[((size_t)NTOK + r) * 4 + hh];
    uint2 vm = *(const uint2*)(p.vmix + (size_t)r * 256 + c0);
    uint2 zg = *(const uint2*)(p.z + (size_t)r * ZW + Z_RWG + c0);
    float r0 = (d0 * rs * gg.x + gb.x + cf * bflo(vm.x)) * silu_(bflo(zg.x));
    float r1 = (d1 * rs * gg.y + gb.y + cf * bfhi(vm.x)) * silu_(bfhi(zg.x));
    float r2 = (d2 * rs * gg.z + gb.z + cf * bflo(vm.y)) * silu_(bflo(zg.y));
    float r3 = (d3 * rs * gg.w + gb.w + cf * bfhi(vm.y)) * silu_(bfhi(zg.y));
    *(uint2*)(p.br + (size_t)r * 1024 + 512 + c0) = make_uint2(pack2(r0, r1), pack2(r2, r3));
  }
}

__device__ __forceinline__ void gsync(cg::grid_group& grid) {
  asm volatile("s_waitcnt vmcnt(0)" ::: "memory");
  grid.sync();
}

#define XB_XCNT(j) (64 * (j))
#define XB_XSUB(j) (1024 + 64 * (j))
#define XB_XGEN(j) (2048 + 64 * (j))
#define XB_TOP 3072
#define XB_TOPGEN 3136
constexpr int XB_WORDS = 3200;
__device__ __forceinline__ unsigned xb_ld(unsigned* q) { return __hip_atomic_load(q, __ATOMIC_RELAXED, __HIP_MEMORY_SCOPE_AGENT); }
__device__ __forceinline__ unsigned xb_add(unsigned* q, unsigned v) { return __hip_atomic_fetch_add(q, v, __ATOMIC_RELAXED, __HIP_MEMORY_SCOPE_AGENT); }
#define XB_SPIN(cond) do { unsigned _sp = 0; while (cond) { __builtin_amdgcn_s_sleep(1); if (++_sp > (1u << 24)) break; } } while (0)
__device__ __forceinline__ void xsync(unsigned* bar, volatile unsigned* st) {
  asm volatile("s_waitcnt vmcnt(0)" ::: "memory");
  __syncthreads();
  if (threadIdx.x == 0) {
    __builtin_amdgcn_s_waitcnt(0);
    const unsigned nloc = st[0], nx = st[1], x = st[2];
    const unsigned old = xb_add(&bar[XB_XSUB(x)], 1u);
    const unsigned gen = old / nloc;
    if (old + 1u == (gen + 1u) * nloc) {
      __builtin_amdgcn_fence(__ATOMIC_RELEASE, "agent");
      asm volatile("s_waitcnt vmcnt(0)" ::: "memory");
      const unsigned og = xb_add(&bar[XB_TOP], 1u);
      const unsigned tg = og / nx;
      if (og + 1u == (tg + 1u) * nx) xb_add(&bar[XB_TOPGEN], 1u);
      else XB_SPIN(xb_ld(&bar[XB_TOPGEN]) == tg);
      __builtin_amdgcn_fence(__ATOMIC_ACQUIRE, "agent");
      xb_add(&bar[XB_XGEN(x)], 1u);
      asm volatile("s_waitcnt vmcnt(0)" ::: "memory");
    } else {
      XB_SPIN(xb_ld(&bar[XB_XGEN(x)]) == gen);
      __builtin_amdgcn_fence(__ATOMIC_ACQUIRE, "agent");
      asm volatile("s_waitcnt vmcnt(0)" ::: "memory");
    }
  }
  __syncthreads();
}
__global__ void __launch_bounds__(NTHR, 2) hybrid_mega(Params p) {
  extern __shared__ __attribute__((aligned(16))) char smem[];
  cg::grid_group grid = cg::this_grid();
  __shared__ unsigned xb_st[4];
  const unsigned my_xcc = (unsigned)__builtin_amdgcn_s_getreg((3 << 11) | 20) & 0xFu;
  if (threadIdx.x == 0) (void)xb_add(&p.xbar[XB_XCNT(my_xcc)], 1u);
  publish_cu(p);
  phase0(p, smem);
  if (p.xbar == nullptr) gsync(grid);
  if (threadIdx.x == 0) {
    unsigned mine = 0, cnt = 0, sum = 0, sp = 0;
    for (;;) {
      mine = 0; cnt = 0; sum = 0;
      for (unsigned j = 0; j < 16; j++) { const unsigned c = xb_ld(&p.xbar[XB_XCNT(j)]); sum += c; cnt += c > 0u ? 1u : 0u; mine = j == my_xcc ? c : mine; }
      if (sum == gridDim.x || ++sp > (1u << 22)) break;
      __builtin_amdgcn_s_sleep(1);
    }
    xb_st[0] = mine > 0u ? mine : 1u; xb_st[1] = cnt > 0u ? cnt : 1u; xb_st[2] = my_xcc;
  }
  __syncthreads();
  xsync(p.xbar, xb_st);
  if (blockIdx.x == 0) compute_roles(p, smem);
#pragma unroll 1
  for (int l = 0; l < 2; l++) {
    phase_norm(p, l, l == 0 ? p.x : p.out, l == 0 ? p.ctx : p.ctx1);
    xsync(p.xbar, xb_st);
    const bool overlap = (gridDim.x == 512) && (p.cuinfo[1024] == 0u);
    phase_g1(p, l, smem, overlap ? 1 : 0, -1, 0);
    xsync(p.xbar, xb_st);
    {
      if (overlap) {
        const unsigned role = p.cuinfo[512 + blockIdx.x];
        if (role < 128u) scan_item(p, l, (int)role, smem);
        else if (role >= ROLE_WORK && role < ROLE_WORK + 256u) {
          phase_g1(p, l, smem, 2, (int)(role - ROLE_WORK), 256);
          worker_barrier(p.ctr + 4 + l, 256u);
          phase_mix(p, l, smem, l | 4);
        }
      } else {
        for (int it = blockIdx.x; it < 128; it += gridDim.x) scan_item(p, l, it, smem);
      }
      xsync(p.xbar, xb_st);
      if (!overlap) phase_mix(p, l, smem, l | 4);
      phase_rwfin(p, l);
      xsync(p.xbar, xb_st);
    }
    phase_g2(p, l, smem);
    xsync(p.xbar, xb_st);
    if (DUP_MASK & 2) { phase_g2(p, l, smem); xsync(p.xbar, xb_st); }
    phase_g3(p, l, smem);
    xsync(p.xbar, xb_st);
    if ((DUP_MASK & 8) && l == 0) { phase_g3(p, l, smem); xsync(p.xbar, xb_st); }
  }
  phase_final(p);
}

extern "C" void kernel_launch(void* const* d_in, const int* in_sizes, int n_in, void* d_out, int out_size, void* d_ws,
                              size_t ws_size, hipStream_t stream) {
  static int grid_blocks = 0;
  if (!grid_blocks) {
    int dev = 0, cus = 0, per_cu = 0;
    hipGetDevice(&dev);
    hipDeviceGetAttribute(&cus, hipDeviceAttributeMultiprocessorCount, dev);
    hipFuncSetAttribute((const void*)hybrid_mega, hipFuncAttributeMaxDynamicSharedMemorySize, LDS_BYTES);
    hipOccupancyMaxActiveBlocksPerMultiprocessor(&per_cu, hybrid_mega, NTHR, LDS_BYTES);
    if (per_cu > 2) per_cu = 2;
    if (per_cu < 1) per_cu = 1;
    grid_blocks = cus * per_cu;
  }
  Params p{};
  const float* const* in = (const float* const*)d_in;
  p.x = in[0]; p.c = in[1]; p.ctx = in[2]; p.c_ctx = in[3]; p.ada_w = in[4]; p.ada_b = in[5]; p.norm_g = in[6]; p.w_in = in[7];
  p.gm_ln_g = in[8]; p.gm_ln_b = in[9]; p.gm_ws = in[10]; p.gm_bs = in[11]; p.na_rpb = in[12]; p.rw_mu = in[13]; p.rw_w0 = in[14];
  p.rw_w2 = in[15]; p.rw_a0 = in[16]; p.rw_a2 = in[17]; p.rw_kk = in[18]; p.rw_ka = in[19]; p.rw_rk = in[20]; p.rw_gn_g = in[21];
  p.rw_gn_b = in[22]; p.pl_w = in[23]; p.pl_scale = in[24]; p.w_br = in[25]; p.w_out = in[26]; p.final_g = in[27];
  p.out = (float*)d_out;
  char* w = (char*)d_ws;
  size_t off = 0;
  auto take = [&](size_t bytes) { char* r = w + off; off += (bytes + 255) & ~(size_t)255; return r; };
  p.ctr = (unsigned*)take(256);
  p.cuinfo = (unsigned*)take(8192);
  p.xbar = (unsigned*)take(XB_WORDS * 4);
  p.mod = (float*)take((size_t)2 * 9 * 3072 * 4);
  p.WtIn = (bf16_t*)take((size_t)2 * INC * 1024 * 2);
  p.WtBr = (bf16_t*)take((size_t)2 * 4 * 1024 * 256 * 2);
  p.WtOut = (bf16_t*)take((size_t)2 * 1024 * 1024 * 2);
  p.h = (bf16_t*)take((size_t)NTOK * 1024 * 2);
  p.z = (bf16_t*)take((size_t)NTOK * ZW * 2);
  p.zvT = (bf16_t*)take((size_t)NB * 256 * SEQ * 2);
  p.zvTc = (bf16_t*)take((size_t)NB * 256 * CTXL * 2);
  p.br = (bf16_t*)take((size_t)NTOK * 1024 * 2);
  p.yscan = (float*)take((size_t)2 * NTOK * 256 * 4);
  p.vmix = (bf16_t*)take((size_t)NTOK * 256 * 2);
  p.coef = (float*)take((size_t)2 * NTOK * 4 * 4);
  p.ctx1 = (float*)take((size_t)NCTX * 1024 * 4);
  if (off > ws_size) fprintf(stderr, "workspace too small: need %zu have %zu\n", off, ws_size);
  hipMemsetAsync(p.xbar, 0, XB_WORDS * 4, stream);
  void* args[] = {&p};
  hipError_t e = hipLaunchCooperativeKernel((const void*)hybrid_mega, dim3(grid_blocks), dim3(NTHR), args, LDS_BYTES, stream);
  if (e != hipSuccess) fprintf(stderr, "cooperative launch failed: %s (grid %d)\n", hipGetErrorString(e), grid_blocks);
}
```

```cpp
#include <hip/hip_runtime.h>
#include <hip/hip_cooperative_groups.h>
#include <cstdio>
namespace cg = cooperative_groups;

typedef unsigned short bf16_t;
using bf16x8 = __attribute__((ext_vector_type(8))) short;
using f32x4 = __attribute__((ext_vector_type(4))) float;

constexpr int D = 1024;
constexpr int NB = 8;
constexpr int SEQ = 4096;
constexpr int CTXL = 256;
constexpr int NLAT = NB * SEQ;
constexpr int NCTX = NB * CTXL;
constexpr int NTOK = NLAT + NCTX;
constexpr int INC = 7552;
constexpr int ZW = 3200;
constexpr int Z_GMU = 0, Z_GMV = 256, Z_GMG = 512, Z_NAQ = 768, Z_NAK = 1024, Z_NAG = 1280;
constexpr int Z_RWR = 1536, Z_RWK = 1792, Z_RWV = 2048, Z_RWW = 2304, Z_RWA = 2368, Z_RWG = 2432, Z_PLP = 2688, Z_PLG = 2944;
constexpr int LDS_BYTES = 73728;
constexpr int NTHR = 256;
#ifndef DUP_MASK
#define DUP_MASK 0
#endif

struct Params {
  const float *x, *c, *ctx, *c_ctx, *ada_w, *ada_b, *norm_g, *w_in, *gm_ln_g, *gm_ln_b, *gm_ws, *gm_bs, *na_rpb,
      *rw_mu, *rw_w0, *rw_w2, *rw_a0, *rw_a2, *rw_kk, *rw_ka, *rw_rk, *rw_gn_g, *rw_gn_b, *pl_w, *pl_scale, *w_br, *w_out, *final_g;
  float* out;
  bf16_t *WtIn, *WtBr, *WtOut, *h, *z, *zvT, *zvTc, *br, *vmix;
  float *mod, *yscan, *coef, *ctx1;
  unsigned* ctr;
  unsigned* xbar;
  unsigned* cuinfo;
};

__device__ __forceinline__ bf16_t f2bf(float f) {
  unsigned u = __float_as_uint(f);
  u += 0x7fffu + ((u >> 16) & 1u);
  return (bf16_t)(u >> 16);
}
__device__ __forceinline__ float bf2f(unsigned v) { return __uint_as_float(v << 16); }
__device__ __forceinline__ unsigned pack2(float a, float b) { return (unsigned)f2bf(a) | ((unsigned)f2bf(b) << 16); }
__device__ __forceinline__ float bflo(unsigned w) { return __uint_as_float(w << 16); }
__device__ __forceinline__ float bfhi(unsigned w) { return __uint_as_float(w & 0xffff0000u); }
__device__ __forceinline__ float frcp(float x) { return __builtin_amdgcn_rcpf(x); }
__device__ __forceinline__ float sigm(float x) { return frcp(1.f + __expf(-x)); }
__device__ __forceinline__ float silu_(float x) { return x * frcp(1.f + __expf(-x)); }
__device__ __forceinline__ float gelu_(float x) {
  float u = 1.5957691216f * (x + 0.044715f * x * x * x);
  return x * frcp(1.f + __expf(-u));
}
template <int CTRL>
__device__ __forceinline__ float dppf(float v) {
  return __int_as_float(__builtin_amdgcn_update_dpp(0, __float_as_int(v), CTRL, 0xf, 0xf, false));
}
__device__ __forceinline__ float red16_sum(float v) {
  v += dppf<0xB1>(v); v += dppf<0x4E>(v); v += dppf<0x141>(v); v += dppf<0x140>(v); return v;
}
__device__ __forceinline__ void red16_sum2(float& a, float& b) {
  a += dppf<0xB1>(a); asm volatile("" : "+v"(a));
  b += dppf<0xB1>(b); asm volatile("" : "+v"(b));
  a += dppf<0x4E>(a); asm volatile("" : "+v"(a));
  b += dppf<0x4E>(b); asm volatile("" : "+v"(b));
  a += dppf<0x141>(a); asm volatile("" : "+v"(a));
  b += dppf<0x141>(b); asm volatile("" : "+v"(b));
  a += dppf<0x140>(a); asm volatile("" : "+v"(a));
  b += dppf<0x140>(b); asm volatile("" : "+v"(b));
}
__device__ __forceinline__ float red16_max(float v) {
  v = fmaxf(v, dppf<0xB1>(v)); v = fmaxf(v, dppf<0x4E>(v)); v = fmaxf(v, dppf<0x141>(v)); v = fmaxf(v, dppf<0x140>(v)); return v;
}
__device__ __forceinline__ float red8_sum(float v) {
  v += dppf<0xB1>(v); v += dppf<0x4E>(v); v += dppf<0x141>(v); return v;
}
__device__ __forceinline__ float wave_sum(float v) {
#pragma unroll
  for (int o = 32; o > 0; o >>= 1) v += __shfl_xor(v, o);
  return v;
}
__device__ __forceinline__ int tid_op() {
  int t = threadIdx.x;
  asm volatile("" : "+v"(t));
  return t;
}
__device__ __forceinline__ void lds_barrier() {
  asm volatile("s_waitcnt lgkmcnt(0)" ::: "memory");
  __builtin_amdgcn_s_barrier();
  asm volatile("" ::: "memory");
}
__device__ __forceinline__ f32x4 mfma16(bf16x8 a, bf16x8 b, f32x4 c) {
  return __builtin_amdgcn_mfma_f32_16x16x32_bf16(a, b, c, 0, 0, 0);
}
__device__ __forceinline__ void unpack8(uint4 v, float* f) {
  f[0] = bflo(v.x); f[1] = bfhi(v.x); f[2] = bflo(v.y); f[3] = bfhi(v.y);
  f[4] = bflo(v.z); f[5] = bfhi(v.z); f[6] = bflo(v.w); f[7] = bfhi(v.w);
}

__device__ void transpose_tile(const float* __restrict__ src, int N, bf16_t* __restrict__ dst, int K, int k0, int n0, float* tile) {
  const int t = tid_op();
  const int r = t >> 4, c4 = (t & 15) * 4;
#pragma unroll
  for (int i = 0; i < 4; i++) {
    int k = r + 16 * i;
    float4 v = *(const float4*)(src + (size_t)(k0 + k) * N + n0 + c4);
    tile[k * 65 + c4 + 0] = v.x; tile[k * 65 + c4 + 1] = v.y; tile[k * 65 + c4 + 2] = v.z; tile[k * 65 + c4 + 3] = v.w;
  }
  __syncthreads();
  const int n = t >> 2, ks = (t & 3) * 16;
  unsigned pk[8];
#pragma unroll
  for (int i = 0; i < 8; i++) pk[i] = pack2(tile[(ks + 2 * i) * 65 + n], tile[(ks + 2 * i + 1) * 65 + n]);
  uint4* dp = (uint4*)(dst + (size_t)(n0 + n) * K + k0 + ks);
  dp[0] = make_uint4(pk[0], pk[1], pk[2], pk[3]);
  dp[1] = make_uint4(pk[4], pk[5], pk[6], pk[7]);
  __syncthreads();
}

__device__ void mod_item(const Params& p, int l, int jc, char* smem) {
  float* sil = (float*)smem;
  float* red = sil + 9 * 1024;
  const int t = tid_op();
  for (int i = t; i < 9 * 1024; i += NTHR) {
    int r = i >> 10, k = i & 1023;
    float v = r < 8 ? p.c[r * 1024 + k] : p.c_ctx[k];
    sil[i] = silu_(v);
  }
  __syncthreads();
  const int col = t & 63, q = t >> 6;
  float acc[9];
#pragma unroll
  for (int r = 0; r < 9; r++) acc[r] = 0.f;
  const float* w = p.ada_w + (size_t)l * 1024 * 3072 + jc * 64 + col;
  for (int k = q * 256; k < q * 256 + 256; k++) {
    float wv = w[(size_t)k * 3072];
#pragma unroll
    for (int r = 0; r < 9; r++) acc[r] += sil[r * 1024 + k] * wv;
  }
#pragma unroll
  for (int r = 0; r < 9; r++) red[(q * 9 + r) * 64 + col] = acc[r];
  __syncthreads();
  if (t < 64) {
    float bb = p.ada_b[l * 3072 + jc * 64 + t];
#pragma unroll
    for (int r = 0; r < 9; r++) {
      float s = red[(0 * 9 + r) * 64 + t] + red[(1 * 9 + r) * 64 + t] + red[(2 * 9 + r) * 64 + t] + red[(3 * 9 + r) * 64 + t];
      p.mod[(l * 9 + r) * 3072 + jc * 64 + t] = s + bb;
    }
  }
  __syncthreads();
}

__device__ void phase0(const Params& p, char* smem) {
  if (blockIdx.x == 0 && threadIdx.x < 8) p.ctr[threadIdx.x] = 0u;
  constexpr int PER_L = 2400 + 48;
  for (int it = blockIdx.x; it < 2 * PER_L; it += gridDim.x) {
    int l = it / PER_L, r = it % PER_L;
    if (r < 1888) {
      int kt = r & 15, nt = r >> 4;
      transpose_tile(p.w_in + (size_t)l * 1024 * INC, INC, p.WtIn + (size_t)l * INC * 1024, 1024, kt * 64, nt * 64, (float*)smem);
    } else if (r < 2144) {
      int q = r - 1888; int i = q >> 6; int kt = q & 3, nt = (q >> 2) & 15;
      transpose_tile(p.w_br + ((size_t)l * 4 + i) * 256 * 1024, 1024, p.WtBr + ((size_t)l * 4 + i) * 1024 * 256, 256, kt * 64, nt * 64, (float*)smem);
    } else if (r < 2400) {
      int q = r - 2144; int kt = q & 15, nt = q >> 4;
      transpose_tile(p.w_out + (size_t)l * 1024 * 1024, 1024, p.WtOut + (size_t)l * 1024 * 1024, 1024, kt * 64, nt * 64, (float*)smem);
    } else {
      mod_item(p, l, r - 2400, smem);
    }
  }
}

__device__ void phase_norm(const Params& p, int l, const float* xsrc, const float* csrc) {
  const int t_ = tid_op();
  const int lane = t_ & 63;
  const int gw = blockIdx.x * 4 + (t_ >> 6), nw = gridDim.x * 4;
  const float* g = p.norm_g + l * 1024;
  for (int r = gw; r < NTOK; r += nw) {
    const float* src; int mb;
    if (r < NLAT) { src = xsrc + (size_t)r * 1024; mb = r >> 12; } else { src = csrc + (size_t)(r - NLAT) * 1024; mb = 8; }
    const float* md = p.mod + (l * 9 + mb) * 3072;
    float4 v[4]; float ss = 0.f;
#pragma unroll
    for (int i = 0; i < 4; i++) {
      v[i] = *(const float4*)(src + lane * 4 + 256 * i);
      ss += v[i].x * v[i].x + v[i].y * v[i].y + v[i].z * v[i].z + v[i].w * v[i].w;
    }
    ss = wave_sum(ss);
    float rs = rsqrtf(ss * (1.f / 1024.f) + 1e-6f);
#pragma unroll
    for (int i = 0; i < 4; i++) {
      int col = lane * 4 + 256 * i;
      float4 gg = *(const float4*)(g + col);
      float4 sh = *(const float4*)(md + col);
      float4 sc = *(const float4*)(md + 1024 + col);
      float a0 = v[i].x * rs * gg.x * (1.f + sc.x) + sh.x;
      float a1 = v[i].y * rs * gg.y * (1.f + sc.y) + sh.y;
      float a2 = v[i].z * rs * gg.z * (1.f + sc.z) + sh.z;
      float a3 = v[i].w * rs * gg.w * (1.f + sc.w) + sh.w;
      *(uint2*)(p.h + (size_t)r * 1024 + col) = make_uint2(pack2(a0, a1), pack2(a2, a3));
    }
  }
}

__device__ void phase_final(const Params& p) {
  const int t_ = tid_op();
  const int lane = t_ & 63;
  const int gw = blockIdx.x * 4 + (t_ >> 6), nw = gridDim.x * 4;
  for (int r = gw; r < NLAT; r += nw) {
    float* src = p.out + (size_t)r * 1024;
    float4 v[4]; float ss = 0.f;
#pragma unroll
    for (int i = 0; i < 4; i++) {
      v[i] = *(const float4*)(src + lane * 4 + 256 * i);
      ss += v[i].x * v[i].x + v[i].y * v[i].y + v[i].z * v[i].z + v[i].w * v[i].w;
    }
    ss = wave_sum(ss);
    float rs = rsqrtf(ss * (1.f / 1024.f) + 1e-6f);
#pragma unroll
    for (int i = 0; i < 4; i++) {
      int col = lane * 4 + 256 * i;
      float4 gg = *(const float4*)(p.final_g + col);
      float4 o = make_float4(v[i].x * rs * gg.x, v[i].y * rs * gg.y, v[i].z * rs * gg.z, v[i].w * rs * gg.w);
      *(float4*)(src + col) = o;
    }
  }
}

template <int NT, bool SWAP>
__device__ __forceinline__ void gemm_compute(const bf16_t* a_s, const bf16_t* b_s, int o0, f32x4 (&acc)[4][NT]) {
#pragma unroll
  for (int ks = 0; ks < 2; ks++) {
    const int off = ks == 0 ? o0 : (o0 ^ 32);
    bf16x8 af[4], bfr[NT];
#pragma unroll
    for (int mt = 0; mt < 4; mt++) af[mt] = *(const bf16x8*)(a_s + mt * 16 * 64 + off);
#pragma unroll
    for (int nt = 0; nt < NT; nt++) bfr[nt] = *(const bf16x8*)(b_s + nt * 16 * 64 + off);
#pragma unroll
    for (int mt = 0; mt < 4; mt++)
#pragma unroll
      for (int nt = 0; nt < NT; nt++)
        acc[mt][nt] = SWAP ? mfma16(bfr[nt], af[mt], acc[mt][nt]) : mfma16(af[mt], bfr[nt], acc[mt][nt]);
  }
}

template <int NT, bool SWAP, int DEEP = 2>
__device__ __forceinline__ void gemm_mainloop(const bf16_t* __restrict__ A, int lda, const bf16_t* __restrict__ Bm, int ldb,
                                              int nk, f32x4 (&acc)[4][NT], bf16_t* sm) {
  constexpr int ASZ = 128 * 64, BSZ = NT * 32 * 64;
  bf16_t* sA = sm;
  bf16_t* sB = sm + 2 * ASZ;
  const int t = tid_op(), lane = t & 63, wave = t >> 6, wm = wave >> 1, wn = wave & 1;
  const int lr = t >> 3, lc = (t & 7) * 8;
  const int lcs = ((t & 7) ^ ((lr >> 1) & 7)) * 8;
  const int fr = lane & 15, fq = lane >> 4;
  uint4 p0a0, p0a1, p0a2, p0a3, p0b0, p0b1, p0b2, p0b3;
  uint4 p1a0, p1a1, p1a2, p1a3, p1b0, p1b1, p1b2, p1b3;
  p0b2 = p0b3 = p1b2 = p1b3 = make_uint4(0, 0, 0, 0);
  const bf16_t* Ap = A + (size_t)lr * lda + lc;
  const bf16_t* Bp = Bm + (size_t)lr * ldb + lc;
#define GLD(P, R, I, KT) *(const uint4*)(P + (size_t)(32 * I) * R + (KT) * 64)
#define GLOAD(S, KT)                                                         \
  {                                                                          \
    S##a0 = GLD(Ap, lda, 0, KT); S##a1 = GLD(Ap, lda, 1, KT);                \
    S##a2 = GLD(Ap, lda, 2, KT); S##a3 = GLD(Ap, lda, 3, KT);                \
    S##b0 = GLD(Bp, ldb, 0, KT); S##b1 = GLD(Bp, ldb, 1, KT);                \
    if constexpr (NT == 4) { S##b2 = GLD(Bp, ldb, 2, KT); S##b3 = GLD(Bp, ldb, 3, KT); } \
  }
#define SST(BASE, I) *(uint4*)(BASE + (lr + 32 * I) * 64 + lcs)
#define SWRITE(S, BUF)                                                       \
  {                                                                          \
    SST(sA + (BUF) * ASZ, 0) = S##a0; SST(sA + (BUF) * ASZ, 1) = S##a1;      \
    SST(sA + (BUF) * ASZ, 2) = S##a2; SST(sA + (BUF) * ASZ, 3) = S##a3;      \
    SST(sB + (BUF) * BSZ, 0) = S##b0; SST(sB + (BUF) * BSZ, 1) = S##b1;      \
    if constexpr (NT == 4) { SST(sB + (BUF) * BSZ, 2) = S##b2; SST(sB + (BUF) * BSZ, 3) = S##b3; } \
  }
  const bf16_t* a_s0 = sA + (wm * 64 + fr) * 64;
  const bf16_t* b_s0 = sB + (wn * (NT * 16) + fr) * 64;
  const int o0 = (fq ^ ((fr >> 1) & 7)) * 8;
  if (DEEP == 2) {
    GLOAD(p0, 0);
    GLOAD(p1, 1);
    SWRITE(p0, 0);
    __syncthreads();
#pragma unroll 1
    for (int kt = 0; kt < nk; kt += 2) {
      const bool m2 = kt + 2 < nk;
      if (m2) GLOAD(p0, kt + 2);
      gemm_compute<NT, SWAP>(a_s0, b_s0, o0, acc);
      SWRITE(p1, 1);
      __syncthreads();
      if (m2) GLOAD(p1, kt + 3);
      gemm_compute<NT, SWAP>(a_s0 + ASZ, b_s0 + BSZ, o0, acc);
      if (m2) SWRITE(p0, 0);
      __syncthreads();
    }
  } else {
    GLOAD(p0, 0);
    SWRITE(p0, 0);
    __syncthreads();
#pragma unroll 1
    for (int kt = 0; kt < nk; kt += 2) {
      const bool m2 = kt + 2 < nk;
      GLOAD(p0, kt + 1);
      gemm_compute<NT, SWAP>(a_s0, b_s0, o0, acc);
      SWRITE(p0, 1);
      __syncthreads();
      if (m2) GLOAD(p0, kt + 2);
      gemm_compute<NT, SWAP>(a_s0 + ASZ, b_s0 + BSZ, o0, acc);
      if (m2) SWRITE(p0, 0);
      __syncthreads();
    }
  }
#undef GLOAD
#undef SWRITE
#undef GLD
#undef SST
}

template <int NT>
__device__ __forceinline__ void zero_acc(f32x4 (&acc)[4][NT]) {
#pragma unroll
  for (int i = 0; i < 4; i++)
#pragma unroll
    for (int j = 0; j < NT; j++) acc[i][j] = f32x4{0.f, 0.f, 0.f, 0.f};
}

struct TileIter {
  int total, TN, per_x, base, lim, nslot, slot;
  __device__ __forceinline__ void init(int TM, int TN_, int vb = -1, int nvb = 0) {
    TN = TN_; total = TM * TN_;
    const int nx = 8;
    if (vb < 0) { vb = blockIdx.x; nvb = gridDim.x; }
    per_x = (total + nx - 1) / nx;
    const int xcd = vb % nx;
    slot = vb / nx;
    nslot = (nvb + nx - 1) / nx;
    base = xcd * per_x;
    lim = min(total, base + per_x);
  }
  __device__ __forceinline__ bool get(int iter, int& m, int& n) const {
    const int T = base + iter * nslot + slot;
    if (T >= lim) return false;
    const int grp = T / (8 * TN), r = T % (8 * TN);
    m = grp * 8 + (r & 7); n = r >> 3;
    return true;
  }
};

__device__ void phase_g1(const Params& p, int l, char* smem, int part, int vb, int nvb) {
  const int t_ = tid_op(); const int lane = t_ & 63, wave = t_ >> 6, wm = wave >> 1, wn = wave & 1, fr = lane & 15, fq = lane >> 4;
  const bf16_t* W = p.WtIn + (size_t)l * INC * 1024;
  constexpr int NTILE_N = 27, NTILE_M = NTOK / 128;
  TileIter ti; ti.init(NTILE_M, part == 0 ? NTILE_N : part == 1 ? 13 : 14, vb, nvb);
  for (int iter = 0;; iter++) {
    int mtile, ntile;
    if (!ti.get(iter, mtile, ntile)) break;
    if (part == 1) ntile += 8; else if (part == 2) ntile = ntile < 8 ? ntile : ntile + 13;
    const int m0 = mtile * 128, n0 = ntile * 128;
    f32x4 acc[4][4];
    zero_acc<4>(acc);
    if (ntile == 10 || ntile == 11) {
      gemm_mainloop<4, false>(p.h + (size_t)m0 * 1024, 1024, W + (size_t)n0 * 1024, 1024, 16, acc, (bf16_t*)smem);
#pragma unroll
      for (int mt = 0; mt < 4; mt++)
#pragma unroll
        for (int nt = 0; nt < 4; nt++) {
          int m = m0 + wm * 64 + mt * 16 + fq * 4;
          int ch = n0 + wn * 64 + nt * 16 + fr - 1280;
          bf16_t* dst;
          if (m0 < NLAT) { int b = m0 >> 12; dst = p.zvT + ((size_t)(b * 256 + ch)) * 4096 + (m - b * 4096); }
          else { int mm = m - NLAT; int b = mm >> 8; dst = p.zvTc + ((size_t)(b * 256 + ch)) * 256 + (mm & 255); }
          *(uint2*)dst = make_uint2(pack2(acc[mt][nt][0], acc[mt][nt][1]), pack2(acc[mt][nt][2], acc[mt][nt][3]));
        }
    } else {
      gemm_mainloop<4, true>(p.h + (size_t)m0 * 1024, 1024, W + (size_t)n0 * 1024, 1024, 16, acc, (bf16_t*)smem);
      const int zoff = n0 < 1280 ? 0 : -256;
#pragma unroll
      for (int mt = 0; mt < 4; mt++)
#pragma unroll
        for (int nt = 0; nt < 4; nt++) {
          int m = m0 + wm * 64 + mt * 16 + fr;
          int n = n0 + wn * 64 + nt * 16 + fq * 4 + zoff;
          *(uint2*)(p.z + (size_t)m * ZW + n) = make_uint2(pack2(acc[mt][nt][0], acc[mt][nt][1]), pack2(acc[mt][nt][2], acc[mt][nt][3]));
        }
    }
  }
}

__device__ void phase_g2(const Params& p, int l, char* smem) {
  const int t_ = tid_op(); const int lane = t_ & 63, wave = t_ >> 6, wm = wave >> 1, wn = wave & 1, fr = lane & 15, fq = lane >> 4;
  const bf16_t* W = p.WtIn + (size_t)l * INC * 1024;
  const bf16_t* Wb = p.WtBr + (size_t)l * 4 * 1024 * 256;
  bf16_t* y = p.z;
  const int ntm = (l == 0 ? NTOK : NLAT) / 128;
  TileIter ti; ti.init(ntm, 8);
  for (int iter = 0;; iter++) {
    int mtile, ntile;
    if (!ti.get(iter, mtile, ntile)) break;
    const int m0 = mtile * 128, n0 = ntile * 128;
#pragma unroll 1
    for (int i = 0; i < 4; i++) {
      f32x4 acc[4][4];
      unsigned ppk[4][4][2];
      zero_acc<4>(acc);
      gemm_mainloop<4, true, 1>(p.br + (size_t)m0 * 1024 + i * 256, 1024, Wb + ((size_t)i * 1024 + n0) * 256, 256, 4, acc, (bf16_t*)smem);
#pragma unroll
      for (int mt = 0; mt < 4; mt++)
#pragma unroll
        for (int nt = 0; nt < 4; nt++) {
          ppk[mt][nt][0] = pack2(acc[mt][nt][0], acc[mt][nt][1]);
          ppk[mt][nt][1] = pack2(acc[mt][nt][2], acc[mt][nt][3]);
        }
      zero_acc<4>(acc);
      gemm_mainloop<4, true, 1>(p.h + (size_t)m0 * 1024, 1024, W + (size_t)(3456 + i * 1024 + n0) * 1024, 1024, 16, acc, (bf16_t*)smem);
#pragma unroll
      for (int mt = 0; mt < 4; mt++)
#pragma unroll
        for (int nt = 0; nt < 4; nt++) {
          const int m = m0 + wm * 64 + mt * 16 + fr;
          const int n = n0 + wn * 64 + nt * 16 + fq * 4;
          uint2* yp = (uint2*)(y + (size_t)m * 1024 + n);
          uint2 yo = make_uint2(0u, 0u);
          if (i > 0) yo = *yp;
          float y0 = bflo(yo.x) + sigm(acc[mt][nt][0]) * bflo(ppk[mt][nt][0]);
          float y1 = bfhi(yo.x) + sigm(acc[mt][nt][1]) * bfhi(ppk[mt][nt][0]);
          float y2 = bflo(yo.y) + sigm(acc[mt][nt][2]) * bflo(ppk[mt][nt][1]);
          float y3 = bfhi(yo.y) + sigm(acc[mt][nt][3]) * bfhi(ppk[mt][nt][1]);
          *yp = make_uint2(pack2(y0, y1), pack2(y2, y3));
        }
    }
  }
}

__device__ void phase_g3(const Params& p, int l, char* smem) {
  const int t_ = tid_op(); const int lane = t_ & 63, wave = t_ >> 6, wm = wave >> 1, wn = wave & 1, fr = lane & 15, fq = lane >> 4;
  const bf16_t* W = p.WtOut + (size_t)l * 1024 * 1024;
  const bf16_t* y = p.z;
  const int ntm = (l == 0 ? NTOK : NLAT) / 128;
  TileIter ti; ti.init(ntm, 8);
  for (int iter = 0;; iter++) {
    int mtile, ntile;
    if (!ti.get(iter, mtile, ntile)) break;
    const int m0 = mtile * 128, n0 = ntile * 128;
    f32x4 acc[4][4];
    zero_acc<4>(acc);
    gemm_mainloop<4, true>(y + (size_t)m0 * 1024, 1024, W + (size_t)n0 * 1024, 1024, 16, acc, (bf16_t*)smem);
    const float* src; float* dst; int mb;
    if (m0 < NLAT) { src = (l == 0 ? p.x : p.out) + (size_t)m0 * 1024; dst = p.out + (size_t)m0 * 1024; mb = m0 >> 12; }
    else { src = p.ctx + (size_t)(m0 - NLAT) * 1024; dst = p.ctx1 + (size_t)(m0 - NLAT) * 1024; mb = 8; }
    const float* gate = p.mod + (l * 9 + mb) * 3072 + 2048;
#pragma unroll
    for (int mt = 0; mt < 4; mt++)
#pragma unroll
      for (int nt = 0; nt < 4; nt++) {
        int mr = wm * 64 + mt * 16 + fr;
        int n = n0 + wn * 64 + nt * 16 + fq * 4;
        float4 xv = *(const float4*)(src + (size_t)mr * 1024 + n);
        float4 gv = *(const float4*)(gate + n);
        float4 o = make_float4(xv.x + gv.x * acc[mt][nt][0], xv.y + gv.y * acc[mt][nt][1], xv.z + gv.z * acc[mt][nt][2], xv.w + gv.w * acc[mt][nt][3]);
        *(float4*)(dst + (size_t)mr * 1024 + n) = o;
      }
  }
}

__device__ void scan_item(const Params& p, int l, int item, char* smem) {
  const int rq = item & 1, d = (item >> 1) & 1, h = (item >> 2) & 3, b = item >> 4;
  const int t = tid_op(), lane = t & 63, wave = t >> 6, fr = lane & 15, fq = lane >> 4;
  float* Wd = (float*)smem;
  float* Av = Wd + 2048;
  float* Bv = Av + 2048;
  float* Kd = Bv + 2048;
  float* Rr = Kd + 2048;
  float* Vv = Rr + 2048;
  float* Pf = Vv + 1024;
  float* Yb = Pf;
  float* Qf = Pf + 2048;
  float* prm = Qf + 2048;
  bf16_t* wl = (bf16_t*)(prm + 320);
  bf16_t* al = wl + 32 * 72;

  for (int i = t; i < 320; i += NTHR) {
    int which = i >> 6, k = i & 63;
    float v;
    if (which == 0) v = p.rw_w0[(l * 2 + d) * 256 + h * 64 + k];
    else if (which == 1) v = p.rw_a0[(l * 2 + d) * 256 + h * 64 + k];
    else if (which == 2) v = p.rw_ka[l * 256 + h * 64 + k];
    else if (which == 3) v = p.rw_kk[l * 256 + h * 64 + k];
    else v = p.rw_rk[(l * 4 + h) * 64 + k];
    prm[i] = v;
  }
  bf16x8 w2f[2], a2f[2];
  {
    const int n = h * 64 + 16 * wave + fr;
    const float* w2 = p.rw_w2 + (size_t)(l * 2 + d) * 64 * 256 + n;
    const float* a2 = p.rw_a2 + (size_t)(l * 2 + d) * 64 * 256 + n;
#pragma unroll
    for (int ks = 0; ks < 2; ks++)
#pragma unroll
      for (int j = 0; j < 8; j++) {
        int kk = ks * 32 + fq * 8 + j;
        w2f[ks][j] = (short)f2bf(w2[kk * 256]);
        a2f[ks][j] = (short)f2bf(a2[kk * 256]);
      }
  }
  __syncthreads();

  float s0 = 0.f, s1 = 0.f, s2 = 0.f, s3 = 0.f;
  float u0 = 0.f, u1 = 0.f, u2 = 0.f, u3 = 0.f;
  const int kseg = lane & 15, rowl = wave * 8 + (lane >> 4) * 2;
  const int tt1 = t >> 3, oct = t & 7;
  constexpr int NCH_C = CTXL / 32, NCH_L = SEQ / 32, NCH = NCH_C + NCH_L;
  uint4 rcu[5], rpv[5], rnx[5];
  auto load_raw = [&](int gc) {
    const bool isc = gc < NCH_C;
    const int T = isc ? CTXL : SEQ;
    const int nch = isc ? NCH_C : NCH_L;
    const int ci = isc ? gc : gc - NCH_C;
    const int c = d ? nch - 1 - ci : ci;
    const size_t rowbase = isc ? (size_t)NLAT + b * CTXL : (size_t)b * SEQ;
    const int tok = c * 32 + tt1;
    const bf16_t* zr = p.z + (rowbase + tok) * ZW;
    const bool hp = tok > 0, hn = tok < T - 1;
#pragma unroll
    for (int g = 0; g < 5; g++) {
      const int colbase = g == 0 ? Z_RWR + h * 64 : g == 1 ? Z_RWK + h * 64 : g == 2 ? Z_RWV + h * 64 : g == 3 ? Z_RWW : Z_RWA;
      const int col = colbase + oct * 8;
      rcu[g] = *(const uint4*)(zr + col);
      rpv[g] = make_uint4(0, 0, 0, 0);
      rnx[g] = make_uint4(0, 0, 0, 0);
      if (hp) rpv[g] = *(const uint4*)(zr - ZW + col);
      if (hn) rnx[g] = *(const uint4*)(zr + ZW + col);
    }
  };
  float mureg[5][8];
#pragma unroll
  for (int g = 0; g < 5; g++) {
    const int colbase = g == 0 ? Z_RWR + h * 64 : g == 1 ? Z_RWK + h * 64 : g == 2 ? Z_RWV + h * 64 : g == 3 ? Z_RWW : Z_RWA;
    const float* mup = p.rw_mu + l * 896 + (colbase + oct * 8 - Z_RWR);
    float4 m0 = *(const float4*)mup, m1 = *(const float4*)(mup + 4);
    mureg[g][0] = m0.x; mureg[g][1] = m0.y; mureg[g][2] = m0.z; mureg[g][3] = m0.w;
    mureg[g][4] = m1.x; mureg[g][5] = m1.y; mureg[g][6] = m1.z; mureg[g][7] = m1.w;
  }
  load_raw(0);
  __builtin_amdgcn_s_setprio(2);
#pragma unroll 1
  for (int gc = 0; gc < NCH; gc++) {
    const bool isc = gc < NCH_C;
    const int nch = isc ? NCH_C : NCH_L;
    const int ci = isc ? gc : gc - NCH_C;
    const int c = d ? nch - 1 - ci : ci;
    const size_t rowbase = isc ? (size_t)NLAT + b * CTXL : (size_t)b * SEQ;
    const int t0 = c * 32;
    {
      const int tt = tt1;
      const int tok = t0 + tt;
#pragma unroll
      for (int g = 0; g < 5; g++) {
        const int colbase = g == 0 ? Z_RWR + h * 64 : g == 1 ? Z_RWK + h * 64 : g == 2 ? Z_RWV + h * 64 : g == 3 ? Z_RWW : Z_RWA;
        const int col = colbase + oct * 8;
        float fc[8], fp[8], fn[8], mix[8];
        unpack8(rcu[g], fc); unpack8(rpv[g], fp); unpack8(rnx[g], fn);
#pragma unroll
        for (int i = 0; i < 8; i++) mix[i] = fc[i] + (0.5f * (fp[i] + fn[i]) - fc[i]) * mureg[g][i];
        if (g == 0) {
          *(float4*)(Rr + tt * 64 + oct * 8) = make_float4(mix[0], mix[1], mix[2], mix[3]);
          *(float4*)(Rr + tt * 64 + oct * 8 + 4) = make_float4(mix[4], mix[5], mix[6], mix[7]);
        } else if (g == 1) {
          *(float4*)(Kd + tt * 64 + oct * 8) = make_float4(mix[0], mix[1], mix[2], mix[3]);
          *(float4*)(Kd + tt * 64 + oct * 8 + 4) = make_float4(mix[4], mix[5], mix[6], mix[7]);
        } else if (g == 2) {
          if ((oct >> 2) == rq) {
            *(float4*)(Vv + tt * 32 + (oct & 3) * 8) = make_float4(mix[0], mix[1], mix[2], mix[3]);
            *(float4*)(Vv + tt * 32 + (oct & 3) * 8 + 4) = make_float4(mix[4], mix[5], mix[6], mix[7]);
            if (d == 0) {
              *(uint4*)(p.vmix + (rowbase + tok) * 256 + h * 64 + oct * 8) =
                  make_uint4(pack2(mix[0], mix[1]), pack2(mix[2], mix[3]), pack2(mix[4], mix[5]), pack2(mix[6], mix[7]));
            }
          }
        } else if (g == 3) {
          float th[8];
#pragma unroll
          for (int i = 0; i < 8; i++) th[i] = 1.f - 2.f * frcp(1.f + __expf(2.f * mix[i]));
          *(uint4*)(wl + tt * 72 + oct * 8) = make_uint4(pack2(th[0], th[1]), pack2(th[2], th[3]), pack2(th[4], th[5]), pack2(th[6], th[7]));
        } else {
          *(uint4*)(al + tt * 72 + oct * 8) = make_uint4(pack2(mix[0], mix[1]), pack2(mix[2], mix[3]), pack2(mix[4], mix[5]), pack2(mix[6], mix[7]));
        }
      }
    }
    if (gc + 1 < NCH) load_raw(gc + 1);
    lds_barrier();
    {
#pragma unroll
      for (int mt = 0; mt < 2; mt++) {
        f32x4 ap = {0.f, 0.f, 0.f, 0.f}, aq = {0.f, 0.f, 0.f, 0.f};
#pragma unroll
        for (int ks = 0; ks < 2; ks++) {
          bf16x8 fa = *(const bf16x8*)(wl + (mt * 16 + fr) * 72 + ks * 32 + fq * 8);
          bf16x8 fb = *(const bf16x8*)(al + (mt * 16 + fr) * 72 + ks * 32 + fq * 8);
          ap = mfma16(fa, w2f[ks], ap);
          aq = mfma16(fb, a2f[ks], aq);
        }
#pragma unroll
        for (int j = 0; j < 4; j++) {
          Pf[(mt * 16 + fq * 4 + j) * 64 + wave * 16 + fr] = ap[j];
          Qf[(mt * 16 + fq * 4 + j) * 64 + wave * 16 + fr] = aq[j];
        }
      }
    }
    lds_barrier();
    {
      const int tt = tt1;
      float ss = 0.f, cf = 0.f;
      float kkr[8], aa[8], pv[8], qv[8], kv[8], rv[8], dec[8], kdv[8];
      *(float4*)(pv) = *(const float4*)(Pf + tt * 64 + oct * 8); *(float4*)(pv + 4) = *(const float4*)(Pf + tt * 64 + oct * 8 + 4);
      *(float4*)(qv) = *(const float4*)(Qf + tt * 64 + oct * 8); *(float4*)(qv + 4) = *(const float4*)(Qf + tt * 64 + oct * 8 + 4);
      *(float4*)(kv) = *(const float4*)(Kd + tt * 64 + oct * 8); *(float4*)(kv + 4) = *(const float4*)(Kd + tt * 64 + oct * 8 + 4);
      *(float4*)(rv) = *(const float4*)(Rr + tt * 64 + oct * 8); *(float4*)(rv + 4) = *(const float4*)(Rr + tt * 64 + oct * 8 + 4);
#pragma unroll
      for (int i = 0; i < 8; i++) {
        const int k = oct * 8 + i;
        float pp = prm[k] + pv[i];
        dec[i] = __expf(-0.6065306597f * sigm(pp));
        float a = sigm(prm[64 + k] + qv[i]);
        float kr = kv[i];
        kdv[i] = kr * (1.f + (a - 1.f) * prm[128 + k]);
        kkr[i] = kr * prm[192 + k];
        ss += kkr[i] * kkr[i];
        cf += rv[i] * kdv[i] * prm[256 + k];
        aa[i] = a;
      }
      ss = red8_sum(ss);
      cf = red8_sum(cf);
      float inv = frcp(fmaxf(__builtin_amdgcn_sqrtf(ss), 1e-12f));
      float av[8], bv[8];
#pragma unroll
      for (int i = 0; i < 8; i++) { float kk = kkr[i] * inv; av[i] = -kk; bv[i] = kk * aa[i]; }
      *(float4*)(Wd + tt * 64 + oct * 8) = *(float4*)(dec); *(float4*)(Wd + tt * 64 + oct * 8 + 4) = *(float4*)(dec + 4);
      *(float4*)(Kd + tt * 64 + oct * 8) = *(float4*)(kdv); *(float4*)(Kd + tt * 64 + oct * 8 + 4) = *(float4*)(kdv + 4);
      *(float4*)(Av + tt * 64 + oct * 8) = *(float4*)(av); *(float4*)(Av + tt * 64 + oct * 8 + 4) = *(float4*)(av + 4);
      *(float4*)(Bv + tt * 64 + oct * 8) = *(float4*)(bv); *(float4*)(Bv + tt * 64 + oct * 8 + 4) = *(float4*)(bv + 4);
      if (rq == 0 && oct == 0) p.coef[((size_t)d * NTOK + rowbase + t0 + tt) * 4 + h] = cf;
    }
    lds_barrier();
    {
      const int step = d ? -1 : 1;
      int tt = d ? 31 : 0;
      float4 w = *(const float4*)(Wd + tt * 64 + kseg * 4);
      float4 a = *(const float4*)(Av + tt * 64 + kseg * 4);
      float4 bb = *(const float4*)(Bv + tt * 64 + kseg * 4);
      float4 kd = *(const float4*)(Kd + tt * 64 + kseg * 4);
      float4 r = *(const float4*)(Rr + tt * 64 + kseg * 4);
      float2 v = *(const float2*)(Vv + tt * 32 + rowl);
      float ysel0 = 0.f, ysel1 = 0.f;
#pragma unroll 16
      for (int i = 0; i < 32; i++) {
        const int tn = (i < 31) ? tt + step : tt;
        float4 w2 = *(const float4*)(Wd + tn * 64 + kseg * 4);
        float4 a2 = *(const float4*)(Av + tn * 64 + kseg * 4);
        float4 b2 = *(const float4*)(Bv + tn * 64 + kseg * 4);
        float4 k2 = *(const float4*)(Kd + tn * 64 + kseg * 4);
        float4 r2 = *(const float4*)(Rr + tn * 64 + kseg * 4);
        float2 v2 = *(const float2*)(Vv + tn * 32 + rowl);
        float sa = (s0 * a.x + s1 * a.y) + (s2 * a.z + s3 * a.w);
        float ua = (u0 * a.x + u1 * a.y) + (u2 * a.z + u3 * a.w);
        red16_sum2(sa, ua);
        s0 = s0 * w.x + sa * bb.x + v.x * kd.x;
        s1 = s1 * w.y + sa * bb.y + v.x * kd.y;
        s2 = s2 * w.z + sa * bb.z + v.x * kd.z;
        s3 = s3 * w.w + sa * bb.w + v.x * kd.w;
        u0 = u0 * w.x + ua * bb.x + v.y * kd.x;
        u1 = u1 * w.y + ua * bb.y + v.y * kd.y;
        u2 = u2 * w.z + ua * bb.z + v.y * kd.z;
        u3 = u3 * w.w + ua * bb.w + v.y * kd.w;
        float y0 = (s0 * r.x + s1 * r.y) + (s2 * r.z + s3 * r.w);
        float y1 = (u0 * r.x + u1 * r.y) + (u2 * r.z + u3 * r.w);
        red16_sum2(y0, y1);
        ysel0 = ((i & 15) == kseg) ? y0 : ysel0;
        ysel1 = ((i & 15) == kseg) ? y1 : ysel1;
        if ((i & 15) == 15) {
          const int si = (i - 15) + kseg;
          const int ts = d ? 31 - si : si;
          *(float2*)(Yb + ts * 32 + rowl) = make_float2(ysel0, ysel1);
        }
        w = w2; a = a2; bb = b2; kd = k2; r = r2; v = v2; tt = tn;
      }
    }
    lds_barrier();
    {
      const int tt = t >> 3, q4 = t & 7;
      float4 yv = *(const float4*)(Yb + tt * 32 + q4 * 4);
      *(float4*)(p.yscan + ((size_t)d * NTOK + rowbase + t0 + tt) * 256 + h * 64 + rq * 32 + q4 * 4) = yv;
    }
  }
  __builtin_amdgcn_s_setprio(0);
  __syncthreads();
}

__device__ void natten_item(const Params& p, int l, int b, int h, size_t qrow0, int nband, int r, char* smem) {
  const int t = tid_op(), lane = t & 63, wave = t >> 6, fr = lane & 15, fq = lane >> 4;
  float* rpb = (float*)smem;
  bf16_t* Ps = (bf16_t*)(smem + 2048) + wave * 16 * 72;
  for (int i = t; i < 465; i += NTHR) rpb[i] = p.na_rpb[(l * 4 + h) * 465 + i];
  __syncthreads();
  const int qloc = wave * 16;
  bf16x8 qf[2];
#pragma unroll
  for (int ks = 0; ks < 2; ks++) qf[ks] = *(const bf16x8*)(p.z + (qrow0 + qloc + fr) * ZW + Z_NAQ + h * 64 + ks * 32 + fq * 8);
  float mrow[4], lrow[4];
  f32x4 o[4];
#pragma unroll
  for (int j = 0; j < 4; j++) { mrow[j] = -1e30f; lrow[j] = 0.f; o[j] = f32x4{0.f, 0.f, 0.f, 0.f}; }
  const int rstart = min(max(r - 4, 0), 56);
  const int c0w = wave == 0 ? 0 : wave == 1 ? 8 : wave == 2 ? 24 : 32;
#pragma unroll 1
  for (int kt = 0; kt < nband; kt++) {
    const int rr = rstart + kt;
    const size_t krow0 = (size_t)b * SEQ + rr * 64 + c0w;
    const bf16_t* vt = p.zvT + ((size_t)(b * 256 + h * 64)) * 4096 + rr * 64 + c0w;
    f32x4 s[2];
#pragma unroll
    for (int nt = 0; nt < 2; nt++) {
      s[nt] = f32x4{0.f, 0.f, 0.f, 0.f};
#pragma unroll
      for (int ks = 0; ks < 2; ks++) {
        bf16x8 kf = *(const bf16x8*)(p.z + (krow0 + nt * 16 + fr) * ZW + Z_NAK + h * 64 + ks * 32 + fq * 8);
        s[nt] = mfma16(qf[ks], kf, s[nt]);
      }
    }
    float pj[2][4];
#pragma unroll
    for (int j = 0; j < 4; j++) {
      const int q = qloc + fq * 4 + j;
      float mx = -1e30f;
#pragma unroll
      for (int nt = 0; nt < 2; nt++) {
        const int kc = c0w + nt * 16 + fr;
        const int cs = min(max(q - 8, 0), 48);
        const bool ok = (kc >= cs) && (kc < cs + 16);
        const int dc = min(max(kc - q, -15), 15);
        float bias = rpb[(rr - r + 7) * 31 + dc + 15];
        float val = ok ? s[nt][j] * 0.125f + bias : -1e30f;
        pj[nt][j] = val;
        mx = fmaxf(mx, val);
      }
      mx = red16_max(mx);
      const float mnew = fmaxf(mrow[j], mx);
      const float alpha = __expf(mrow[j] - mnew);
      float sum = 0.f;
#pragma unroll
      for (int nt = 0; nt < 2; nt++) { float e = __expf(pj[nt][j] - mnew); pj[nt][j] = e; sum += e; }
      sum = red16_sum(sum);
      lrow[j] = lrow[j] * alpha + sum;
      mrow[j] = mnew;
#pragma unroll
      for (int nt = 0; nt < 4; nt++) o[nt][j] *= alpha;
    }
#pragma unroll
    for (int nt = 0; nt < 2; nt++)
#pragma unroll
      for (int j = 0; j < 4; j++) Ps[(fq * 4 + j) * 72 + nt * 16 + fr] = f2bf(pj[nt][j]);
    __builtin_amdgcn_fence(__ATOMIC_RELEASE, "wavefront");
    __builtin_amdgcn_wave_barrier();
    __builtin_amdgcn_fence(__ATOMIC_ACQUIRE, "wavefront");
    bf16x8 pf = *(const bf16x8*)(Ps + fr * 72 + fq * 8);
#pragma unroll
    for (int nt = 0; nt < 4; nt++) {
      bf16x8 vf = *(const bf16x8*)(vt + (size_t)(nt * 16 + fr) * 4096 + fq * 8);
      o[nt] = mfma16(pf, vf, o[nt]);
    }
    __builtin_amdgcn_fence(__ATOMIC_RELEASE, "wavefront");
    __builtin_amdgcn_wave_barrier();
  }
#pragma unroll 1
  for (int cc = 0; cc < 4; cc++) {
    const size_t krow0 = (size_t)NLAT + b * CTXL + cc * 64;
    const bf16_t* vt = p.zvTc + ((size_t)(b * 256 + h * 64)) * 256 + cc * 64;
    f32x4 s[4];
#pragma unroll
    for (int nt = 0; nt < 4; nt++) {
      s[nt] = f32x4{0.f, 0.f, 0.f, 0.f};
#pragma unroll
      for (int ks = 0; ks < 2; ks++) {
        bf16x8 kf = *(const bf16x8*)(p.z + (krow0 + nt * 16 + fr) * ZW + Z_NAK + h * 64 + ks * 32 + fq * 8);
        s[nt] = mfma16(qf[ks], kf, s[nt]);
      }
    }
    float pj[4][4];
#pragma unroll
    for (int j = 0; j < 4; j++) {
      float mx = -1e30f;
#pragma unroll
      for (int nt = 0; nt < 4; nt++) { float val = s[nt][j] * 0.125f; pj[nt][j] = val; mx = fmaxf(mx, val); }
      mx = red16_max(mx);
      const float mnew = fmaxf(mrow[j], mx);
      const float alpha = __expf(mrow[j] - mnew);
      float sum = 0.f;
#pragma unroll
      for (int nt = 0; nt < 4; nt++) { float e = __expf(pj[nt][j] - mnew); pj[nt][j] = e; sum += e; }
      sum = red16_sum(sum);
      lrow[j] = lrow[j] * alpha + sum;
      mrow[j] = mnew;
#pragma unroll
      for (int nt = 0; nt < 4; nt++) o[nt][j] *= alpha;
    }
#pragma unroll
    for (int nt = 0; nt < 4; nt++)
#pragma unroll
      for (int j = 0; j < 4; j++) Ps[(fq * 4 + j) * 72 + nt * 16 + fr] = f2bf(pj[nt][j]);
    __builtin_amdgcn_fence(__ATOMIC_RELEASE, "wavefront");
    __builtin_amdgcn_wave_barrier();
    __builtin_amdgcn_fence(__ATOMIC_ACQUIRE, "wavefront");
    bf16x8 pf[2];
#pragma unroll
    for (int ks = 0; ks < 2; ks++) pf[ks] = *(const bf16x8*)(Ps + fr * 72 + ks * 32 + fq * 8);
#pragma unroll
    for (int nt = 0; nt < 4; nt++)
#pragma unroll
      for (int ks = 0; ks < 2; ks++) {
        bf16x8 vf = *(const bf16x8*)(vt + (size_t)(nt * 16 + fr) * 256 + ks * 32 + fq * 8);
        o[nt] = mfma16(pf[ks], vf, o[nt]);
      }
    __builtin_amdgcn_fence(__ATOMIC_RELEASE, "wavefront");
    __builtin_amdgcn_wave_barrier();
  }
#pragma unroll
  for (int j = 0; j < 4; j++) {
    const size_t row = qrow0 + qloc + fq * 4 + j;
    const float inv = frcp(lrow[j]);
#pragma unroll
    for (int nt = 0; nt < 4; nt++) {
      const int dcol = nt * 16 + fr;
      float g = silu_(bf2f(p.z[row * ZW + Z_NAG + h * 64 + dcol]));
      p.br[row * 1024 + 256 + h * 64 + dcol] = f2bf(o[nt][j] * inv * g);
    }
  }
  __syncthreads();
}

__device__ void gmlp_item(const Params& p, int l, size_t row0, int g, char* smem) {
  const int t = tid_op(), lane = t & 63, wave = t >> 6, fr = lane & 15, fq = lane >> 4;
  bf16_t* Ws = (bf16_t*)smem;
  bf16_t* VhT = Ws + 128 * 136;
  const float* ws = p.gm_ws + (size_t)(l * 4 + g) * 128 * 128;
#pragma unroll
  for (int i = 0; i < 16; i++) {
    int e = (i * NTHR + t) * 4;
    int pr = e >> 7, q = e & 127;
    float4 v = *(const float4*)(ws + e);
    *(uint2*)(Ws + pr * 136 + q) = make_uint2(pack2(v.x, v.y), pack2(v.z, v.w));
  }
  {
    const int q = t >> 1, half = t & 1;
    const bf16_t* zr = p.z + (row0 + q) * ZW + Z_GMV + g * 64 + half * 32;
    float v[32];
#pragma unroll
    for (int i = 0; i < 4; i++) { uint4 u = *(const uint4*)(zr + i * 8); unpack8(u, v + i * 8); }
    float sum = 0.f;
#pragma unroll
    for (int i = 0; i < 32; i++) { v[i] = gelu_(v[i]); sum += v[i]; }
    sum += dppf<0xB1>(sum);
    const float mu = sum * (1.f / 64.f);
    float vs = 0.f;
#pragma unroll
    for (int i = 0; i < 32; i++) { float dd = v[i] - mu; vs += dd * dd; }
    vs += dppf<0xB1>(vs);
    const float rs = rsqrtf(vs * (1.f / 64.f) + 1e-6f);
    const float* lg = p.gm_ln_g + (l * 4 + g) * 64 + half * 32;
    const float* lb = p.gm_ln_b + (l * 4 + g) * 64 + half * 32;
#pragma unroll
    for (int i = 0; i < 32; i++) VhT[(half * 32 + i) * 136 + q] = f2bf((v[i] - mu) * rs * lg[i] + lb[i]);
  }
  __syncthreads();
  f32x4 acc[2][4];
#pragma unroll
  for (int mt = 0; mt < 2; mt++)
#pragma unroll
    for (int nt = 0; nt < 4; nt++) acc[mt][nt] = f32x4{0.f, 0.f, 0.f, 0.f};
#pragma unroll
  for (int ks = 0; ks < 4; ks++) {
    bf16x8 af[2], bfr[4];
#pragma unroll
    for (int mt = 0; mt < 2; mt++) af[mt] = *(const bf16x8*)(Ws + (wave * 32 + mt * 16 + fr) * 136 + ks * 32 + fq * 8);
#pragma unroll
    for (int nt = 0; nt < 4; nt++) bfr[nt] = *(const bf16x8*)(VhT + (nt * 16 + fr) * 136 + ks * 32 + fq * 8);
#pragma unroll
    for (int mt = 0; mt < 2; mt++)
#pragma unroll
      for (int nt = 0; nt < 4; nt++) acc[mt][nt] = mfma16(bfr[nt], af[mt], acc[mt][nt]);
  }
#pragma unroll
  for (int mt = 0; mt < 2; mt++) {
    const int pr = wave * 32 + mt * 16 + fr;
    const float bs = p.gm_bs[(l * 4 + g) * 128 + pr];
    const bf16_t* zr = p.z + (row0 + pr) * ZW;
#pragma unroll
    for (int nt = 0; nt < 4; nt++) {
      const int c = nt * 16 + fq * 4;
      uint2 uu = *(const uint2*)(zr + Z_GMU + g * 64 + c);
      uint2 gg = *(const uint2*)(zr + Z_GMG + g * 64 + c);
      float o0 = gelu_(bflo(uu.x)) * (acc[mt][nt][0] + bs) * silu_(bflo(gg.x));
      float o1 = gelu_(bfhi(uu.x)) * (acc[mt][nt][1] + bs) * silu_(bfhi(gg.x));
      float o2 = gelu_(bflo(uu.y)) * (acc[mt][nt][2] + bs) * silu_(bflo(gg.y));
      float o3 = gelu_(bfhi(uu.y)) * (acc[mt][nt][3] + bs) * silu_(bfhi(gg.y));
      *(uint2*)(p.br + (row0 + pr) * 1024 + g * 64 + c) = make_uint2(pack2(o0, o1), pack2(o2, o3));
    }
  }
  __syncthreads();
}

__device__ void pool_item(const Params& p, int l, size_t seqrow0, int T, int t0, int g, char* smem) {
  const int t = tid_op(), lane = t & 63, wave = t >> 6, fr = lane & 15, fq = lane >> 4;
  float* Pp = (float*)smem;
  bf16_t* Dd = (bf16_t*)(Pp + 80 * 64);
  bf16_t* WT = Dd + 64 * 72;
  const int hw = 1 << g;
  for (int i = t; i < 80 * 8; i += NTHR) {
    int rr = i >> 3, oc = i & 7;
    int tok = t0 - 8 + rr;
    float f[8];
    if (tok >= 0 && tok < T) { uint4 u = *(const uint4*)(p.z + (seqrow0 + tok) * ZW + Z_PLP + g * 64 + oc * 8); unpack8(u, f); }
    else {
#pragma unroll
      for (int k = 0; k < 8; k++) f[k] = 0.f;
    }
#pragma unroll
    for (int k = 0; k < 8; k++) Pp[rr * 64 + oc * 8 + k] = f[k];
  }
  {
    const float* w = p.pl_w + (size_t)(l * 4 + g) * 64 * 64;
#pragma unroll
    for (int i = 0; i < 16; i++) {
      int e = i * NTHR + t;
      int c = e >> 6, dd = e & 63;
      WT[dd * 72 + c] = f2bf(w[e]);
    }
  }
  __syncthreads();
  {
    const int c = t & 63, tq = t >> 6;
    for (int i = 0; i < 16; i++) {
      const int tl = tq * 16 + i;
      const int tok = t0 + tl;
      const int lo = max(tok - hw, 0), hi = min(tok + hw, T);
      float s = 0.f;
      for (int u = lo; u < hi; u++) s += Pp[(u - t0 + 8) * 64 + c];
      float dv = s / (float)(hi - lo) - Pp[(tl + 8) * 64 + c];
      Dd[tl * 72 + c] = f2bf(dv);
    }
  }
  __syncthreads();
  f32x4 acc[4];
#pragma unroll
  for (int nt = 0; nt < 4; nt++) acc[nt] = f32x4{0.f, 0.f, 0.f, 0.f};
#pragma unroll
  for (int ks = 0; ks < 2; ks++) {
    bf16x8 af = *(const bf16x8*)(Dd + (wave * 16 + fr) * 72 + ks * 32 + fq * 8);
#pragma unroll
    for (int nt = 0; nt < 4; nt++) {
      bf16x8 bw = *(const bf16x8*)(WT + (nt * 16 + fr) * 72 + ks * 32 + fq * 8);
      acc[nt] = mfma16(bw, af, acc[nt]);
    }
  }
  {
    const size_t row = seqrow0 + t0 + wave * 16 + fr;
#pragma unroll
    for (int nt = 0; nt < 4; nt++) {
      const int dd = g * 64 + nt * 16 + fq * 4;
      float4 sc = *(const float4*)(p.pl_scale + l * 256 + dd);
      uint2 gg = *(const uint2*)(p.z + row * ZW + Z_PLG + dd);
      float o0 = acc[nt][0] * sc.x * silu_(bflo(gg.x));
      float o1 = acc[nt][1] * sc.y * silu_(bfhi(gg.x));
      float o2 = acc[nt][2] * sc.z * silu_(bflo(gg.y));
      float o3 = acc[nt][3] * sc.w * silu_(bfhi(gg.y));
      *(uint2*)(p.br + row * 1024 + 768 + dd) = make_uint2(pack2(o0, o1), pack2(o2, o3));
    }
  }
  __syncthreads();
}


constexpr unsigned ROLE_IDLE = 0xFFFF0001u, ROLE_WORK = 0x10000u;
__device__ void publish_cu(const Params& p) {
  if (threadIdx.x == 0 && gridDim.x == 512) {
    unsigned hw = __builtin_amdgcn_s_getreg(63492);
    unsigned xcc = __builtin_amdgcn_s_getreg(63508);
    p.cuinfo[blockIdx.x] = ((xcc & 0xfu) << 16) | (hw & 0xff00u);
  }
}
__device__ void compute_roles(const Params& p, char* smem) {
  const int t = tid_op();
  if (gridDim.x != 512) { if (t == 0) p.cuinfo[1024] = 1u; return; }
  unsigned* keys = (unsigned*)smem;
  unsigned* mate = keys + 512;
  unsigned* prim = mate + 512;
  for (int i = t; i < 512; i += NTHR) keys[i] = p.cuinfo[i];
  __syncthreads();
  int bad = 0;
  for (int i = t; i < 512; i += NTHR) {
    int cnt = 0, m = 0;
    for (int j = 0; j < 512; j++) if (j != i && keys[j] == keys[i]) { cnt++; m = j; }
    if (cnt != 1) bad = 1;
    mate[i] = (unsigned)m;
    prim[i] = (cnt == 1 && i < m) ? 1u : 0u;
  }
  bad = __syncthreads_or(bad);
  for (int i = t; i < 512; i += NTHR) {
    const int pi = prim[i] ? i : (int)mate[i];
    int rank = 0;
    for (int j = 0; j < pi; j++) rank += (int)prim[j];
    unsigned role;
    if (rank < 128) role = prim[i] ? (unsigned)rank : ROLE_IDLE;
    else role = ROLE_WORK + (unsigned)((rank - 128) * 2 + (prim[i] ? 0 : 1));
    p.cuinfo[512 + i] = role;
  }
  if (t == 0) p.cuinfo[1024] = bad ? 1u : 0u;
  __syncthreads();
}

__device__ void worker_barrier(unsigned* cnt, unsigned target) {
  asm volatile("s_waitcnt vmcnt(0)" ::: "memory");
  __syncthreads();
  if (threadIdx.x == 0) {
    __builtin_amdgcn_fence(__ATOMIC_RELEASE, "agent");
    atomicAdd(cnt, 1u);
    while (__hip_atomic_load(cnt, __ATOMIC_RELAXED, __HIP_MEMORY_SCOPE_AGENT) < target) __builtin_amdgcn_s_sleep(2);
    __builtin_amdgcn_fence(__ATOMIC_ACQUIRE, "agent");
    asm volatile("s_waitcnt vmcnt(0)" ::: "memory");
  }
  __syncthreads();
}
__device__ void phase_mix(const Params& p, int l, char* smem, int cslot) {
  __shared__ unsigned s_item;
  if (!(cslot & 4)) for (int it = blockIdx.x; it < 128; it += gridDim.x) scan_item(p, l, it, smem);
  cslot &= 3;
  const int n_na = 2048, n_ca = (l == 0 ? 128 : 0), n_gm = 1024, n_gc = (l == 0 ? 64 : 0), n_pl = 2048, n_pc = (l == 0 ? 128 : 0);
  const int total = n_na + n_ca + n_gm + n_gc + n_pl + n_pc;
  while (true) {
    if (threadIdx.x == 0) s_item = atomicAdd(p.ctr + cslot, 1u);
    __syncthreads();
    int it = (int)s_item;
    __syncthreads();
    if (it >= total) break;
    if (it < n_na) {
      int r = it & 63, h = (it >> 6) & 3, b = it >> 8;
      natten_item(p, l, b, h, (size_t)b * SEQ + r * 64, 8, r, smem);
      continue;
    }
    it -= n_na;
    if (it < n_ca) {
      int qt = it & 3, h = (it >> 2) & 3, b = it >> 4;
      natten_item(p, l, b, h, (size_t)NLAT + b * CTXL + qt * 64, 0, 0, smem);
      continue;
    }
    it -= n_ca;
    if (it < n_gm) {
      int g = it & 3, ch = (it >> 2) & 31, b = it >> 7;
      gmlp_item(p, l, (size_t)b * SEQ + ch * 128, g, smem);
      continue;
    }
    it -= n_gm;
    if (it < n_gc) {
      int g = it & 3, ch = (it >> 2) & 1, b = it >> 3;
      gmlp_item(p, l, (size_t)NLAT + b * CTXL + ch * 128, g, smem);
      continue;
    }
    it -= n_gc;
    if (it < n_pl) {
      int g = it & 3, tl = (it >> 2) & 63, b = it >> 8;
      pool_item(p, l, (size_t)b * SEQ, SEQ, tl * 64, g, smem);
      continue;
    }
    it -= n_pl;
    {
      int g = it & 3, tl = (it >> 2) & 3, b = it >> 4;
      pool_item(p, l, (size_t)NLAT + b * CTXL, CTXL, tl * 64, g, smem);
    }
  }
}

__device__ void phase_rwfin(const Params& p, int l) {
  const int t_ = tid_op();
  const int lane = t_ & 63;
  const int gw = blockIdx.x * 4 + (t_ >> 6), nw = gridDim.x * 4;
  const int nrow = (l == 0 ? NTOK : NLAT);
  const int hh = lane >> 4, c0 = lane * 4;
  float4 gg = *(const float4*)(p.rw_gn_g + l * 256 + c0);
  float4 gb = *(const float4*)(p.rw_gn_b + l * 256 + c0);
  for (int r = gw; r < nrow; r += nw) {
    float4 y0 = *(const float4*)(p.yscan + (size_t)r * 256 + c0);
    float4 y1 = *(const float4*)(p.yscan + ((size_t)NTOK + r) * 256 + c0);
    float o0 = y0.x + y1.x, o1 = y0.y + y1.y, o2 = y0.z + y1.z, o3 = y0.w + y1.w;
    float mu = red16_sum(o0 + o1 + o2 + o3) * (1.f / 64.f);
    float d0 = o0 - mu, d1 = o1 - mu, d2 = o2 - mu, d3 = o3 - mu;
    float var = red16_sum(d0 * d0 + d1 * d1 + d2 * d2 + d3 * d3) * (1.f / 64.f);
    float rs = rsqrtf(var + 64e-5f);
    float cf = p.coef[(size_t)r * 4 + hh] + p.coef[((size_t)NTOK + r) * 4 + hh];
    uint2 vm = *(const uint2*)(p.vmix + (size_t)r * 256 + c0);
    uint2 zg = *(const uint2*)(p.z + (size_t)r * ZW + Z_RWG + c0);
    float r0 = (d0 * rs * gg.x + gb.x + cf * bflo(vm.x)) * silu_(bflo(zg.x));
    float r1 = (d1 * rs * gg.y + gb.y + cf * bfhi(vm.x)) * silu_(bfhi(zg.x));
    float r2 = (d2 * rs * gg.z + gb.z + cf * bflo(vm.y)) * silu_(bflo(zg.y));
    float r3 = (d3 * rs * gg.w + gb.w + cf * bfhi(vm.y)) * silu_(bfhi(zg.y));
    *(uint2*)(p.br + (size_t)r * 1024 + 512 + c0) = make_uint2(pack2(r0, r1), pack2(r2, r3));
  }
}

__device__ __forceinline__ void gsync(cg::grid_group& grid) {
  asm volatile("s_waitcnt vmcnt(0)" ::: "memory");
  grid.sync();
}

#define XB_XCNT(j) (64 * (j))
#define XB_XSUB(j) (1024 + 64 * (j))
#define XB_XGEN(j) (2048 + 64 * (j))
#define XB_TOP 3072
#define XB_TOPGEN 3136
constexpr int XB_WORDS = 3200;
__device__ __forceinline__ unsigned xb_ld(unsigned* q) { return __hip_atomic_load(q, __ATOMIC_RELAXED, __HIP_MEMORY_SCOPE_AGENT); }
__device__ __forceinline__ unsigned xb_add(unsigned* q, unsigned v) { return __hip_atomic_fetch_add(q, v, __ATOMIC_RELAXED, __HIP_MEMORY_SCOPE_AGENT); }
#define XB_SPIN(cond) do { unsigned _sp = 0; while (cond) { __builtin_amdgcn_s_sleep(1); if (++_sp > (1u << 24)) break; } } while (0)
__device__ __forceinline__ void xsync(unsigned* bar, volatile unsigned* st) {
  asm volatile("s_waitcnt vmcnt(0)" ::: "memory");
  __syncthreads();
  if (threadIdx.x == 0) {
    __builtin_amdgcn_s_waitcnt(0);
    const unsigned nloc = st[0], nx = st[1], x = st[2];
    const unsigned old = xb_add(&bar[XB_XSUB(x)], 1u);
    const unsigned gen = old / nloc;
    if (old + 1u == (gen + 1u) * nloc) {
      __builtin_amdgcn_fence(__ATOMIC_RELEASE, "agent");
      asm volatile("s_waitcnt vmcnt(0)" ::: "memory");
      const unsigned og = xb_add(&bar[XB_TOP], 1u);
      const unsigned tg = og / nx;
      if (og + 1u == (tg + 1u) * nx) xb_add(&bar[XB_TOPGEN], 1u);
      else XB_SPIN(xb_ld(&bar[XB_TOPGEN]) == tg);
      __builtin_amdgcn_fence(__ATOMIC_ACQUIRE, "agent");
      xb_add(&bar[XB_XGEN(x)], 1u);
      asm volatile("s_waitcnt vmcnt(0)" ::: "memory");
    } else {
      XB_SPIN(xb_ld(&bar[XB_XGEN(x)]) == gen);
      __builtin_amdgcn_fence(__ATOMIC_ACQUIRE, "agent");
      asm volatile("s_waitcnt vmcnt(0)" ::: "memory");
    }
  }
  __syncthreads();
}
__global__ void __launch_bounds__(NTHR, 2) hybrid_mega(Params p) {
  extern __shared__ __attribute__((aligned(16))) char smem[];
  cg::grid_group grid = cg::this_grid();
  __shared__ unsigned xb_st[4];
  const unsigned my_xcc = (unsigned)__builtin_amdgcn_s_getreg((3 << 11) | 20) & 0xFu;
  if (threadIdx.x == 0) (void)xb_add(&p.xbar[XB_XCNT(my_xcc)], 1u);
  publish_cu(p);
  phase0(p, smem);
  if (p.xbar == nullptr) gsync(grid);
  if (threadIdx.x == 0) {
    unsigned mine = 0, cnt = 0, sum = 0, sp = 0;
    for (;;) {
      mine = 0; cnt = 0; sum = 0;
      for (unsigned j = 0; j < 16; j++) { const unsigned c = xb_ld(&p.xbar[XB_XCNT(j)]); sum += c; cnt += c > 0u ? 1u : 0u; mine = j == my_xcc ? c : mine; }
      if (sum == gridDim.x || ++sp > (1u << 22)) break;
      __builtin_amdgcn_s_sleep(1);
    }
    xb_st[0] = mine > 0u ? mine : 1u; xb_st[1] = cnt > 0u ? cnt : 1u; xb_st[2] = my_xcc;
  }
  __syncthreads();
  xsync(p.xbar, xb_st);
  if (blockIdx.x == 0) compute_roles(p, smem);
#pragma unroll 1
  for (int l = 0; l < 2; l++) {
    phase_norm(p, l, l == 0 ? p.x : p.out, l == 0 ? p.ctx : p.ctx1);
    xsync(p.xbar, xb_st);
    const bool overlap = (gridDim.x == 512) && (p.cuinfo[1024] == 0u);
    phase_g1(p, l, smem, overlap ? 1 : 0, -1, 0);
    xsync(p.xbar, xb_st);
    {
      if (overlap) {
        const unsigned role = p.cuinfo[512 + blockIdx.x];
        if (role < 128u) scan_item(p, l, (int)role, smem);
        else if (role >= ROLE_WORK && role < ROLE_WORK + 256u) {
          phase_g1(p, l, smem, 2, (int)(role - ROLE_WORK), 256);
          worker_barrier(p.ctr + 4 + l, 256u);
          phase_mix(p, l, smem, l | 4);
        }
      } else {
        for (int it = blockIdx.x; it < 128; it += gridDim.x) scan_item(p, l, it, smem);
      }
      xsync(p.xbar, xb_st);
      if (!overlap) phase_mix(p, l, smem, l | 4);
      phase_rwfin(p, l);
      xsync(p.xbar, xb_st);
    }
    phase_g2(p, l, smem);
    xsync(p.xbar, xb_st);
    if (DUP_MASK & 2) { phase_g2(p, l, smem); xsync(p.xbar, xb_st); }
    phase_g3(p, l, smem);
    xsync(p.xbar, xb_st);
    if ((DUP_MASK & 8) && l == 0) { phase_g3(p, l, smem); xsync(p.xbar, xb_st); }
  }
  phase_final(p);
}

extern "C" void kernel_launch(void* const* d_in, const int* in_sizes, int n_in, void* d_out, int out_size, void* d_ws,
                              size_t ws_size, hipStream_t stream) {
  static int grid_blocks = 0;
  if (!grid_blocks) {
    int dev = 0, cus = 0, per_cu = 0;
    hipGetDevice(&dev);
    hipDeviceGetAttribute(&cus, hipDeviceAttributeMultiprocessorCount, dev);
    hipFuncSetAttribute((const void*)hybrid_mega, hipFuncAttributeMaxDynamicSharedMemorySize, LDS_BYTES);
    hipOccupancyMaxActiveBlocksPerMultiprocessor(&per_cu, hybrid_mega, NTHR, LDS_BYTES);
    if (per_cu > 2) per_cu = 2;
    if (per_cu < 1) per_cu = 1;
    grid_blocks = cus * per_cu;
  }
  Params p{};
  const float* const* in = (const float* const*)d_in;
  p.x = in[0]; p.c = in[1]; p.ctx = in[2]; p.c_ctx = in[3]; p.ada_w = in[4]; p.ada_b = in[5]; p.norm_g = in[6]; p.w_in = in[7];
  p.gm_ln_g = in[8]; p.gm_ln_b = in[9]; p.gm_ws = in[10]; p.gm_bs = in[11]; p.na_rpb = in[12]; p.rw_mu = in[13]; p.rw_w0 = in[14];
  p.rw_w2 = in[15]; p.rw_a0 = in[16]; p.rw_a2 = in[17]; p.rw_kk = in[18]; p.rw_ka = in[19]; p.rw_rk = in[20]; p.rw_gn_g = in[21];
  p.rw_gn_b = in[22]; p.pl_w = in[23]; p.pl_scale = in[24]; p.w_br = in[25]; p.w_out = in[26]; p.final_g = in[27];
  p.out = (float*)d_out;
  char* w = (char*)d_ws;
  size_t off = 0;
  auto take = [&](size_t bytes) { char* r = w + off; off += (bytes + 255) & ~(size_t)255; return r; };
  p.ctr = (unsigned*)take(256);
  p.cuinfo = (unsigned*)take(8192);
  p.xbar = (unsigned*)take(XB_WORDS * 4);
  p.mod = (float*)take((size_t)2 * 9 * 3072 * 4);
  p.WtIn = (bf16_t*)take((size_t)2 * INC * 1024 * 2);
  p.WtBr = (bf16_t*)take((size_t)2 * 4 * 1024 * 256 * 2);
  p.WtOut = (bf16_t*)take((size_t)2 * 1024 * 1024 * 2);
  p.h = (bf16_t*)take((size_t)NTOK * 1024 * 2);
  p.z = (bf16_t*)take((size_t)NTOK * ZW * 2);
  p.zvT = (bf16_t*)take((size_t)NB * 256 * SEQ * 2);
  p.zvTc = (bf16_t*)take((size_t)NB * 256 * CTXL * 2);
  p.br = (bf16_t*)take((size_t)NTOK * 1024 * 2);
  p.yscan = (float*)take((size_t)2 * NTOK * 256 * 4);
  p.vmix = (bf16_t*)take((size_t)NTOK * 256 * 2);
  p.coef = (float*)take((size_t)2 * NTOK * 4 * 4);
  p.ctx1 = (float*)take((size_t)NCTX * 1024 * 4);
  if (off > ws_size) fprintf(stderr, "workspace too small: need %zu have %zu\n", off, ws_size);
  hipMemsetAsync(p.xbar, 0, XB_WORDS * 4, stream);
  void* args[] = {&p};
  hipError_t e = hipLaunchCooperativeKernel((const void*)hybrid_mega, dim3(grid_blocks), dim3(NTHR), args, LDS_BYTES, stream);
  if (e != hipSuccess) fprintf(stderr, "cooperative launch failed: %s (grid %d)\n", hipGetErrorString(e), grid_blocks);
}
```

```cpp
#include <hip/hip_runtime.h>
#include <hip/hip_cooperative_groups.h>
#include <cstdio>
namespace cg = cooperative_groups;

typedef unsigned short bf16_t;
using bf16x8 = __attribute__((ext_vector_type(8))) short;
using f32x4 = __attribute__((ext_vector_type(4))) float;

constexpr int D = 1024;
constexpr int NB = 8;
constexpr int SEQ = 4096;
constexpr int CTXL = 256;
constexpr int NLAT = NB * SEQ;
constexpr int NCTX = NB * CTXL;
constexpr int NTOK = NLAT + NCTX;
constexpr int INC = 7552;
constexpr int ZW = 3200;
constexpr int Z_GMU = 0, Z_GMV = 256, Z_GMG = 512, Z_NAQ = 768, Z_NAK = 1024, Z_NAG = 1280;
constexpr int Z_RWR = 1536, Z_RWK = 1792, Z_RWV = 2048, Z_RWW = 2304, Z_RWA = 2368, Z_RWG = 2432, Z_PLP = 2688, Z_PLG = 2944;
constexpr int LDS_BYTES = 73728;
constexpr int NTHR = 256;
#ifndef DUP_MASK
#define DUP_MASK 0
#endif

struct Params {
  const float *x, *c, *ctx, *c_ctx, *ada_w, *ada_b, *norm_g, *w_in, *gm_ln_g, *gm_ln_b, *gm_ws, *gm_bs, *na_rpb,
      *rw_mu, *rw_w0, *rw_w2, *rw_a0, *rw_a2, *rw_kk, *rw_ka, *rw_rk, *rw_gn_g, *rw_gn_b, *pl_w, *pl_scale, *w_br, *w_out, *final_g;
  float* out;
  bf16_t *WtIn, *WtBr, *WtOut, *h, *z, *zvT, *zvTc, *br, *vmix;
  float *mod, *yscan, *coef, *ctx1;
  unsigned* ctr;
  unsigned* xbar;
  unsigned* cuinfo;
};

__device__ __forceinline__ bf16_t f2bf(float f) {
  unsigned u = __float_as_uint(f);
  u += 0x7fffu + ((u >> 16) & 1u);
  return (bf16_t)(u >> 16);
}
__device__ __forceinline__ float bf2f(unsigned v) { return __uint_as_float(v << 16); }
__device__ __forceinline__ unsigned pack2(float a, float b) { return (unsigned)f2bf(a) | ((unsigned)f2bf(b) << 16); }
__device__ __forceinline__ float bflo(unsigned w) { return __uint_as_float(w << 16); }
__device__ __forceinline__ float bfhi(unsigned w) { return __uint_as_float(w & 0xffff0000u); }
__device__ __forceinline__ float frcp(float x) { return __builtin_amdgcn_rcpf(x); }
__device__ __forceinline__ float sigm(float x) { return frcp(1.f + __expf(-x)); }
__device__ __forceinline__ float silu_(float x) { return x * frcp(1.f + __expf(-x)); }
__device__ __forceinline__ float gelu_(float x) {
  float u = 1.5957691216f * (x + 0.044715f * x * x * x);
  return x * frcp(1.f + __expf(-u));
}
template <int CTRL>
__device__ __forceinline__ float dppf(float v) {
  return __int_as_float(__builtin_amdgcn_update_dpp(0, __float_as_int(v), CTRL, 0xf, 0xf, false));
}
__device__ __forceinline__ float red16_sum(float v) {
  v += dppf<0xB1>(v); v += dppf<0x4E>(v); v += dppf<0x141>(v); v += dppf<0x140>(v); return v;
}
__device__ __forceinline__ void red16_sum2(float& a, float& b) {
  a += dppf<0xB1>(a); asm volatile("" : "+v"(a));
  b += dppf<0xB1>(b); asm volatile("" : "+v"(b));
  a += dppf<0x4E>(a); asm volatile("" : "+v"(a));
  b += dppf<0x4E>(b); asm volatile("" : "+v"(b));
  a += dppf<0x141>(a); asm volatile("" : "+v"(a));
  b += dppf<0x141>(b); asm volatile("" : "+v"(b));
  a += dppf<0x140>(a); asm volatile("" : "+v"(a));
  b += dppf<0x140>(b); asm volatile("" : "+v"(b));
}
__device__ __forceinline__ float red16_max(float v) {
  v = fmaxf(v, dppf<0xB1>(v)); v = fmaxf(v, dppf<0x4E>(v)); v = fmaxf(v, dppf<0x141>(v)); v = fmaxf(v, dppf<0x140>(v)); return v;
}
__device__ __forceinline__ float red8_sum(float v) {
  v += dppf<0xB1>(v); v += dppf<0x4E>(v); v += dppf<0x141>(v); return v;
}
__device__ __forceinline__ float wave_sum(float v) {
#pragma unroll
  for (int o = 32; o > 0; o >>= 1) v += __shfl_xor(v, o);
  return v;
}
__device__ __forceinline__ int tid_op() {
  int t = threadIdx.x;
  asm volatile("" : "+v"(t));
  return t;
}
__device__ __forceinline__ void lds_barrier() {
  asm volatile("s_waitcnt lgkmcnt(0)" ::: "memory");
  __builtin_amdgcn_s_barrier();
  asm volatile("" ::: "memory");
}
__device__ __forceinline__ f32x4 mfma16(bf16x8 a, bf16x8 b, f32x4 c) {
  return __builtin_amdgcn_mfma_f32_16x16x32_bf16(a, b, c, 0, 0, 0);
}
__device__ __forceinline__ void unpack8(uint4 v, float* f) {
  f[0] = bflo(v.x); f[1] = bfhi(v.x); f[2] = bflo(v.y); f[3] = bfhi(v.y);
  f[4] = bflo(v.z); f[5] = bfhi(v.z); f[6] = bflo(v.w); f[7] = bfhi(v.w);
}

__device__ void transpose_tile(const float* __restrict__ src, int N, bf16_t* __restrict__ dst, int K, int k0, int n0, float* tile) {
  const int t = tid_op();
  const int r = t >> 4, c4 = (t & 15) * 4;
#pragma unroll
  for (int i = 0; i < 4; i++) {
    int k = r + 16 * i;
    float4 v = *(const float4*)(src + (size_t)(k0 + k) * N + n0 + c4);
    tile[k * 65 + c4 + 0] = v.x; tile[k * 65 + c4 + 1] = v.y; tile[k * 65 + c4 + 2] = v.z; tile[k * 65 + c4 + 3] = v.w;
  }
  __syncthreads();
  const int n = t >> 2, ks = (t & 3) * 16;
  unsigned pk[8];
#pragma unroll
  for (int i = 0; i < 8; i++) pk[i] = pack2(tile[(ks + 2 * i) * 65 + n], tile[(ks + 2 * i + 1) * 65 + n]);
  uint4* dp = (uint4*)(dst + (size_t)(n0 + n) * K + k0 + ks);
  dp[0] = make_uint4(pk[0], pk[1], pk[2], pk[3]);
  dp[1] = make_uint4(pk[4], pk[5], pk[6], pk[7]);
  __syncthreads();
}

__device__ void mod_item(const Params& p, int l, int jc, char* smem) {
  float* sil = (float*)smem;
  float* red = sil + 9 * 1024;
  const int t = tid_op();
  for (int i = t; i < 9 * 1024; i += NTHR) {
    int r = i >> 10, k = i & 1023;
    float v = r < 8 ? p.c[r * 1024 + k] : p.c_ctx[k];
    sil[i] = silu_(v);
  }
  __syncthreads();
  const int col = t & 63, q = t >> 6;
  float acc[9];
#pragma unroll
  for (int r = 0; r < 9; r++) acc[r] = 0.f;
  const float* w = p.ada_w + (size_t)l * 1024 * 3072 + jc * 64 + col;
  for (int k = q * 256; k < q * 256 + 256; k++) {
    float wv = w[(size_t)k * 3072];
#pragma unroll
    for (int r = 0; r < 9; r++) acc[r] += sil[r * 1024 + k] * wv;
  }
#pragma unroll
  for (int r = 0; r < 9; r++) red[(q * 9 + r) * 64 + col] = acc[r];
  __syncthreads();
  if (t < 64) {
    float bb = p.ada_b[l * 3072 + jc * 64 + t];
#pragma unroll
    for (int r = 0; r < 9; r++) {
      float s = red[(0 * 9 + r) * 64 + t] + red[(1 * 9 + r) * 64 + t] + red[(2 * 9 + r) * 64 + t] + red[(3 * 9 + r) * 64 + t];
      p.mod[(l * 9 + r) * 3072 + jc * 64 + t] = s + bb;
    }
  }
  __syncthreads();
}

__device__ void phase0(const Params& p, char* smem) {
  if (blockIdx.x == 0 && threadIdx.x < 8) p.ctr[threadIdx.x] = 0u;
  constexpr int PER_L = 2400 + 48;
  for (int it = blockIdx.x; it < 2 * PER_L; it += gridDim.x) {
    int l = it / PER_L, r = it % PER_L;
    if (r < 1888) {
      int kt = r & 15, nt = r >> 4;
      transpose_tile(p.w_in + (size_t)l * 1024 * INC, INC, p.WtIn + (size_t)l * INC * 1024, 1024, kt * 64, nt * 64, (float*)smem);
    } else if (r < 2144) {
      int q = r - 1888; int i = q >> 6; int kt = q & 3, nt = (q >> 2) & 15;
      transpose_tile(p.w_br + ((size_t)l * 4 + i) * 256 * 1024, 1024, p.WtBr + ((size_t)l * 4 + i) * 1024 * 256, 256, kt * 64, nt * 64, (float*)smem);
    } else if (r < 2400) {
      int q = r - 2144; int kt = q & 15, nt = q >> 4;
      transpose_tile(p.w_out + (size_t)l * 1024 * 1024, 1024, p.WtOut + (size_t)l * 1024 * 1024, 1024, kt * 64, nt * 64, (float*)smem);
    } else {
      mod_item(p, l, r - 2400, smem);
    }
  }
}

__device__ void phase_norm(const Params& p, int l, const float* xsrc, const float* csrc) {
  const int t_ = tid_op();
  const int lane = t_ & 63;
  const int gw = blockIdx.x * 4 + (t_ >> 6), nw = gridDim.x * 4;
  const float* g = p.norm_g + l * 1024;
  for (int r = gw; r < NTOK; r += nw) {
    const float* src; int mb;
    if (r < NLAT) { src = xsrc + (size_t)r * 1024; mb = r >> 12; } else { src = csrc + (size_t)(r - NLAT) * 1024; mb = 8; }
    const float* md = p.mod + (l * 9 + mb) * 3072;
    float4 v[4]; float ss = 0.f;
#pragma unroll
    for (int i = 0; i < 4; i++) {
      v[i] = *(const float4*)(src + lane * 4 + 256 * i);
      ss += v[i].x * v[i].x + v[i].y * v[i].y + v[i].z * v[i].z + v[i].w * v[i].w;
    }
    ss = wave_sum(ss);
    float rs = rsqrtf(ss * (1.f / 1024.f) + 1e-6f);
#pragma unroll
    for (int i = 0; i < 4; i++) {
      int col = lane * 4 + 256 * i;
      float4 gg = *(const float4*)(g + col);
      float4 sh = *(const float4*)(md + col);
      float4 sc = *(const float4*)(md + 1024 + col);
      float a0 = v[i].x * rs * gg.x * (1.f + sc.x) + sh.x;
      float a1 = v[i].y * rs * gg.y * (1.f + sc.y) + sh.y;
      float a2 = v[i].z * rs * gg.z * (1.f + sc.z) + sh.z;
      float a3 = v[i].w * rs * gg.w * (1.f + sc.w) + sh.w;
      *(uint2*)(p.h + (size_t)r * 1024 + col) = make_uint2(pack2(a0, a1), pack2(a2, a3));
    }
  }
}

__device__ void phase_final(const Params& p) {
  const int t_ = tid_op();
  const int lane = t_ & 63;
  const int gw = blockIdx.x * 4 + (t_ >> 6), nw = gridDim.x * 4;
  for (int r = gw; r < NLAT; r += nw) {
    float* src = p.out + (size_t)r * 1024;
    float4 v[4]; float ss = 0.f;
#pragma unroll
    for (int i = 0; i < 4; i++) {
      v[i] = *(const float4*)(src + lane * 4 + 256 * i);
      ss += v[i].x * v[i].x + v[i].y * v[i].y + v[i].z * v[i].z + v[i].w * v[i].w;
    }
    ss = wave_sum(ss);
    float rs = rsqrtf(ss * (1.f / 1024.f) + 1e-6f);
#pragma unroll
    for (int i = 0; i < 4; i++) {
      int col = lane * 4 + 256 * i;
      float4 gg = *(const float4*)(p.final_g + col);
      float4 o = make_float4(v[i].x * rs * gg.x, v[i].y * rs * gg.y, v[i].z * rs * gg.z, v[i].w * rs * gg.w);
      *(float4*)(src + col) = o;
    }
  }
}

template <int NT, bool SWAP>
__device__ __forceinline__ void gemm_compute(const bf16_t* a_s, const bf16_t* b_s, int o0, f32x4 (&acc)[4][NT]) {
#pragma unroll
  for (int ks = 0; ks < 2; ks++) {
    const int off = ks == 0 ? o0 : (o0 ^ 32);
    bf16x8 af[4], bfr[NT];
#pragma unroll
    for (int mt = 0; mt < 4; mt++) af[mt] = *(const bf16x8*)(a_s + mt * 16 * 64 + off);
#pragma unroll
    for (int nt = 0; nt < NT; nt++) bfr[nt] = *(const bf16x8*)(b_s + nt * 16 * 64 + off);
#pragma unroll
    for (int mt = 0; mt < 4; mt++)
#pragma unroll
      for (int nt = 0; nt < NT; nt++)
        acc[mt][nt] = SWAP ? mfma16(bfr[nt], af[mt], acc[mt][nt]) : mfma16(af[mt], bfr[nt], acc[mt][nt]);
  }
}

template <int NT, bool SWAP, int DEEP = 2>
__device__ __forceinline__ void gemm_mainloop(const bf16_t* __restrict__ A, int lda, const bf16_t* __restrict__ Bm, int ldb,
                                              int nk, f32x4 (&acc)[4][NT], bf16_t* sm) {
  constexpr int ASZ = 128 * 64, BSZ = NT * 32 * 64;
  bf16_t* sA = sm;
  bf16_t* sB = sm + 2 * ASZ;
  const int t = tid_op(), lane = t & 63, wave = t >> 6, wm = wave >> 1, wn = wave & 1;
  const int lr = t >> 3, lc = (t & 7) * 8;
  const int lcs = ((t & 7) ^ ((lr >> 1) & 7)) * 8;
  const int fr = lane & 15, fq = lane >> 4;
  uint4 p0a0, p0a1, p0a2, p0a3, p0b0, p0b1, p0b2, p0b3;
  uint4 p1a0, p1a1, p1a2, p1a3, p1b0, p1b1, p1b2, p1b3;
  p0b2 = p0b3 = p1b2 = p1b3 = make_uint4(0, 0, 0, 0);
  const bf16_t* Ap = A + (size_t)lr * lda + lc;
  const bf16_t* Bp = Bm + (size_t)lr * ldb + lc;
#define GLD(P, R, I, KT) *(const uint4*)(P + (size_t)(32 * I) * R + (KT) * 64)
#define GLOAD(S, KT)                                                         \
  {                                                                          \
    S##a0 = GLD(Ap, lda, 0, KT); S##a1 = GLD(Ap, lda, 1, KT);                \
    S##a2 = GLD(Ap, lda, 2, KT); S##a3 = GLD(Ap, lda, 3, KT);                \
    S##b0 = GLD(Bp, ldb, 0, KT); S##b1 = GLD(Bp, ldb, 1, KT);                \
    if constexpr (NT == 4) { S##b2 = GLD(Bp, ldb, 2, KT); S##b3 = GLD(Bp, ldb, 3, KT); } \
  }
#define SST(BASE, I) *(uint4*)(BASE + (lr + 32 * I) * 64 + lcs)
#define SWRITE(S, BUF)                                                       \
  {                                                                          \
    SST(sA + (BUF) * ASZ, 0) = S##a0; SST(sA + (BUF) * ASZ, 1) = S##a1;      \
    SST(sA + (BUF) * ASZ, 2) = S##a2; SST(sA + (BUF) * ASZ, 3) = S##a3;      \
    SST(sB + (BUF) * BSZ, 0) = S##b0; SST(sB + (BUF) * BSZ, 1) = S##b1;      \
    if constexpr (NT == 4) { SST(sB + (BUF) * BSZ, 2) = S##b2; SST(sB + (BUF) * BSZ, 3) = S##b3; } \
  }
  const bf16_t* a_s0 = sA + (wm * 64 + fr) * 64;
  const bf16_t* b_s0 = sB + (wn * (NT * 16) + fr) * 64;
  const int o0 = (fq ^ ((fr >> 1) & 7)) * 8;
  if (DEEP == 2) {
    GLOAD(p0, 0);
    GLOAD(p1, 1);
    SWRITE(p0, 0);
    __syncthreads();
#pragma unroll 1
    for (int kt = 0; kt < nk; kt += 2) {
      const bool m2 = kt + 2 < nk;
      if (m2) GLOAD(p0, kt + 2);
      gemm_compute<NT, SWAP>(a_s0, b_s0, o0, acc);
      SWRITE(p1, 1);
      __syncthreads();
      if (m2) GLOAD(p1, kt + 3);
      gemm_compute<NT, SWAP>(a_s0 + ASZ, b_s0 + BSZ, o0, acc);
      if (m2) SWRITE(p0, 0);
      __syncthreads();
    }
  } else {
    GLOAD(p0, 0);
    SWRITE(p0, 0);
    __syncthreads();
#pragma unroll 1
    for (int kt = 0; kt < nk; kt += 2) {
      const bool m2 = kt + 2 < nk;
      GLOAD(p0, kt + 1);
      gemm_compute<NT, SWAP>(a_s0, b_s0, o0, acc);
      SWRITE(p0, 1);
      __syncthreads();
      if (m2) GLOAD(p0, kt + 2);
      gemm_compute<NT, SWAP>(a_s0 + ASZ, b_s0 + BSZ, o0, acc);
      if (m2) SWRITE(p0, 0);
      __syncthreads();
    }
  }
#undef GLOAD
#undef SWRITE
#undef GLD
#undef SST
}

template <int NT>
__device__ __forceinline__ void zero_acc(f32x4 (&acc)[4][NT]) {
#pragma unroll
  for (int i = 0; i < 4; i++)
#pragma unroll
    for (int j = 0; j < NT; j++) acc[i][j] = f32x4{0.f, 0.f, 0.f, 0.f};
}

struct TileIter {
  int total, TN, per_x, base, lim, nslot, slot;
  __device__ __forceinline__ void init(int TM, int TN_, int vb = -1, int nvb = 0) {
    TN = TN_; total = TM * TN_;
    const int nx = 8;
    if (vb < 0) { vb = blockIdx.x; nvb = gridDim.x; }
    per_x = (total + nx - 1) / nx;
    const int xcd = vb % nx;
    slot = vb / nx;
    nslot = (nvb + nx - 1) / nx;
    base = xcd * per_x;
    lim = min(total, base + per_x);
  }
  __device__ __forceinline__ bool get(int iter, int& m, int& n) const {
    const int T = base + iter * nslot + slot;
    if (T >= lim) return false;
    const int grp = T / (8 * TN), r = T % (8 * TN);
    m = grp * 8 + (r & 7); n = r >> 3;
    return true;
  }
};

__device__ void phase_g1(const Params& p, int l, char* smem, int part, int vb, int nvb) {
  const int t_ = tid_op(); const int lane = t_ & 63, wave = t_ >> 6, wm = wave >> 1, wn = wave & 1, fr = lane & 15, fq = lane >> 4;
  const bf16_t* W = p.WtIn + (size_t)l * INC * 1024;
  constexpr int NTILE_N = 27, NTILE_M = NTOK / 128;
  TileIter ti; ti.init(NTILE_M, part == 0 ? NTILE_N : part == 1 ? 13 : 14, vb, nvb);
  for (int iter = 0;; iter++) {
    int mtile, ntile;
    if (!ti.get(iter, mtile, ntile)) break;
    if (part == 1) ntile += 8; else if (part == 2) ntile = ntile < 8 ? ntile : ntile + 13;
    const int m0 = mtile * 128, n0 = ntile * 128;
    f32x4 acc[4][4];
    zero_acc<4>(acc);
    if (ntile == 10 || ntile == 11) {
      gemm_mainloop<4, false>(p.h + (size_t)m0 * 1024, 1024, W + (size_t)n0 * 1024, 1024, 16, acc, (bf16_t*)smem);
#pragma unroll
      for (int mt = 0; mt < 4; mt++)
#pragma unroll
        for (int nt = 0; nt < 4; nt++) {
          int m = m0 + wm * 64 + mt * 16 + fq * 4;
          int ch = n0 + wn * 64 + nt * 16 + fr - 1280;
          bf16_t* dst;
          if (m0 < NLAT) { int b = m0 >> 12; dst = p.zvT + ((size_t)(b * 256 + ch)) * 4096 + (m - b * 4096); }
          else { int mm = m - NLAT; int b = mm >> 8; dst = p.zvTc + ((size_t)(b * 256 + ch)) * 256 + (mm & 255); }
          *(uint2*)dst = make_uint2(pack2(acc[mt][nt][0], acc[mt][nt][1]), pack2(acc[mt][nt][2], acc[mt][nt][3]));
        }
    } else {
      gemm_mainloop<4, true>(p.h + (size_t)m0 * 1024, 1024, W + (size_t)n0 * 1024, 1024, 16, acc, (bf16_t*)smem);
      const int zoff = n0 < 1280 ? 0 : -256;
#pragma unroll
      for (int mt = 0; mt < 4; mt++)
#pragma unroll
        for (int nt = 0; nt < 4; nt++) {
          int m = m0 + wm * 64 + mt * 16 + fr;
          int n = n0 + wn * 64 + nt * 16 + fq * 4 + zoff;
          *(uint2*)(p.z + (size_t)m * ZW + n) = make_uint2(pack2(acc[mt][nt][0], acc[mt][nt][1]), pack2(acc[mt][nt][2], acc[mt][nt][3]));
        }
    }
  }
}

template <int NT>
__device__ __forceinline__ void g2_tile(const Params& p, int l, char* smem, int m0, int n0) {
  const int t_ = tid_op(); const int lane = t_ & 63, wave = t_ >> 6, wm = wave >> 1, wn = wave & 1, fr = lane & 15, fq = lane >> 4;
  const bf16_t* W = p.WtIn + (size_t)l * INC * 1024;
  const bf16_t* Wb = p.WtBr + (size_t)l * 4 * 1024 * 256;
  bf16_t* y = p.z;
#pragma unroll 1
  for (int i = 0; i < 4; i++) {
    f32x4 acc[4][NT];
    unsigned ppk[4][NT][2];
    zero_acc<NT>(acc);
    gemm_mainloop<NT, true, 1>(p.br + (size_t)m0 * 1024 + i * 256, 1024, Wb + ((size_t)i * 1024 + n0) * 256, 256, 4, acc, (bf16_t*)smem);
#pragma unroll
    for (int mt = 0; mt < 4; mt++)
#pragma unroll
      for (int nt = 0; nt < NT; nt++) {
        ppk[mt][nt][0] = pack2(acc[mt][nt][0], acc[mt][nt][1]);
        ppk[mt][nt][1] = pack2(acc[mt][nt][2], acc[mt][nt][3]);
      }
    zero_acc<NT>(acc);
    gemm_mainloop<NT, true, 1>(p.h + (size_t)m0 * 1024, 1024, W + (size_t)(3456 + i * 1024 + n0) * 1024, 1024, 16, acc, (bf16_t*)smem);
#pragma unroll
    for (int mt = 0; mt < 4; mt++)
#pragma unroll
      for (int nt = 0; nt < NT; nt++) {
        const int m = m0 + wm * 64 + mt * 16 + fr;
        const int n = n0 + wn * (NT * 16) + nt * 16 + fq * 4;
        uint2* yp = (uint2*)(y + (size_t)m * 1024 + n);
        uint2 yo = make_uint2(0u, 0u);
        if (i > 0) yo = *yp;
        float y0 = bflo(yo.x) + sigm(acc[mt][nt][0]) * bflo(ppk[mt][nt][0]);
        float y1 = bfhi(yo.x) + sigm(acc[mt][nt][1]) * bfhi(ppk[mt][nt][0]);
        float y2 = bflo(yo.y) + sigm(acc[mt][nt][2]) * bflo(ppk[mt][nt][1]);
        float y3 = bfhi(yo.y) + sigm(acc[mt][nt][3]) * bfhi(ppk[mt][nt][1]);
        *yp = make_uint2(pack2(y0, y1), pack2(y2, y3));
      }
  }
}
__device__ void phase_g2(const Params& p, int l, char* smem) {
  {
    TileIter ti; ti.init(NLAT / 128, 8);
    for (int iter = 0;; iter++) {
      int mtile, ntile;
      if (!ti.get(iter, mtile, ntile)) break;
      g2_tile<4>(p, l, smem, mtile * 128, ntile * 128);
    }
  }
  if (l == 0) {
    TileIter ti; ti.init(NCTX / 128, 16);
    for (int iter = 0;; iter++) {
      int mtile, ntile;
      if (!ti.get(iter, mtile, ntile)) break;
      g2_tile<2>(p, l, smem, NLAT + mtile * 128, ntile * 64);
    }
  }
}

__device__ void phase_g3(const Params& p, int l, char* smem) {
  const int t_ = tid_op(); const int lane = t_ & 63, wave = t_ >> 6, wm = wave >> 1, wn = wave & 1, fr = lane & 15, fq = lane >> 4;
  const bf16_t* W = p.WtOut + (size_t)l * 1024 * 1024;
  const bf16_t* y = p.z;
  const int ntm = (l == 0 ? NTOK : NLAT) / 128;
  TileIter ti; ti.init(ntm, 8);
  for (int iter = 0;; iter++) {
    int mtile, ntile;
    if (!ti.get(iter, mtile, ntile)) break;
    const int m0 = mtile * 128, n0 = ntile * 128;
    f32x4 acc[4][4];
    zero_acc<4>(acc);
    gemm_mainloop<4, true>(y + (size_t)m0 * 1024, 1024, W + (size_t)n0 * 1024, 1024, 16, acc, (bf16_t*)smem);
    const float* src; float* dst; int mb;
    if (m0 < NLAT) { src = (l == 0 ? p.x : p.out) + (size_t)m0 * 1024; dst = p.out + (size_t)m0 * 1024; mb = m0 >> 12; }
    else { src = p.ctx + (size_t)(m0 - NLAT) * 1024; dst = p.ctx1 + (size_t)(m0 - NLAT) * 1024; mb = 8; }
    const float* gate = p.mod + (l * 9 + mb) * 3072 + 2048;
#pragma unroll
    for (int mt = 0; mt < 4; mt++)
#pragma unroll
      for (int nt = 0; nt < 4; nt++) {
        int mr = wm * 64 + mt * 16 + fr;
        int n = n0 + wn * 64 + nt * 16 + fq * 4;
        float4 xv = *(const float4*)(src + (size_t)mr * 1024 + n);
        float4 gv = *(const float4*)(gate + n);
        float4 o = make_float4(xv.x + gv.x * acc[mt][nt][0], xv.y + gv.y * acc[mt][nt][1], xv.z + gv.z * acc[mt][nt][2], xv.w + gv.w * acc[mt][nt][3]);
        *(float4*)(dst + (size_t)mr * 1024 + n) = o;
      }
  }
}

__device__ void scan_item(const Params& p, int l, int item, char* smem) {
  const int rq = item & 1, d = (item >> 1) & 1, h = (item >> 2) & 3, b = item >> 4;
  const int t = tid_op(), lane = t & 63, wave = t >> 6, fr = lane & 15, fq = lane >> 4;
  float* Wd = (float*)smem;
  float* Av = Wd + 2048;
  float* Bv = Av + 2048;
  float* Kd = Bv + 2048;
  float* Rr = Kd + 2048;
  float* Vv = Rr + 2048;
  float* Pf = Vv + 1024;
  float* Yb = Pf;
  float* Qf = Pf + 2048;
  float* prm = Qf + 2048;
  bf16_t* wl = (bf16_t*)(prm + 320);
  bf16_t* al = wl + 32 * 72;

  for (int i = t; i < 320; i += NTHR) {
    int which = i >> 6, k = i & 63;
    float v;
    if (which == 0) v = p.rw_w0[(l * 2 + d) * 256 + h * 64 + k];
    else if (which == 1) v = p.rw_a0[(l * 2 + d) * 256 + h * 64 + k];
    else if (which == 2) v = p.rw_ka[l * 256 + h * 64 + k];
    else if (which == 3) v = p.rw_kk[l * 256 + h * 64 + k];
    else v = p.rw_rk[(l * 4 + h) * 64 + k];
    prm[i] = v;
  }
  bf16x8 w2f[2], a2f[2];
  {
    const int n = h * 64 + 16 * wave + fr;
    const float* w2 = p.rw_w2 + (size_t)(l * 2 + d) * 64 * 256 + n;
    const float* a2 = p.rw_a2 + (size_t)(l * 2 + d) * 64 * 256 + n;
#pragma unroll
    for (int ks = 0; ks < 2; ks++)
#pragma unroll
      for (int j = 0; j < 8; j++) {
        int kk = ks * 32 + fq * 8 + j;
        w2f[ks][j] = (short)f2bf(w2[kk * 256]);
        a2f[ks][j] = (short)f2bf(a2[kk * 256]);
      }
  }
  __syncthreads();

  float s0 = 0.f, s1 = 0.f, s2 = 0.f, s3 = 0.f;
  float u0 = 0.f, u1 = 0.f, u2 = 0.f, u3 = 0.f;
  const int kseg = lane & 15, rowl = wave * 8 + (lane >> 4) * 2;
  const int tt1 = t >> 3, oct = t & 7;
  constexpr int NCH_C = CTXL / 32, NCH_L = SEQ / 32, NCH = NCH_C + NCH_L;
  uint4 rcu[5], rpv[5], rnx[5];
  auto load_raw = [&](int gc) {
    const bool isc = gc < NCH_C;
    const int T = isc ? CTXL : SEQ;
    const int nch = isc ? NCH_C : NCH_L;
    const int ci = isc ? gc : gc - NCH_C;
    const int c = d ? nch - 1 - ci : ci;
    const size_t rowbase = isc ? (size_t)NLAT + b * CTXL : (size_t)b * SEQ;
    const int tok = c * 32 + tt1;
    const bf16_t* zr = p.z + (rowbase + tok) * ZW;
    const bool hp = tok > 0, hn = tok < T - 1;
#pragma unroll
    for (int g = 0; g < 5; g++) {
      const int colbase = g == 0 ? Z_RWR + h * 64 : g == 1 ? Z_RWK + h * 64 : g == 2 ? Z_RWV + h * 64 : g == 3 ? Z_RWW : Z_RWA;
      const int col = colbase + oct * 8;
      rcu[g] = *(const uint4*)(zr + col);
      rpv[g] = make_uint4(0, 0, 0, 0);
      rnx[g] = make_uint4(0, 0, 0, 0);
      if (hp) rpv[g] = *(const uint4*)(zr - ZW + col);
      if (hn) rnx[g] = *(const uint4*)(zr + ZW + col);
    }
  };
  float mureg[5][8];
#pragma unroll
  for (int g = 0; g < 5; g++) {
    const int colbase = g == 0 ? Z_RWR + h * 64 : g == 1 ? Z_RWK + h * 64 : g == 2 ? Z_RWV + h * 64 : g == 3 ? Z_RWW : Z_RWA;
    const float* mup = p.rw_mu + l * 896 + (colbase + oct * 8 - Z_RWR);
    float4 m0 = *(const float4*)mup, m1 = *(const float4*)(mup + 4);
    mureg[g][0] = m0.x; mureg[g][1] = m0.y; mureg[g][2] = m0.z; mureg[g][3] = m0.w;
    mureg[g][4] = m1.x; mureg[g][5] = m1.y; mureg[g][6] = m1.z; mureg[g][7] = m1.w;
  }
  load_raw(0);
  __builtin_amdgcn_s_setprio(2);
#pragma unroll 1
  for (int gc = 0; gc < NCH; gc++) {
    const bool isc = gc < NCH_C;
    const int nch = isc ? NCH_C : NCH_L;
    const int ci = isc ? gc : gc - NCH_C;
    const int c = d ? nch - 1 - ci : ci;
    const size_t rowbase = isc ? (size_t)NLAT + b * CTXL : (size_t)b * SEQ;
    const int t0 = c * 32;
    {
      const int tt = tt1;
      const int tok = t0 + tt;
#pragma unroll
      for (int g = 0; g < 5; g++) {
        const int colbase = g == 0 ? Z_RWR + h * 64 : g == 1 ? Z_RWK + h * 64 : g == 2 ? Z_RWV + h * 64 : g == 3 ? Z_RWW : Z_RWA;
        const int col = colbase + oct * 8;
        float fc[8], fp[8], fn[8], mix[8];
        unpack8(rcu[g], fc); unpack8(rpv[g], fp); unpack8(rnx[g], fn);
#pragma unroll
        for (int i = 0; i < 8; i++) mix[i] = fc[i] + (0.5f * (fp[i] + fn[i]) - fc[i]) * mureg[g][i];
        if (g == 0) {
          *(float4*)(Rr + tt * 64 + oct * 8) = make_float4(mix[0], mix[1], mix[2], mix[3]);
          *(float4*)(Rr + tt * 64 + oct * 8 + 4) = make_float4(mix[4], mix[5], mix[6], mix[7]);
        } else if (g == 1) {
          *(float4*)(Kd + tt * 64 + oct * 8) = make_float4(mix[0], mix[1], mix[2], mix[3]);
          *(float4*)(Kd + tt * 64 + oct * 8 + 4) = make_float4(mix[4], mix[5], mix[6], mix[7]);
        } else if (g == 2) {
          if ((oct >> 2) == rq) {
            *(float4*)(Vv + tt * 32 + (oct & 3) * 8) = make_float4(mix[0], mix[1], mix[2], mix[3]);
            *(float4*)(Vv + tt * 32 + (oct & 3) * 8 + 4) = make_float4(mix[4], mix[5], mix[6], mix[7]);
            if (d == 0) {
              *(uint4*)(p.vmix + (rowbase + tok) * 256 + h * 64 + oct * 8) =
                  make_uint4(pack2(mix[0], mix[1]), pack2(mix[2], mix[3]), pack2(mix[4], mix[5]), pack2(mix[6], mix[7]));
            }
          }
        } else if (g == 3) {
          float th[8];
#pragma unroll
          for (int i = 0; i < 8; i++) th[i] = 1.f - 2.f * frcp(1.f + __expf(2.f * mix[i]));
          *(uint4*)(wl + tt * 72 + oct * 8) = make_uint4(pack2(th[0], th[1]), pack2(th[2], th[3]), pack2(th[4], th[5]), pack2(th[6], th[7]));
        } else {
          *(uint4*)(al + tt * 72 + oct * 8) = make_uint4(pack2(mix[0], mix[1]), pack2(mix[2], mix[3]), pack2(mix[4], mix[5]), pack2(mix[6], mix[7]));
        }
      }
    }
    if (gc + 1 < NCH) load_raw(gc + 1);
    lds_barrier();
    {
#pragma unroll
      for (int mt = 0; mt < 2; mt++) {
        f32x4 ap = {0.f, 0.f, 0.f, 0.f}, aq = {0.f, 0.f, 0.f, 0.f};
#pragma unroll
        for (int ks = 0; ks < 2; ks++) {
          bf16x8 fa = *(const bf16x8*)(wl + (mt * 16 + fr) * 72 + ks * 32 + fq * 8);
          bf16x8 fb = *(const bf16x8*)(al + (mt * 16 + fr) * 72 + ks * 32 + fq * 8);
          ap = mfma16(fa, w2f[ks], ap);
          aq = mfma16(fb, a2f[ks], aq);
        }
#pragma unroll
        for (int j = 0; j < 4; j++) {
          Pf[(mt * 16 + fq * 4 + j) * 64 + wave * 16 + fr] = ap[j];
          Qf[(mt * 16 + fq * 4 + j) * 64 + wave * 16 + fr] = aq[j];
        }
      }
    }
    lds_barrier();
    {
      const int tt = tt1;
      float ss = 0.f, cf = 0.f;
      float kkr[8], aa[8], pv[8], qv[8], kv[8], rv[8], dec[8], kdv[8];
      *(float4*)(pv) = *(const float4*)(Pf + tt * 64 + oct * 8); *(float4*)(pv + 4) = *(const float4*)(Pf + tt * 64 + oct * 8 + 4);
      *(float4*)(qv) = *(const float4*)(Qf + tt * 64 + oct * 8); *(float4*)(qv + 4) = *(const float4*)(Qf + tt * 64 + oct * 8 + 4);
      *(float4*)(kv) = *(const float4*)(Kd + tt * 64 + oct * 8); *(float4*)(kv + 4) = *(const float4*)(Kd + tt * 64 + oct * 8 + 4);
      *(float4*)(rv) = *(const float4*)(Rr + tt * 64 + oct * 8); *(float4*)(rv + 4) = *(const float4*)(Rr + tt * 64 + oct * 8 + 4);
#pragma unroll
      for (int i = 0; i < 8; i++) {
        const int k = oct * 8 + i;
        float pp = prm[k] + pv[i];
        dec[i] = __expf(-0.6065306597f * sigm(pp));
        float a = sigm(prm[64 + k] + qv[i]);
        float kr = kv[i];
        kdv[i] = kr * (1.f + (a - 1.f) * prm[128 + k]);
        kkr[i] = kr * prm[192 + k];
        ss += kkr[i] * kkr[i];
        cf += rv[i] * kdv[i] * prm[256 + k];
        aa[i] = a;
      }
      ss = red8_sum(ss);
      cf = red8_sum(cf);
      float inv = frcp(fmaxf(__builtin_amdgcn_sqrtf(ss), 1e-12f));
      float av[8], bv[8];
#pragma unroll
      for (int i = 0; i < 8; i++) { float kk = kkr[i] * inv; av[i] = -kk; bv[i] = kk * aa[i]; }
      *(float4*)(Wd + tt * 64 + oct * 8) = *(float4*)(dec); *(float4*)(Wd + tt * 64 + oct * 8 + 4) = *(float4*)(dec + 4);
      *(float4*)(Kd + tt * 64 + oct * 8) = *(float4*)(kdv); *(float4*)(Kd + tt * 64 + oct * 8 + 4) = *(float4*)(kdv + 4);
      *(float4*)(Av + tt * 64 + oct * 8) = *(float4*)(av); *(float4*)(Av + tt * 64 + oct * 8 + 4) = *(float4*)(av + 4);
      *(float4*)(Bv + tt * 64 + oct * 8) = *(float4*)(bv); *(float4*)(Bv + tt * 64 + oct * 8 + 4) = *(float4*)(bv + 4);
      if (rq == 0 && oct == 0) p.coef[((size_t)d * NTOK + rowbase + t0 + tt) * 4 + h] = cf;
    }
    lds_barrier();
    {
      const int step = d ? -1 : 1;
      int tt = d ? 31 : 0;
      float4 w = *(const float4*)(Wd + tt * 64 + kseg * 4);
      float4 a = *(const float4*)(Av + tt * 64 + kseg * 4);
      float4 bb = *(const float4*)(Bv + tt * 64 + kseg * 4);
      float4 kd = *(const float4*)(Kd + tt * 64 + kseg * 4);
      float4 r = *(const float4*)(Rr + tt * 64 + kseg * 4);
      float2 v = *(const float2*)(Vv + tt * 32 + rowl);
      float ysel0 = 0.f, ysel1 = 0.f;
#pragma unroll 16
      for (int i = 0; i < 32; i++) {
        const int tn = (i < 31) ? tt + step : tt;
        float4 w2 = *(const float4*)(Wd + tn * 64 + kseg * 4);
        float4 a2 = *(const float4*)(Av + tn * 64 + kseg * 4);
        float4 b2 = *(const float4*)(Bv + tn * 64 + kseg * 4);
        float4 k2 = *(const float4*)(Kd + tn * 64 + kseg * 4);
        float4 r2 = *(const float4*)(Rr + tn * 64 + kseg * 4);
        float2 v2 = *(const float2*)(Vv + tn * 32 + rowl);
        float sa = (s0 * a.x + s1 * a.y) + (s2 * a.z + s3 * a.w);
        float ua = (u0 * a.x + u1 * a.y) + (u2 * a.z + u3 * a.w);
        red16_sum2(sa, ua);
        s0 = s0 * w.x + sa * bb.x + v.x * kd.x;
        s1 = s1 * w.y + sa * bb.y + v.x * kd.y;
        s2 = s2 * w.z + sa * bb.z + v.x * kd.z;
        s3 = s3 * w.w + sa * bb.w + v.x * kd.w;
        u0 = u0 * w.x + ua * bb.x + v.y * kd.x;
        u1 = u1 * w.y + ua * bb.y + v.y * kd.y;
        u2 = u2 * w.z + ua * bb.z + v.y * kd.z;
        u3 = u3 * w.w + ua * bb.w + v.y * kd.w;
        float y0 = (s0 * r.x + s1 * r.y) + (s2 * r.z + s3 * r.w);
        float y1 = (u0 * r.x + u1 * r.y) + (u2 * r.z + u3 * r.w);
        red16_sum2(y0, y1);
        ysel0 = ((i & 15) == kseg) ? y0 : ysel0;
        ysel1 = ((i & 15) == kseg) ? y1 : ysel1;
        if ((i & 15) == 15) {
          const int si = (i - 15) + kseg;
          const int ts = d ? 31 - si : si;
          *(float2*)(Yb + ts * 32 + rowl) = make_float2(ysel0, ysel1);
        }
        w = w2; a = a2; bb = b2; kd = k2; r = r2; v = v2; tt = tn;
      }
    }
    lds_barrier();
    {
      const int tt = t >> 3, q4 = t & 7;
      float4 yv = *(const float4*)(Yb + tt * 32 + q4 * 4);
      *(float4*)(p.yscan + ((size_t)d * NTOK + rowbase + t0 + tt) * 256 + h * 64 + rq * 32 + q4 * 4) = yv;
    }
  }
  __builtin_amdgcn_s_setprio(0);
  __syncthreads();
}

__device__ void natten_item(const Params& p, int l, int b, int h, size_t qrow0, int nband, int r, char* smem) {
  const int t = tid_op(), lane = t & 63, wave = t >> 6, fr = lane & 15, fq = lane >> 4;
  float* rpb = (float*)smem;
  bf16_t* Ps = (bf16_t*)(smem + 2048) + wave * 16 * 72;
  for (int i = t; i < 465; i += NTHR) rpb[i] = p.na_rpb[(l * 4 + h) * 465 + i];
  __syncthreads();
  const int qloc = wave * 16;
  bf16x8 qf[2];
#pragma unroll
  for (int ks = 0; ks < 2; ks++) qf[ks] = *(const bf16x8*)(p.z + (qrow0 + qloc + fr) * ZW + Z_NAQ + h * 64 + ks * 32 + fq * 8);
  float mrow[4], lrow[4];
  f32x4 o[4];
#pragma unroll
  for (int j = 0; j < 4; j++) { mrow[j] = -1e30f; lrow[j] = 0.f; o[j] = f32x4{0.f, 0.f, 0.f, 0.f}; }
  const int rstart = min(max(r - 4, 0), 56);
  const int c0w = wave == 0 ? 0 : wave == 1 ? 8 : wave == 2 ? 24 : 32;
#pragma unroll 1
  for (int kt = 0; kt < nband; kt++) {
    const int rr = rstart + kt;
    const size_t krow0 = (size_t)b * SEQ + rr * 64 + c0w;
    const bf16_t* vt = p.zvT + ((size_t)(b * 256 + h * 64)) * 4096 + rr * 64 + c0w;
    f32x4 s[2];
#pragma unroll
    for (int nt = 0; nt < 2; nt++) {
      s[nt] = f32x4{0.f, 0.f, 0.f, 0.f};
#pragma unroll
      for (int ks = 0; ks < 2; ks++) {
        bf16x8 kf = *(const bf16x8*)(p.z + (krow0 + nt * 16 + fr) * ZW + Z_NAK + h * 64 + ks * 32 + fq * 8);
        s[nt] = mfma16(qf[ks], kf, s[nt]);
      }
    }
    float pj[2][4];
#pragma unroll
    for (int j = 0; j < 4; j++) {
      const int q = qloc + fq * 4 + j;
      float mx = -1e30f;
#pragma unroll
      for (int nt = 0; nt < 2; nt++) {
        const int kc = c0w + nt * 16 + fr;
        const int cs = min(max(q - 8, 0), 48);
        const bool ok = (kc >= cs) && (kc < cs + 16);
        const int dc = min(max(kc - q, -15), 15);
        float bias = rpb[(rr - r + 7) * 31 + dc + 15];
        float val = ok ? s[nt][j] * 0.125f + bias : -1e30f;
        pj[nt][j] = val;
        mx = fmaxf(mx, val);
      }
      mx = red16_max(mx);
      const float mnew = fmaxf(mrow[j], mx);
      const float alpha = __expf(mrow[j] - mnew);
      float sum = 0.f;
#pragma unroll
      for (int nt = 0; nt < 2; nt++) { float e = __expf(pj[nt][j] - mnew); pj[nt][j] = e; sum += e; }
      sum = red16_sum(sum);
      lrow[j] = lrow[j] * alpha + sum;
      mrow[j] = mnew;
#pragma unroll
      for (int nt = 0; nt < 4; nt++) o[nt][j] *= alpha;
    }
#pragma unroll
    for (int nt = 0; nt < 2; nt++)
#pragma unroll
      for (int j = 0; j < 4; j++) Ps[(fq * 4 + j) * 72 + nt * 16 + fr] = f2bf(pj[nt][j]);
    __builtin_amdgcn_fence(__ATOMIC_RELEASE, "wavefront");
    __builtin_amdgcn_wave_barrier();
    __builtin_amdgcn_fence(__ATOMIC_ACQUIRE, "wavefront");
    bf16x8 pf = *(const bf16x8*)(Ps + fr * 72 + fq * 8);
#pragma unroll
    for (int nt = 0; nt < 4; nt++) {
      bf16x8 vf = *(const bf16x8*)(vt + (size_t)(nt * 16 + fr) * 4096 + fq * 8);
      o[nt] = mfma16(pf, vf, o[nt]);
    }
    __builtin_amdgcn_fence(__ATOMIC_RELEASE, "wavefront");
    __builtin_amdgcn_wave_barrier();
  }
#pragma unroll 1
  for (int cc = 0; cc < 4; cc++) {
    const size_t krow0 = (size_t)NLAT + b * CTXL + cc * 64;
    const bf16_t* vt = p.zvTc + ((size_t)(b * 256 + h * 64)) * 256 + cc * 64;
    f32x4 s[4];
#pragma unroll
    for (int nt = 0; nt < 4; nt++) {
      s[nt] = f32x4{0.f, 0.f, 0.f, 0.f};
#pragma unroll
      for (int ks = 0; ks < 2; ks++) {
        bf16x8 kf = *(const bf16x8*)(p.z + (krow0 + nt * 16 + fr) * ZW + Z_NAK + h * 64 + ks * 32 + fq * 8);
        s[nt] = mfma16(qf[ks], kf, s[nt]);
      }
    }
    float pj[4][4];
#pragma unroll
    for (int j = 0; j < 4; j++) {
      float mx = -1e30f;
#pragma unroll
      for (int nt = 0; nt < 4; nt++) { float val = s[nt][j] * 0.125f; pj[nt][j] = val; mx = fmaxf(mx, val); }
      mx = red16_max(mx);
      const float mnew = fmaxf(mrow[j], mx);
      const float alpha = __expf(mrow[j] - mnew);
      float sum = 0.f;
#pragma unroll
      for (int nt = 0; nt < 4; nt++) { float e = __expf(pj[nt][j] - mnew); pj[nt][j] = e; sum += e; }
      sum = red16_sum(sum);
      lrow[j] = lrow[j] * alpha + sum;
      mrow[j] = mnew;
#pragma unroll
      for (int nt = 0; nt < 4; nt++) o[nt][j] *= alpha;
    }
#pragma unroll
    for (int nt = 0; nt < 4; nt++)
#pragma unroll
      for (int j = 0; j < 4; j++) Ps[(fq * 4 + j) * 72 + nt * 16 + fr] = f2bf(pj[nt][j]);
    __builtin_amdgcn_fence(__ATOMIC_RELEASE, "wavefront");
    __builtin_amdgcn_wave_barrier();
    __builtin_amdgcn_fence(__ATOMIC_ACQUIRE, "wavefront");
    bf16x8 pf[2];
#pragma unroll
    for (int ks = 0; ks < 2; ks++) pf[ks] = *(const bf16x8*)(Ps + fr * 72 + ks * 32 + fq * 8);
#pragma unroll
    for (int nt = 0; nt < 4; nt++)
#pragma unroll
      for (int ks = 0; ks < 2; ks++) {
        bf16x8 vf = *(const bf16x8*)(vt + (size_t)(nt * 16 + fr) * 256 + ks * 32 + fq * 8);
        o[nt] = mfma16(pf[ks], vf, o[nt]);
      }
    __builtin_amdgcn_fence(__ATOMIC_RELEASE, "wavefront");
    __builtin_amdgcn_wave_barrier();
  }
#pragma unroll
  for (int j = 0; j < 4; j++) {
    const size_t row = qrow0 + qloc + fq * 4 + j;
    const float inv = frcp(lrow[j]);
#pragma unroll
    for (int nt = 0; nt < 4; nt++) {
      const int dcol = nt * 16 + fr;
      float g = silu_(bf2f(p.z[row * ZW + Z_NAG + h * 64 + dcol]));
      p.br[row * 1024 + 256 + h * 64 + dcol] = f2bf(o[nt][j] * inv * g);
    }
  }
  __syncthreads();
}

__device__ void gmlp_item(const Params& p, int l, size_t row0, int g, char* smem) {
  const int t = tid_op(), lane = t & 63, wave = t >> 6, fr = lane & 15, fq = lane >> 4;
  bf16_t* Ws = (bf16_t*)smem;
  bf16_t* VhT = Ws + 128 * 136;
  const float* ws = p.gm_ws + (size_t)(l * 4 + g) * 128 * 128;
#pragma unroll
  for (int i = 0; i < 16; i++) {
    int e = (i * NTHR + t) * 4;
    int pr = e >> 7, q = e & 127;
    float4 v = *(const float4*)(ws + e);
    *(uint2*)(Ws + pr * 136 + q) = make_uint2(pack2(v.x, v.y), pack2(v.z, v.w));
  }
  {
    const int q = t >> 1, half = t & 1;
    const bf16_t* zr = p.z + (row0 + q) * ZW + Z_GMV + g * 64 + half * 32;
    float v[32];
#pragma unroll
    for (int i = 0; i < 4; i++) { uint4 u = *(const uint4*)(zr + i * 8); unpack8(u, v + i * 8); }
    float sum = 0.f;
#pragma unroll
    for (int i = 0; i < 32; i++) { v[i] = gelu_(v[i]); sum += v[i]; }
    sum += dppf<0xB1>(sum);
    const float mu = sum * (1.f / 64.f);
    float vs = 0.f;
#pragma unroll
    for (int i = 0; i < 32; i++) { float dd = v[i] - mu; vs += dd * dd; }
    vs += dppf<0xB1>(vs);
    const float rs = rsqrtf(vs * (1.f / 64.f) + 1e-6f);
    const float* lg = p.gm_ln_g + (l * 4 + g) * 64 + half * 32;
    const float* lb = p.gm_ln_b + (l * 4 + g) * 64 + half * 32;
#pragma unroll
    for (int i = 0; i < 32; i++) VhT[(half * 32 + i) * 136 + q] = f2bf((v[i] - mu) * rs * lg[i] + lb[i]);
  }
  __syncthreads();
  f32x4 acc[2][4];
#pragma unroll
  for (int mt = 0; mt < 2; mt++)
#pragma unroll
    for (int nt = 0; nt < 4; nt++) acc[mt][nt] = f32x4{0.f, 0.f, 0.f, 0.f};
#pragma unroll
  for (int ks = 0; ks < 4; ks++) {
    bf16x8 af[2], bfr[4];
#pragma unroll
    for (int mt = 0; mt < 2; mt++) af[mt] = *(const bf16x8*)(Ws + (wave * 32 + mt * 16 + fr) * 136 + ks * 32 + fq * 8);
#pragma unroll
    for (int nt = 0; nt < 4; nt++) bfr[nt] = *(const bf16x8*)(VhT + (nt * 16 + fr) * 136 + ks * 32 + fq * 8);
#pragma unroll
    for (int mt = 0; mt < 2; mt++)
#pragma unroll
      for (int nt = 0; nt < 4; nt++) acc[mt][nt] = mfma16(bfr[nt], af[mt], acc[mt][nt]);
  }
#pragma unroll
  for (int mt = 0; mt < 2; mt++) {
    const int pr = wave * 32 + mt * 16 + fr;
    const float bs = p.gm_bs[(l * 4 + g) * 128 + pr];
    const bf16_t* zr = p.z + (row0 + pr) * ZW;
#pragma unroll
    for (int nt = 0; nt < 4; nt++) {
      const int c = nt * 16 + fq * 4;
      uint2 uu = *(const uint2*)(zr + Z_GMU + g * 64 + c);
      uint2 gg = *(const uint2*)(zr + Z_GMG + g * 64 + c);
      float o0 = gelu_(bflo(uu.x)) * (acc[mt][nt][0] + bs) * silu_(bflo(gg.x));
      float o1 = gelu_(bfhi(uu.x)) * (acc[mt][nt][1] + bs) * silu_(bfhi(gg.x));
      float o2 = gelu_(bflo(uu.y)) * (acc[mt][nt][2] + bs) * silu_(bflo(gg.y));
      float o3 = gelu_(bfhi(uu.y)) * (acc[mt][nt][3] + bs) * silu_(bfhi(gg.y));
      *(uint2*)(p.br + (row0 + pr) * 1024 + g * 64 + c) = make_uint2(pack2(o0, o1), pack2(o2, o3));
    }
  }
  __syncthreads();
}

__device__ void pool_item(const Params& p, int l, size_t seqrow0, int T, int t0, int g, char* smem) {
  const int t = tid_op(), lane = t & 63, wave = t >> 6, fr = lane & 15, fq = lane >> 4;
  float* Pp = (float*)smem;
  bf16_t* Dd = (bf16_t*)(Pp + 80 * 64);
  bf16_t* WT = Dd + 64 * 72;
  const int hw = 1 << g;
  for (int i = t; i < 80 * 8; i += NTHR) {
    int rr = i >> 3, oc = i & 7;
    int tok = t0 - 8 + rr;
    float f[8];
    if (tok >= 0 && tok < T) { uint4 u = *(const uint4*)(p.z + (seqrow0 + tok) * ZW + Z_PLP + g * 64 + oc * 8); unpack8(u, f); }
    else {
#pragma unroll
      for (int k = 0; k < 8; k++) f[k] = 0.f;
    }
#pragma unroll
    for (int k = 0; k < 8; k++) Pp[rr * 64 + oc * 8 + k] = f[k];
  }
  {
    const float* w = p.pl_w + (size_t)(l * 4 + g) * 64 * 64;
#pragma unroll
    for (int i = 0; i < 16; i++) {
      int e = i * NTHR + t;
      int c = e >> 6, dd = e & 63;
      WT[dd * 72 + c] = f2bf(w[e]);
    }
  }
  __syncthreads();
  {
    const int c = t & 63, tq = t >> 6;
    for (int i = 0; i < 16; i++) {
      const int tl = tq * 16 + i;
      const int tok = t0 + tl;
      const int lo = max(tok - hw, 0), hi = min(tok + hw, T);
      float s = 0.f;
      for (int u = lo; u < hi; u++) s += Pp[(u - t0 + 8) * 64 + c];
      float dv = s / (float)(hi - lo) - Pp[(tl + 8) * 64 + c];
      Dd[tl * 72 + c] = f2bf(dv);
    }
  }
  __syncthreads();
  f32x4 acc[4];
#pragma unroll
  for (int nt = 0; nt < 4; nt++) acc[nt] = f32x4{0.f, 0.f, 0.f, 0.f};
#pragma unroll
  for (int ks = 0; ks < 2; ks++) {
    bf16x8 af = *(const bf16x8*)(Dd + (wave * 16 + fr) * 72 + ks * 32 + fq * 8);
#pragma unroll
    for (int nt = 0; nt < 4; nt++) {
      bf16x8 bw = *(const bf16x8*)(WT + (nt * 16 + fr) * 72 + ks * 32 + fq * 8);
      acc[nt] = mfma16(bw, af, acc[nt]);
    }
  }
  {
    const size_t row = seqrow0 + t0 + wave * 16 + fr;
#pragma unroll
    for (int nt = 0; nt < 4; nt++) {
      const int dd = g * 64 + nt * 16 + fq * 4;
      float4 sc = *(const float4*)(p.pl_scale + l * 256 + dd);
      uint2 gg = *(const uint2*)(p.z + row * ZW + Z_PLG + dd);
      float o0 = acc[nt][0] * sc.x * silu_(bflo(gg.x));
      float o1 = acc[nt][1] * sc.y * silu_(bfhi(gg.x));
      float o2 = acc[nt][2] * sc.z * silu_(bflo(gg.y));
      float o3 = acc[nt][3] * sc.w * silu_(bfhi(gg.y));
      *(uint2*)(p.br + row * 1024 + 768 + dd) = make_uint2(pack2(o0, o1), pack2(o2, o3));
    }
  }
  __syncthreads();
}


constexpr unsigned ROLE_IDLE = 0xFFFF0001u, ROLE_WORK = 0x10000u;
__device__ void publish_cu(const Params& p) {
  if (threadIdx.x == 0 && gridDim.x == 512) {
    unsigned hw = __builtin_amdgcn_s_getreg(63492);
    unsigned xcc = __builtin_amdgcn_s_getreg(63508);
    p.cuinfo[blockIdx.x] = ((xcc & 0xfu) << 16) | (hw & 0xff00u);
  }
}
__device__ void compute_roles(const Params& p, char* smem) {
  const int t = tid_op();
  if (gridDim.x != 512) { if (t == 0) p.cuinfo[1024] = 1u; return; }
  unsigned* keys = (unsigned*)smem;
  unsigned* mate = keys + 512;
  unsigned* prim = mate + 512;
  for (int i = t; i < 512; i += NTHR) keys[i] = p.cuinfo[i];
  __syncthreads();
  int bad = 0;
  for (int i = t; i < 512; i += NTHR) {
    int cnt = 0, m = 0;
    for (int j = 0; j < 512; j++) if (j != i && keys[j] == keys[i]) { cnt++; m = j; }
    if (cnt != 1) bad = 1;
    mate[i] = (unsigned)m;
    prim[i] = (cnt == 1 && i < m) ? 1u : 0u;
  }
  bad = __syncthreads_or(bad);
  for (int i = t; i < 512; i += NTHR) {
    const int pi = prim[i] ? i : (int)mate[i];
    int rank = 0;
    for (int j = 0; j < pi; j++) rank += (int)prim[j];
    unsigned role;
    if (rank < 128) role = prim[i] ? (unsigned)rank : ROLE_IDLE;
    else role = ROLE_WORK + (unsigned)((rank - 128) * 2 + (prim[i] ? 0 : 1));
    p.cuinfo[512 + i] = role;
  }
  if (t == 0) p.cuinfo[1024] = bad ? 1u : 0u;
  __syncthreads();
}

__device__ void worker_barrier(unsigned* cnt, unsigned target) {
  asm volatile("s_waitcnt vmcnt(0)" ::: "memory");
  __syncthreads();
  if (threadIdx.x == 0) {
    __builtin_amdgcn_fence(__ATOMIC_RELEASE, "agent");
    atomicAdd(cnt, 1u);
    while (__hip_atomic_load(cnt, __ATOMIC_RELAXED, __HIP_MEMORY_SCOPE_AGENT) < target) __builtin_amdgcn_s_sleep(2);
    __builtin_amdgcn_fence(__ATOMIC_ACQUIRE, "agent");
    asm volatile("s_waitcnt vmcnt(0)" ::: "memory");
  }
  __syncthreads();
}
__device__ void phase_mix(const Params& p, int l, char* smem, int cslot) {
  __shared__ unsigned s_item;
  if (!(cslot & 4)) for (int it = blockIdx.x; it < 128; it += gridDim.x) scan_item(p, l, it, smem);
  cslot &= 3;
  const int n_na = 2048, n_ca = (l == 0 ? 128 : 0), n_gm = 1024, n_gc = (l == 0 ? 64 : 0), n_pl = 2048, n_pc = (l == 0 ? 128 : 0);
  const int total = n_na + n_ca + n_gm + n_gc + n_pl + n_pc;
  while (true) {
    if (threadIdx.x == 0) s_item = atomicAdd(p.ctr + cslot, 1u);
    __syncthreads();
    int it = (int)s_item;
    __syncthreads();
    if (it >= total) break;
    if (it < n_na) {
      int r = it & 63, h = (it >> 6) & 3, b = it >> 8;
      natten_item(p, l, b, h, (size_t)b * SEQ + r * 64, 8, r, smem);
      continue;
    }
    it -= n_na;
    if (it < n_ca) {
      int qt = it & 3, h = (it >> 2) & 3, b = it >> 4;
      natten_item(p, l, b, h, (size_t)NLAT + b * CTXL + qt * 64, 0, 0, smem);
      continue;
    }
    it -= n_ca;
    if (it < n_gm) {
      int g = it & 3, ch = (it >> 2) & 31, b = it >> 7;
      gmlp_item(p, l, (size_t)b * SEQ + ch * 128, g, smem);
      continue;
    }
    it -= n_gm;
    if (it < n_gc) {
      int g = it & 3, ch = (it >> 2) & 1, b = it >> 3;
      gmlp_item(p, l, (size_t)NLAT + b * CTXL + ch * 128, g, smem);
      continue;
    }
    it -= n_gc;
    if (it < n_pl) {
      int g = it & 3, tl = (it >> 2) & 63, b = it >> 8;
      pool_item(p, l, (size_t)b * SEQ, SEQ, tl * 64, g, smem);
      continue;
    }
    it -= n_pl;
    {
      int g = it & 3, tl = (it >> 2) & 3, b = it >> 4;
      pool_item(p, l, (size_t)NLAT + b * CTXL, CTXL, tl * 64, g, smem);
    }
  }
}

__device__ void phase_rwfin(const Params& p, int l) {
  const int t_ = tid_op();
  const int lane = t_ & 63;
  const int gw = blockIdx.x * 4 + (t_ >> 6), nw = gridDim.x * 4;
  const int nrow = (l == 0 ? NTOK : NLAT);
  const int hh = lane >> 4, c0 = lane * 4;
  float4 gg = *(const float4*)(p.rw_gn_g + l * 256 + c0);
  float4 gb = *(const float4*)(p.rw_gn_b + l * 256 + c0);
  for (int r = gw; r < nrow; r += nw) {
    float4 y0 = *(const float4*)(p.yscan + (size_t)r * 256 + c0);
    float4 y1 = *(const float4*)(p.yscan + ((size_t)NTOK + r) * 256 + c0);
    float o0 = y0.x + y1.x, o1 = y0.y + y1.y, o2 = y0.z + y1.z, o3 = y0.w + y1.w;
    float mu = red16_sum(o0 + o1 + o2 + o3) * (1.f / 64.f);
    float d0 = o0 - mu, d1 = o1 - mu, d2 = o2 - mu, d3 = o3 - mu;
    float var = red16_sum(d0 * d0 + d1 * d1 + d2 * d2 + d3 * d3) * (1.f / 64.f);
    float rs = rsqrtf(var + 64e-5f);
    float cf = p.coef[(size_t)r * 4 + hh] + p.coef[((size_t)NTOK + r) * 4 + hh];
    uint2 vm = *(const uint2*)(p.vmix + (size_t)r * 256 + c0);
    uint2 zg = *(const uint2*)(p.z + (size_t)r * ZW + Z_RWG + c0);
    float r0 = (d0 * rs * gg.x + gb.x + cf * bflo(vm.x)) * silu_(bflo(zg.x));
    float r1 = (d1 * rs * gg.y + gb.y + cf * bfhi(vm.x)) * silu_(bfhi(zg.x));
    float r2 = (d2 * rs * gg.z + gb.z + cf * bflo(vm.y)) * silu_(bflo(zg.y));
    float r3 = (d3 * rs * gg.w + gb.w + cf * bfhi(vm.y)) * silu_(bfhi(zg.y));
    *(uint2*)(p.br + (size_t)r * 1024 + 512 + c0) = make_uint2(pack2(r0, r1), pack2(r2, r3));
  }
}

__device__ __forceinline__ void gsync(cg::grid_group& grid) {
  asm volatile("s_waitcnt vmcnt(0)" ::: "memory");
  grid.sync();
}

#define XB_XCNT(j) (64 * (j))
#define XB_XSUB(j) (1024 + 64 * (j))
#define XB_XGEN(j) (2048 + 64 * (j))
#define XB_TOP 3072
#define XB_TOPGEN 3136
constexpr int XB_WORDS = 3200;
__device__ __forceinline__ unsigned xb_ld(unsigned* q) { return __hip_atomic_load(q, __ATOMIC_RELAXED, __HIP_MEMORY_SCOPE_AGENT); }
__device__ __forceinline__ unsigned xb_add(unsigned* q, unsigned v) { return __hip_atomic_fetch_add(q, v, __ATOMIC_RELAXED, __HIP_MEMORY_SCOPE_AGENT); }
#define XB_SPIN(cond) do { unsigned _sp = 0; while (cond) { __builtin_amdgcn_s_sleep(1); if (++_sp > (1u << 24)) break; } } while (0)
__device__ __forceinline__ void xsync(unsigned* bar, volatile unsigned* st) {
  asm volatile("s_waitcnt vmcnt(0)" ::: "memory");
  __syncthreads();
  if (threadIdx.x == 0) {
    __builtin_amdgcn_s_waitcnt(0);
    const unsigned nloc = st[0], nx = st[1], x = st[2];
    const unsigned old = xb_add(&bar[XB_XSUB(x)], 1u);
    const unsigned gen = old / nloc;
    if (old + 1u == (gen + 1u) * nloc) {
      __builtin_amdgcn_fence(__ATOMIC_RELEASE, "agent");
      asm volatile("s_waitcnt vmcnt(0)" ::: "memory");
      const unsigned og = xb_add(&bar[XB_TOP], 1u);
      const unsigned tg = og / nx;
      if (og + 1u == (tg + 1u) * nx) xb_add(&bar[XB_TOPGEN], 1u);
      else XB_SPIN(xb_ld(&bar[XB_TOPGEN]) == tg);
      __builtin_amdgcn_fence(__ATOMIC_ACQUIRE, "agent");
      xb_add(&bar[XB_XGEN(x)], 1u);
      asm volatile("s_waitcnt vmcnt(0)" ::: "memory");
    } else {
      XB_SPIN(xb_ld(&bar[XB_XGEN(x)]) == gen);
      __builtin_amdgcn_fence(__ATOMIC_ACQUIRE, "agent");
      asm volatile("s_waitcnt vmcnt(0)" ::: "memory");
    }
  }
  __syncthreads();
}
__global__ void __launch_bounds__(NTHR, 2) hybrid_mega(Params p) {
  extern __shared__ __attribute__((aligned(16))) char smem[];
  cg::grid_group grid = cg::this_grid();
  __shared__ unsigned xb_st[4];
  const unsigned my_xcc = (unsigned)__builtin_amdgcn_s_getreg((3 << 11) | 20) & 0xFu;
  if (threadIdx.x == 0) (void)xb_add(&p.xbar[XB_XCNT(my_xcc)], 1u);
  publish_cu(p);
  phase0(p, smem);
  if (p.xbar == nullptr) gsync(grid);
  if (threadIdx.x == 0) {
    unsigned mine = 0, cnt = 0, sum = 0, sp = 0;
    for (;;) {
      mine = 0; cnt = 0; sum = 0;
      for (unsigned j = 0; j < 16; j++) { const unsigned c = xb_ld(&p.xbar[XB_XCNT(j)]); sum += c; cnt += c > 0u ? 1u : 0u; mine = j == my_xcc ? c : mine; }
      if (sum == gridDim.x || ++sp > (1u << 22)) break;
      __builtin_amdgcn_s_sleep(1);
    }
    xb_st[0] = mine > 0u ? mine : 1u; xb_st[1] = cnt > 0u ? cnt : 1u; xb_st[2] = my_xcc;
  }
  __syncthreads();
  xsync(p.xbar, xb_st);
  if (blockIdx.x == 0) compute_roles(p, smem);
#pragma unroll 1
  for (int l = 0; l < 2; l++) {
    phase_norm(p, l, l == 0 ? p.x : p.out, l == 0 ? p.ctx : p.ctx1);
    xsync(p.xbar, xb_st);
    const bool overlap = (gridDim.x == 512) && (p.cuinfo[1024] == 0u);
    phase_g1(p, l, smem, overlap ? 1 : 0, -1, 0);
    xsync(p.xbar, xb_st);
    {
      if (overlap) {
        const unsigned role = p.cuinfo[512 + blockIdx.x];
        if (role < 128u) scan_item(p, l, (int)role, smem);
        else if (role >= ROLE_WORK && role < ROLE_WORK + 256u) {
          phase_g1(p, l, smem, 2, (int)(role - ROLE_WORK), 256);
          worker_barrier(p.ctr + 4 + l, 256u);
          phase_mix(p, l, smem, l | 4);
        }
      } else {
        for (int it = blockIdx.x; it < 128; it += gridDim.x) scan_item(p, l, it, smem);
      }
      xsync(p.xbar, xb_st);
      if (!overlap) phase_mix(p, l, smem, l | 4);
      phase_rwfin(p, l);
      xsync(p.xbar, xb_st);
    }
    phase_g2(p, l, smem);
    xsync(p.xbar, xb_st);
    if (DUP_MASK & 2) { phase_g2(p, l, smem); xsync(p.xbar, xb_st); }
    phase_g3(p, l, smem);
    xsync(p.xbar, xb_st);
    if ((DUP_MASK & 8) && l == 0) { phase_g3(p, l, smem); xsync(p.xbar, xb_st); }
  }
  phase_final(p);
}

extern "C" void kernel_launch(void* const* d_in, const int* in_sizes, int n_in, void* d_out, int out_size, void* d_ws,
                              size_t ws_size, hipStream_t stream) {
  static int grid_blocks = 0;
  if (!grid_blocks) {
    int dev = 0, cus = 0, per_cu = 0;
    hipGetDevice(&dev);
    hipDeviceGetAttribute(&cus, hipDeviceAttributeMultiprocessorCount, dev);
    hipFuncSetAttribute((const void*)hybrid_mega, hipFuncAttributeMaxDynamicSharedMemorySize, LDS_BYTES);
    hipOccupancyMaxActiveBlocksPerMultiprocessor(&per_cu, hybrid_mega, NTHR, LDS_BYTES);
    if (per_cu > 2) per_cu = 2;
    if (per_cu < 1) per_cu = 1;
    grid_blocks = cus * per_cu;
  }
  Params p{};
  const float* const* in = (const float* const*)d_in;
  p.x = in[0]; p.c = in[1]; p.ctx = in[2]; p.c_ctx = in[3]; p.ada_w = in[4]; p.ada_b = in[5]; p.norm_g = in[6]; p.w_in = in[7];
  p.gm_ln_g = in[8]; p.gm_ln_b = in[9]; p.gm_ws = in[10]; p.gm_bs = in[11]; p.na_rpb = in[12]; p.rw_mu = in[13]; p.rw_w0 = in[14];
  p.rw_w2 = in[15]; p.rw_a0 = in[16]; p.rw_a2 = in[17]; p.rw_kk = in[18]; p.rw_ka = in[19]; p.rw_rk = in[20]; p.rw_gn_g = in[21];
  p.rw_gn_b = in[22]; p.pl_w = in[23]; p.pl_scale = in[24]; p.w_br = in[25]; p.w_out = in[26]; p.final_g = in[27];
  p.out = (float*)d_out;
  char* w = (char*)d_ws;
  size_t off = 0;
  auto take = [&](size_t bytes) { char* r = w + off; off += (bytes + 255) & ~(size_t)255; return r; };
  p.ctr = (unsigned*)take(256);
  p.cuinfo = (unsigned*)take(8192);
  p.xbar = (unsigned*)take(XB_WORDS * 4);
  p.mod = (float*)take((size_t)2 * 9 * 3072 * 4);
  p.WtIn = (bf16_t*)take((size_t)2 * INC * 1024 * 2);
  p.WtBr = (bf16_t*)take((size_t)2 * 4 * 1024 * 256 * 2);
  p.WtOut = (bf16_t*)take((size_t)2 * 1024 * 1024 * 2);
  p.h = (bf16_t*)take((size_t)NTOK * 1024 * 2);
  p.z = (bf16_t*)take((size_t)NTOK * ZW * 2);
  p.zvT = (bf16_t*)take((size_t)NB * 256 * SEQ * 2);
  p.zvTc = (bf16_t*)take((size_t)NB * 256 * CTXL * 2);
  p.br = (bf16_t*)take((size_t)NTOK * 1024 * 2);
  p.yscan = (float*)take((size_t)2 * NTOK * 256 * 4);
  p.vmix = (bf16_t*)take((size_t)NTOK * 256 * 2);
  p.coef = (float*)take((size_t)2 * NTOK * 4 * 4);
  p.ctx1 = (float*)take((size_t)NCTX * 1024 * 4);
  if (off > ws_size) fprintf(stderr, "workspace too small: need %zu have %zu\n", off, ws_size);
  hipMemsetAsync(p.xbar, 0, XB_WORDS * 4, stream);
  void* args[] = {&p};
  hipError_t e = hipLaunchCooperativeKernel((const void*)hybrid_mega, dim3(grid_blocks), dim3(NTHR), args, LDS_BYTES, stream);
  if (e != hipSuccess) fprintf(stderr, "cooperative launch failed: %s (grid %d)\n", hipGetErrorString(e), grid_blocks);
}
```

```cpp
#include <hip/hip_runtime.h>
#include <hip/hip_cooperative_groups.h>
#include <cstdio>
namespace cg = cooperative_groups;

typedef unsigned short bf16_t;
using bf16x8 = __attribute__((ext_vector_type(8))) short;
using f32x4 = __attribute__((ext_vector_type(4))) float;

constexpr int D = 1024;
constexpr int NB = 8;
constexpr int SEQ = 4096;
constexpr int CTXL = 256;
constexpr int NLAT = NB * SEQ;
constexpr int NCTX = NB * CTXL;
constexpr int NTOK = NLAT + NCTX;
constexpr int INC = 7552;
constexpr int ZW = 3200;
constexpr int Z_GMU = 0, Z_GMV = 256, Z_GMG = 512, Z_NAQ = 768, Z_NAK = 1024, Z_NAG = 1280;
constexpr int Z_RWR = 1536, Z_RWK = 1792, Z_RWV = 2048, Z_RWW = 2304, Z_RWA = 2368, Z_RWG = 2432, Z_PLP = 2688, Z_PLG = 2944;
constexpr int LDS_BYTES = 73728;
constexpr int NTHR = 256;
#ifndef DUP_MASK
#define DUP_MASK 0
#endif

struct Params {
  const float *x, *c, *ctx, *c_ctx, *ada_w, *ada_b, *norm_g, *w_in, *gm_ln_g, *gm_ln_b, *gm_ws, *gm_bs, *na_rpb,
      *rw_mu, *rw_w0, *rw_w2, *rw_a0, *rw_a2, *rw_kk, *rw_ka, *rw_rk, *rw_gn_g, *rw_gn_b, *pl_w, *pl_scale, *w_br, *w_out, *final_g;
  float* out;
  bf16_t *WtIn, *WtBr, *WtOut, *h, *z, *zvT, *zvTc, *br, *vmix;
  float *mod, *yscan, *coef, *ctx1;
  unsigned* ctr;
  unsigned* xbar;
  unsigned* cuinfo;
};

__device__ __forceinline__ bf16_t f2bf(float f) {
  unsigned u = __float_as_uint(f);
  u += 0x7fffu + ((u >> 16) & 1u);
  return (bf16_t)(u >> 16);
}
__device__ __forceinline__ float bf2f(unsigned v) { return __uint_as_float(v << 16); }
__device__ __forceinline__ unsigned pack2(float a, float b) { return (unsigned)f2bf(a) | ((unsigned)f2bf(b) << 16); }
__device__ __forceinline__ float bflo(unsigned w) { return __uint_as_float(w << 16); }
__device__ __forceinline__ float bfhi(unsigned w) { return __uint_as_float(w & 0xffff0000u); }
__device__ __forceinline__ float frcp(float x) { return __builtin_amdgcn_rcpf(x); }
__device__ __forceinline__ float sigm(float x) { return frcp(1.f + __expf(-x)); }
__device__ __forceinline__ float silu_(float x) { return x * frcp(1.f + __expf(-x)); }
__device__ __forceinline__ float gelu_(float x) {
  float u = 1.5957691216f * (x + 0.044715f * x * x * x);
  return x * frcp(1.f + __expf(-u));
}
template <int CTRL>
__device__ __forceinline__ float dppf(float v) {
  return __int_as_float(__builtin_amdgcn_update_dpp(0, __float_as_int(v), CTRL, 0xf, 0xf, false));
}
__device__ __forceinline__ float red16_sum(float v) {
  v += dppf<0xB1>(v); v += dppf<0x4E>(v); v += dppf<0x141>(v); v += dppf<0x140>(v); return v;
}
__device__ __forceinline__ void red16_sum2(float& a, float& b) {
  a += dppf<0xB1>(a); asm volatile("" : "+v"(a));
  b += dppf<0xB1>(b); asm volatile("" : "+v"(b));
  a += dppf<0x4E>(a); asm volatile("" : "+v"(a));
  b += dppf<0x4E>(b); asm volatile("" : "+v"(b));
  a += dppf<0x141>(a); asm volatile("" : "+v"(a));
  b += dppf<0x141>(b); asm volatile("" : "+v"(b));
  a += dppf<0x140>(a); asm volatile("" : "+v"(a));
  b += dppf<0x140>(b); asm volatile("" : "+v"(b));
}
__device__ __forceinline__ float red16_max(float v) {
  v = fmaxf(v, dppf<0xB1>(v)); v = fmaxf(v, dppf<0x4E>(v)); v = fmaxf(v, dppf<0x141>(v)); v = fmaxf(v, dppf<0x140>(v)); return v;
}
__device__ __forceinline__ float red8_sum(float v) {
  v += dppf<0xB1>(v); v += dppf<0x4E>(v); v += dppf<0x141>(v); return v;
}
__device__ __forceinline__ float wave_sum(float v) {
#pragma unroll
  for (int o = 32; o > 0; o >>= 1) v += __shfl_xor(v, o);
  return v;
}
__device__ __forceinline__ int tid_op() {
  int t = threadIdx.x;
  asm volatile("" : "+v"(t));
  return t;
}
__device__ __forceinline__ void lds_barrier() {
  asm volatile("s_waitcnt lgkmcnt(0)" ::: "memory");
  __builtin_amdgcn_s_barrier();
  asm volatile("" ::: "memory");
}
__device__ __forceinline__ f32x4 mfma16(bf16x8 a, bf16x8 b, f32x4 c) {
  return __builtin_amdgcn_mfma_f32_16x16x32_bf16(a, b, c, 0, 0, 0);
}
__device__ __forceinline__ void unpack8(uint4 v, float* f) {
  f[0] = bflo(v.x); f[1] = bfhi(v.x); f[2] = bflo(v.y); f[3] = bfhi(v.y);
  f[4] = bflo(v.z); f[5] = bfhi(v.z); f[6] = bflo(v.w); f[7] = bfhi(v.w);
}

__device__ void transpose_tile(const float* __restrict__ src, int N, bf16_t* __restrict__ dst, int K, int k0, int n0, float* tile) {
  const int t = tid_op();
  const int r = t >> 4, c4 = (t & 15) * 4;
#pragma unroll
  for (int i = 0; i < 4; i++) {
    int k = r + 16 * i;
    float4 v = *(const float4*)(src + (size_t)(k0 + k) * N + n0 + c4);
    tile[k * 65 + c4 + 0] = v.x; tile[k * 65 + c4 + 1] = v.y; tile[k * 65 + c4 + 2] = v.z; tile[k * 65 + c4 + 3] = v.w;
  }
  __syncthreads();
  const int n = t >> 2, ks = (t & 3) * 16;
  unsigned pk[8];
#pragma unroll
  for (int i = 0; i < 8; i++) pk[i] = pack2(tile[(ks + 2 * i) * 65 + n], tile[(ks + 2 * i + 1) * 65 + n]);
  uint4* dp = (uint4*)(dst + (size_t)(n0 + n) * K + k0 + ks);
  dp[0] = make_uint4(pk[0], pk[1], pk[2], pk[3]);
  dp[1] = make_uint4(pk[4], pk[5], pk[6], pk[7]);
  __syncthreads();
}

__device__ void mod_item(const Params& p, int l, int jc, char* smem) {
  float* sil = (float*)smem;
  float* red = sil + 9 * 1024;
  const int t = tid_op();
  for (int i = t; i < 9 * 1024; i += NTHR) {
    int r = i >> 10, k = i & 1023;
    float v = r < 8 ? p.c[r * 1024 + k] : p.c_ctx[k];
    sil[i] = silu_(v);
  }
  __syncthreads();
  const int col = t & 63, q = t >> 6;
  float acc[9];
#pragma unroll
  for (int r = 0; r < 9; r++) acc[r] = 0.f;
  const float* w = p.ada_w + (size_t)l * 1024 * 3072 + jc * 64 + col;
  for (int k = q * 256; k < q * 256 + 256; k++) {
    float wv = w[(size_t)k * 3072];
#pragma unroll
    for (int r = 0; r < 9; r++) acc[r] += sil[r * 1024 + k] * wv;
  }
#pragma unroll
  for (int r = 0; r < 9; r++) red[(q * 9 + r) * 64 + col] = acc[r];
  __syncthreads();
  if (t < 64) {
    float bb = p.ada_b[l * 3072 + jc * 64 + t];
#pragma unroll
    for (int r = 0; r < 9; r++) {
      float s = red[(0 * 9 + r) * 64 + t] + red[(1 * 9 + r) * 64 + t] + red[(2 * 9 + r) * 64 + t] + red[(3 * 9 + r) * 64 + t];
      p.mod[(l * 9 + r) * 3072 + jc * 64 + t] = s + bb;
    }
  }
  __syncthreads();
}

__device__ void phase0(const Params& p, char* smem) {
  if (blockIdx.x == 0 && threadIdx.x < 8) p.ctr[threadIdx.x] = 0u;
  constexpr int PER_L = 2400 + 48;
  for (int it = blockIdx.x; it < 2 * PER_L; it += gridDim.x) {
    int l = it / PER_L, r = it % PER_L;
    if (r < 1888) {
      int kt = r & 15, nt = r >> 4;
      transpose_tile(p.w_in + (size_t)l * 1024 * INC, INC, p.WtIn + (size_t)l * INC * 1024, 1024, kt * 64, nt * 64, (float*)smem);
    } else if (r < 2144) {
      int q = r - 1888; int i = q >> 6; int kt = q & 3, nt = (q >> 2) & 15;
      transpose_tile(p.w_br + ((size_t)l * 4 + i) * 256 * 1024, 1024, p.WtBr + ((size_t)l * 4 + i) * 1024 * 256, 256, kt * 64, nt * 64, (float*)smem);
    } else if (r < 2400) {
      int q = r - 2144; int kt = q & 15, nt = q >> 4;
      transpose_tile(p.w_out + (size_t)l * 1024 * 1024, 1024, p.WtOut + (size_t)l * 1024 * 1024, 1024, kt * 64, nt * 64, (float*)smem);
    } else {
      mod_item(p, l, r - 2400, smem);
    }
  }
}

__device__ void phase_norm(const Params& p, int l, const float* xsrc, const float* csrc) {
  const int t_ = tid_op();
  const int lane = t_ & 63;
  const int gw = blockIdx.x * 4 + (t_ >> 6), nw = gridDim.x * 4;
  const float* g = p.norm_g + l * 1024;
  for (int r = gw; r < NTOK; r += nw) {
    const float* src; int mb;
    if (r < NLAT) { src = xsrc + (size_t)r * 1024; mb = r >> 12; } else { src = csrc + (size_t)(r - NLAT) * 1024; mb = 8; }
    const float* md = p.mod + (l * 9 + mb) * 3072;
    float4 v[4]; float ss = 0.f;
#pragma unroll
    for (int i = 0; i < 4; i++) {
      v[i] = *(const float4*)(src + lane * 4 + 256 * i);
      ss += v[i].x * v[i].x + v[i].y * v[i].y + v[i].z * v[i].z + v[i].w * v[i].w;
    }
    ss = wave_sum(ss);
    float rs = rsqrtf(ss * (1.f / 1024.f) + 1e-6f);
#pragma unroll
    for (int i = 0; i < 4; i++) {
      int col = lane * 4 + 256 * i;
      float4 gg = *(const float4*)(g + col);
      float4 sh = *(const float4*)(md + col);
      float4 sc = *(const float4*)(md + 1024 + col);
      float a0 = v[i].x * rs * gg.x * (1.f + sc.x) + sh.x;
      float a1 = v[i].y * rs * gg.y * (1.f + sc.y) + sh.y;
      float a2 = v[i].z * rs * gg.z * (1.f + sc.z) + sh.z;
      float a3 = v[i].w * rs * gg.w * (1.f + sc.w) + sh.w;
      *(uint2*)(p.h + (size_t)r * 1024 + col) = make_uint2(pack2(a0, a1), pack2(a2, a3));
    }
  }
}

__device__ void phase_final(const Params& p) {
  const int t_ = tid_op();
  const int lane = t_ & 63;
  const int gw = blockIdx.x * 4 + (t_ >> 6), nw = gridDim.x * 4;
  for (int r = gw; r < NLAT; r += nw) {
    float* src = p.out + (size_t)r * 1024;
    float4 v[4]; float ss = 0.f;
#pragma unroll
    for (int i = 0; i < 4; i++) {
      v[i] = *(const float4*)(src + lane * 4 + 256 * i);
      ss += v[i].x * v[i].x + v[i].y * v[i].y + v[i].z * v[i].z + v[i].w * v[i].w;
    }
    ss = wave_sum(ss);
    float rs = rsqrtf(ss * (1.f / 1024.f) + 1e-6f);
#pragma unroll
    for (int i = 0; i < 4; i++) {
      int col = lane * 4 + 256 * i;
      float4 gg = *(const float4*)(p.final_g + col);
      float4 o = make_float4(v[i].x * rs * gg.x, v[i].y * rs * gg.y, v[i].z * rs * gg.z, v[i].w * rs * gg.w);
      *(float4*)(src + col) = o;
    }
  }
}

template <int NT, bool SWAP>
__device__ __forceinline__ void gemm_compute(const bf16_t* a_s, const bf16_t* b_s, int o0, f32x4 (&acc)[4][NT]) {
#pragma unroll
  for (int ks = 0; ks < 2; ks++) {
    const int off = ks == 0 ? o0 : (o0 ^ 32);
    bf16x8 af[4], bfr[NT];
#pragma unroll
    for (int mt = 0; mt < 4; mt++) af[mt] = *(const bf16x8*)(a_s + mt * 16 * 64 + off);
#pragma unroll
    for (int nt = 0; nt < NT; nt++) bfr[nt] = *(const bf16x8*)(b_s + nt * 16 * 64 + off);
#pragma unroll
    for (int mt = 0; mt < 4; mt++)
#pragma unroll
      for (int nt = 0; nt < NT; nt++)
        acc[mt][nt] = SWAP ? mfma16(bfr[nt], af[mt], acc[mt][nt]) : mfma16(af[mt], bfr[nt], acc[mt][nt]);
  }
}

template <int NT, bool SWAP, int DEEP = 2>
__device__ __forceinline__ void gemm_mainloop(const bf16_t* __restrict__ A, int lda, const bf16_t* __restrict__ Bm, int ldb,
                                              int nk, f32x4 (&acc)[4][NT], bf16_t* sm) {
  constexpr int ASZ = 128 * 64, BSZ = NT * 32 * 64;
  bf16_t* sA = sm;
  bf16_t* sB = sm + 2 * ASZ;
  const int t = tid_op(), lane = t & 63, wave = t >> 6, wm = wave >> 1, wn = wave & 1;
  const int lr = t >> 3, lc = (t & 7) * 8;
  const int lcs = ((t & 7) ^ ((lr >> 1) & 7)) * 8;
  const int fr = lane & 15, fq = lane >> 4;
  uint4 p0a0, p0a1, p0a2, p0a3, p0b0, p0b1, p0b2, p0b3;
  uint4 p1a0, p1a1, p1a2, p1a3, p1b0, p1b1, p1b2, p1b3;
  p0b2 = p0b3 = p1b2 = p1b3 = make_uint4(0, 0, 0, 0);
  const bf16_t* Ap = A + (size_t)lr * lda + lc;
  const bf16_t* Bp = Bm + (size_t)lr * ldb + lc;
#define GLD(P, R, I, KT) *(const uint4*)(P + (size_t)(32 * I) * R + (KT) * 64)
#define GLOAD(S, KT)                                                         \
  {                                                                          \
    S##a0 = GLD(Ap, lda, 0, KT); S##a1 = GLD(Ap, lda, 1, KT);                \
    S##a2 = GLD(Ap, lda, 2, KT); S##a3 = GLD(Ap, lda, 3, KT);                \
    S##b0 = GLD(Bp, ldb, 0, KT); S##b1 = GLD(Bp, ldb, 1, KT);                \
    if constexpr (NT == 4) { S##b2 = GLD(Bp, ldb, 2, KT); S##b3 = GLD(Bp, ldb, 3, KT); } \
  }
#define SST(BASE, I) *(uint4*)(BASE + (lr + 32 * I) * 64 + lcs)
#define SWRITE(S, BUF)                                                       \
  {                                                                          \
    SST(sA + (BUF) * ASZ, 0) = S##a0; SST(sA + (BUF) * ASZ, 1) = S##a1;      \
    SST(sA + (BUF) * ASZ, 2) = S##a2; SST(sA + (BUF) * ASZ, 3) = S##a3;      \
    SST(sB + (BUF) * BSZ, 0) = S##b0; SST(sB + (BUF) * BSZ, 1) = S##b1;      \
    if constexpr (NT == 4) { SST(sB + (BUF) * BSZ, 2) = S##b2; SST(sB + (BUF) * BSZ, 3) = S##b3; } \
  }
  const bf16_t* a_s0 = sA + (wm * 64 + fr) * 64;
  const bf16_t* b_s0 = sB + (wn * (NT * 16) + fr) * 64;
  const int o0 = (fq ^ ((fr >> 1) & 7)) * 8;
  if (DEEP == 2) {
    GLOAD(p0, 0);
    GLOAD(p1, 1);
    SWRITE(p0, 0);
    __syncthreads();
#pragma unroll 1
    for (int kt = 0; kt < nk; kt += 2) {
      const bool m2 = kt + 2 < nk;
      if (m2) GLOAD(p0, kt + 2);
      gemm_compute<NT, SWAP>(a_s0, b_s0, o0, acc);
      SWRITE(p1, 1);
      __syncthreads();
      if (m2) GLOAD(p1, kt + 3);
      gemm_compute<NT, SWAP>(a_s0 + ASZ, b_s0 + BSZ, o0, acc);
      if (m2) SWRITE(p0, 0);
      __syncthreads();
    }
  } else {
    GLOAD(p0, 0);
    SWRITE(p0, 0);
    __syncthreads();
#pragma unroll 1
    for (int kt = 0; kt < nk; kt += 2) {
      const bool m2 = kt + 2 < nk;
      GLOAD(p0, kt + 1);
      gemm_compute<NT, SWAP>(a_s0, b_s0, o0, acc);
      SWRITE(p0, 1);
      __syncthreads();
      if (m2) GLOAD(p0, kt + 2);
      gemm_compute<NT, SWAP>(a_s0 + ASZ, b_s0 + BSZ, o0, acc);
      if (m2) SWRITE(p0, 0);
      __syncthreads();
    }
  }
#undef GLOAD
#undef SWRITE
#undef GLD
#undef SST
}

template <int NT>
__device__ __forceinline__ void zero_acc(f32x4 (&acc)[4][NT]) {
#pragma unroll
  for (int i = 0; i < 4; i++)
#pragma unroll
    for (int j = 0; j < NT; j++) acc[i][j] = f32x4{0.f, 0.f, 0.f, 0.f};
}

struct TileIter {
  int total, TN, per_x, base, lim, nslot, slot;
  __device__ __forceinline__ void init(int TM, int TN_, int vb = -1, int nvb = 0) {
    TN = TN_; total = TM * TN_;
    const int nx = 8;
    if (vb < 0) { vb = blockIdx.x; nvb = gridDim.x; }
    per_x = (total + nx - 1) / nx;
    const int xcd = vb % nx;
    slot = vb / nx;
    nslot = (nvb + nx - 1) / nx;
    base = xcd * per_x;
    lim = min(total, base + per_x);
  }
  __device__ __forceinline__ bool get(int iter, int& m, int& n) const {
    const int T = base + iter * nslot + slot;
    if (T >= lim) return false;
    const int grp = T / (8 * TN), r = T % (8 * TN);
    m = grp * 8 + (r & 7); n = r >> 3;
    return true;
  }
};

__device__ void phase_g1(const Params& p, int l, char* smem, int part, int vb, int nvb) {
  const int t_ = tid_op(); const int lane = t_ & 63, wave = t_ >> 6, wm = wave >> 1, wn = wave & 1, fr = lane & 15, fq = lane >> 4;
  const bf16_t* W = p.WtIn + (size_t)l * INC * 1024;
  constexpr int NTILE_N = 27, NTILE_M = NTOK / 128;
  TileIter ti; ti.init(NTILE_M, part == 0 ? NTILE_N : part == 1 ? 7 : 20, vb, nvb);
  for (int iter = 0;; iter++) {
    int mtile, ntile;
    if (!ti.get(iter, mtile, ntile)) break;
    if (part == 1) ntile += 14; else if (part == 2) ntile = ntile < 14 ? ntile : ntile + 7;
    const int m0 = mtile * 128, n0 = ntile * 128;
    f32x4 acc[4][4];
    zero_acc<4>(acc);
    if (ntile == 10 || ntile == 11) {
      gemm_mainloop<4, false>(p.h + (size_t)m0 * 1024, 1024, W + (size_t)n0 * 1024, 1024, 16, acc, (bf16_t*)smem);
#pragma unroll
      for (int mt = 0; mt < 4; mt++)
#pragma unroll
        for (int nt = 0; nt < 4; nt++) {
          int m = m0 + wm * 64 + mt * 16 + fq * 4;
          int ch = n0 + wn * 64 + nt * 16 + fr - 1280;
          bf16_t* dst;
          if (m0 < NLAT) { int b = m0 >> 12; dst = p.zvT + ((size_t)(b * 256 + ch)) * 4096 + (m - b * 4096); }
          else { int mm = m - NLAT; int b = mm >> 8; dst = p.zvTc + ((size_t)(b * 256 + ch)) * 256 + (mm & 255); }
          *(uint2*)dst = make_uint2(pack2(acc[mt][nt][0], acc[mt][nt][1]), pack2(acc[mt][nt][2], acc[mt][nt][3]));
        }
    } else {
      gemm_mainloop<4, true>(p.h + (size_t)m0 * 1024, 1024, W + (size_t)n0 * 1024, 1024, 16, acc, (bf16_t*)smem);
      const int zoff = n0 < 1280 ? 0 : -256;
#pragma unroll
      for (int mt = 0; mt < 4; mt++)
#pragma unroll
        for (int nt = 0; nt < 4; nt++) {
          int m = m0 + wm * 64 + mt * 16 + fr;
          int n = n0 + wn * 64 + nt * 16 + fq * 4 + zoff;
          *(uint2*)(p.z + (size_t)m * ZW + n) = make_uint2(pack2(acc[mt][nt][0], acc[mt][nt][1]), pack2(acc[mt][nt][2], acc[mt][nt][3]));
        }
    }
  }
}

template <int NT>
__device__ __forceinline__ void g2_tile(const Params& p, int l, char* smem, int m0, int n0) {
  const int t_ = tid_op(); const int lane = t_ & 63, wave = t_ >> 6, wm = wave >> 1, wn = wave & 1, fr = lane & 15, fq = lane >> 4;
  const bf16_t* W = p.WtIn + (size_t)l * INC * 1024;
  const bf16_t* Wb = p.WtBr + (size_t)l * 4 * 1024 * 256;
  bf16_t* y = p.z;
#pragma unroll 1
  for (int i = 0; i < 4; i++) {
    f32x4 acc[4][NT];
    unsigned ppk[4][NT][2];
    zero_acc<NT>(acc);
    gemm_mainloop<NT, true, 1>(p.br + (size_t)m0 * 1024 + i * 256, 1024, Wb + ((size_t)i * 1024 + n0) * 256, 256, 4, acc, (bf16_t*)smem);
#pragma unroll
    for (int mt = 0; mt < 4; mt++)
#pragma unroll
      for (int nt = 0; nt < NT; nt++) {
        ppk[mt][nt][0] = pack2(acc[mt][nt][0], acc[mt][nt][1]);
        ppk[mt][nt][1] = pack2(acc[mt][nt][2], acc[mt][nt][3]);
      }
    zero_acc<NT>(acc);
    gemm_mainloop<NT, true, 1>(p.h + (size_t)m0 * 1024, 1024, W + (size_t)(3456 + i * 1024 + n0) * 1024, 1024, 16, acc, (bf16_t*)smem);
#pragma unroll
    for (int mt = 0; mt < 4; mt++)
#pragma unroll
      for (int nt = 0; nt < NT; nt++) {
        const int m = m0 + wm * 64 + mt * 16 + fr;
        const int n = n0 + wn * (NT * 16) + nt * 16 + fq * 4;
        uint2* yp = (uint2*)(y + (size_t)m * 1024 + n);
        uint2 yo = make_uint2(0u, 0u);
        if (i > 0) yo = *yp;
        float y0 = bflo(yo.x) + sigm(acc[mt][nt][0]) * bflo(ppk[mt][nt][0]);
        float y1 = bfhi(yo.x) + sigm(acc[mt][nt][1]) * bfhi(ppk[mt][nt][0]);
        float y2 = bflo(yo.y) + sigm(acc[mt][nt][2]) * bflo(ppk[mt][nt][1]);
        float y3 = bfhi(yo.y) + sigm(acc[mt][nt][3]) * bfhi(ppk[mt][nt][1]);
        *yp = make_uint2(pack2(y0, y1), pack2(y2, y3));
      }
  }
}
__device__ void phase_g2(const Params& p, int l, char* smem) {
  {
    TileIter ti; ti.init(NLAT / 128, 8);
    for (int iter = 0;; iter++) {
      int mtile, ntile;
      if (!ti.get(iter, mtile, ntile)) break;
      g2_tile<4>(p, l, smem, mtile * 128, ntile * 128);
    }
  }
  if (l == 0) {
    TileIter ti; ti.init(NCTX / 128, 16);
    for (int iter = 0;; iter++) {
      int mtile, ntile;
      if (!ti.get(iter, mtile, ntile)) break;
      g2_tile<2>(p, l, smem, NLAT + mtile * 128, ntile * 64);
    }
  }
}

__device__ void phase_g3(const Params& p, int l, char* smem) {
  const int t_ = tid_op(); const int lane = t_ & 63, wave = t_ >> 6, wm = wave >> 1, wn = wave & 1, fr = lane & 15, fq = lane >> 4;
  const bf16_t* W = p.WtOut + (size_t)l * 1024 * 1024;
  const bf16_t* y = p.z;
  const int ntm = (l == 0 ? NTOK : NLAT) / 128;
  TileIter ti; ti.init(ntm, 8);
  for (int iter = 0;; iter++) {
    int mtile, ntile;
    if (!ti.get(iter, mtile, ntile)) break;
    const int m0 = mtile * 128, n0 = ntile * 128;
    f32x4 acc[4][4];
    zero_acc<4>(acc);
    gemm_mainloop<4, true>(y + (size_t)m0 * 1024, 1024, W + (size_t)n0 * 1024, 1024, 16, acc, (bf16_t*)smem);
    const float* src; float* dst; int mb;
    if (m0 < NLAT) { src = (l == 0 ? p.x : p.out) + (size_t)m0 * 1024; dst = p.out + (size_t)m0 * 1024; mb = m0 >> 12; }
    else { src = p.ctx + (size_t)(m0 - NLAT) * 1024; dst = p.ctx1 + (size_t)(m0 - NLAT) * 1024; mb = 8; }
    const float* gate = p.mod + (l * 9 + mb) * 3072 + 2048;
#pragma unroll
    for (int mt = 0; mt < 4; mt++)
#pragma unroll
      for (int nt = 0; nt < 4; nt++) {
        int mr = wm * 64 + mt * 16 + fr;
        int n = n0 + wn * 64 + nt * 16 + fq * 4;
        float4 xv = *(const float4*)(src + (size_t)mr * 1024 + n);
        float4 gv = *(const float4*)(gate + n);
        float4 o = make_float4(xv.x + gv.x * acc[mt][nt][0], xv.y + gv.y * acc[mt][nt][1], xv.z + gv.z * acc[mt][nt][2], xv.w + gv.w * acc[mt][nt][3]);
        *(float4*)(dst + (size_t)mr * 1024 + n) = o;
      }
  }
}

__device__ void scan_item(const Params& p, int l, int item, char* smem) {
  const int rq = item & 1, d = (item >> 1) & 1, h = (item >> 2) & 3, b = item >> 4;
  const int t = tid_op(), lane = t & 63, wave = t >> 6, fr = lane & 15, fq = lane >> 4;
  float* Wd = (float*)smem;
  float* Av = Wd + 2048;
  float* Bv = Av + 2048;
  float* Kd = Bv + 2048;
  float* Rr = Kd + 2048;
  float* Vv = Rr + 2048;
  float* Pf = Vv + 1024;
  float* Yb = Pf;
  float* Qf = Pf + 2048;
  float* prm = Qf + 2048;
  bf16_t* wl = (bf16_t*)(prm + 320);
  bf16_t* al = wl + 32 * 72;

  for (int i = t; i < 320; i += NTHR) {
    int which = i >> 6, k = i & 63;
    float v;
    if (which == 0) v = p.rw_w0[(l * 2 + d) * 256 + h * 64 + k];
    else if (which == 1) v = p.rw_a0[(l * 2 + d) * 256 + h * 64 + k];
    else if (which == 2) v = p.rw_ka[l * 256 + h * 64 + k];
    else if (which == 3) v = p.rw_kk[l * 256 + h * 64 + k];
    else v = p.rw_rk[(l * 4 + h) * 64 + k];
    prm[i] = v;
  }
  bf16x8 w2f[2], a2f[2];
  {
    const int n = h * 64 + 16 * wave + fr;
    const float* w2 = p.rw_w2 + (size_t)(l * 2 + d) * 64 * 256 + n;
    const float* a2 = p.rw_a2 + (size_t)(l * 2 + d) * 64 * 256 + n;
#pragma unroll
    for (int ks = 0; ks < 2; ks++)
#pragma unroll
      for (int j = 0; j < 8; j++) {
        int kk = ks * 32 + fq * 8 + j;
        w2f[ks][j] = (short)f2bf(w2[kk * 256]);
        a2f[ks][j] = (short)f2bf(a2[kk * 256]);
      }
  }
  __syncthreads();

  float s0 = 0.f, s1 = 0.f, s2 = 0.f, s3 = 0.f;
  float u0 = 0.f, u1 = 0.f, u2 = 0.f, u3 = 0.f;
  const int kseg = lane & 15, rowl = wave * 8 + (lane >> 4) * 2;
  const int tt1 = t >> 3, oct = t & 7;
  constexpr int NCH_C = CTXL / 32, NCH_L = SEQ / 32, NCH = NCH_C + NCH_L;
  uint4 rcu[5], rpv[5], rnx[5];
  auto load_raw = [&](int gc) {
    const bool isc = gc < NCH_C;
    const int T = isc ? CTXL : SEQ;
    const int nch = isc ? NCH_C : NCH_L;
    const int ci = isc ? gc : gc - NCH_C;
    const int c = d ? nch - 1 - ci : ci;
    const size_t rowbase = isc ? (size_t)NLAT + b * CTXL : (size_t)b * SEQ;
    const int tok = c * 32 + tt1;
    const bf16_t* zr = p.z + (rowbase + tok) * ZW;
    const bool hp = tok > 0, hn = tok < T - 1;
#pragma unroll
    for (int g = 0; g < 5; g++) {
      const int colbase = g == 0 ? Z_RWR + h * 64 : g == 1 ? Z_RWK + h * 64 : g == 2 ? Z_RWV + h * 64 : g == 3 ? Z_RWW : Z_RWA;
      const int col = colbase + oct * 8;
      rcu[g] = *(const uint4*)(zr + col);
      rpv[g] = make_uint4(0, 0, 0, 0);
      rnx[g] = make_uint4(0, 0, 0, 0);
      if (hp) rpv[g] = *(const uint4*)(zr - ZW + col);
      if (hn) rnx[g] = *(const uint4*)(zr + ZW + col);
    }
  };
  float mureg[5][8];
#pragma unroll
  for (int g = 0; g < 5; g++) {
    const int colbase = g == 0 ? Z_RWR + h * 64 : g == 1 ? Z_RWK + h * 64 : g == 2 ? Z_RWV + h * 64 : g == 3 ? Z_RWW : Z_RWA;
    const float* mup = p.rw_mu + l * 896 + (colbase + oct * 8 - Z_RWR);
    float4 m0 = *(const float4*)mup, m1 = *(const float4*)(mup + 4);
    mureg[g][0] = m0.x; mureg[g][1] = m0.y; mureg[g][2] = m0.z; mureg[g][3] = m0.w;
    mureg[g][4] = m1.x; mureg[g][5] = m1.y; mureg[g][6] = m1.z; mureg[g][7] = m1.w;
  }
  load_raw(0);
  __builtin_amdgcn_s_setprio(2);
#pragma unroll 1
  for (int gc = 0; gc < NCH; gc++) {
    const bool isc = gc < NCH_C;
    const int nch = isc ? NCH_C : NCH_L;
    const int ci = isc ? gc : gc - NCH_C;
    const int c = d ? nch - 1 - ci : ci;
    const size_t rowbase = isc ? (size_t)NLAT + b * CTXL : (size_t)b * SEQ;
    const int t0 = c * 32;
    {
      const int tt = tt1;
      const int tok = t0 + tt;
#pragma unroll
      for (int g = 0; g < 5; g++) {
        const int colbase = g == 0 ? Z_RWR + h * 64 : g == 1 ? Z_RWK + h * 64 : g == 2 ? Z_RWV + h * 64 : g == 3 ? Z_RWW : Z_RWA;
        const int col = colbase + oct * 8;
        float fc[8], fp[8], fn[8], mix[8];
        unpack8(rcu[g], fc); unpack8(rpv[g], fp); unpack8(rnx[g], fn);
#pragma unroll
        for (int i = 0; i < 8; i++) mix[i] = fc[i] + (0.5f * (fp[i] + fn[i]) - fc[i]) * mureg[g][i];
        if (g == 0) {
          *(float4*)(Rr + tt * 64 + oct * 8) = make_float4(mix[0], mix[1], mix[2], mix[3]);
          *(float4*)(Rr + tt * 64 + oct * 8 + 4) = make_float4(mix[4], mix[5], mix[6], mix[7]);
        } else if (g == 1) {
          *(float4*)(Kd + tt * 64 + oct * 8) = make_float4(mix[0], mix[1], mix[2], mix[3]);
          *(float4*)(Kd + tt * 64 + oct * 8 + 4) = make_float4(mix[4], mix[5], mix[6], mix[7]);
        } else if (g == 2) {
          if ((oct >> 2) == rq) {
            *(float4*)(Vv + tt * 32 + (oct & 3) * 8) = make_float4(mix[0], mix[1], mix[2], mix[3]);
            *(float4*)(Vv + tt * 32 + (oct & 3) * 8 + 4) = make_float4(mix[4], mix[5], mix[6], mix[7]);
            if (d == 0) {
              *(uint4*)(p.vmix + (rowbase + tok) * 256 + h * 64 + oct * 8) =
                  make_uint4(pack2(mix[0], mix[1]), pack2(mix[2], mix[3]), pack2(mix[4], mix[5]), pack2(mix[6], mix[7]));
            }
          }
        } else if (g == 3) {
          float th[8];
#pragma unroll
          for (int i = 0; i < 8; i++) th[i] = 1.f - 2.f * frcp(1.f + __expf(2.f * mix[i]));
          *(uint4*)(wl + tt * 72 + oct * 8) = make_uint4(pack2(th[0], th[1]), pack2(th[2], th[3]), pack2(th[4], th[5]), pack2(th[6], th[7]));
        } else {
          *(uint4*)(al + tt * 72 + oct * 8) = make_uint4(pack2(mix[0], mix[1]), pack2(mix[2], mix[3]), pack2(mix[4], mix[5]), pack2(mix[6], mix[7]));
        }
      }
    }
    if (gc + 1 < NCH) load_raw(gc + 1);
    lds_barrier();
    {
#pragma unroll
      for (int mt = 0; mt < 2; mt++) {
        f32x4 ap = {0.f, 0.f, 0.f, 0.f}, aq = {0.f, 0.f, 0.f, 0.f};
#pragma unroll
        for (int ks = 0; ks < 2; ks++) {
          bf16x8 fa = *(const bf16x8*)(wl + (mt * 16 + fr) * 72 + ks * 32 + fq * 8);
          bf16x8 fb = *(const bf16x8*)(al + (mt * 16 + fr) * 72 + ks * 32 + fq * 8);
          ap = mfma16(fa, w2f[ks], ap);
          aq = mfma16(fb, a2f[ks], aq);
        }
#pragma unroll
        for (int j = 0; j < 4; j++) {
          Pf[(mt * 16 + fq * 4 + j) * 64 + wave * 16 + fr] = ap[j];
          Qf[(mt * 16 + fq * 4 + j) * 64 + wave * 16 + fr] = aq[j];
        }
      }
    }
    lds_barrier();
    {
      const int tt = tt1;
      float ss = 0.f, cf = 0.f;
      float kkr[8], aa[8], pv[8], qv[8], kv[8], rv[8], dec[8], kdv[8];
      *(float4*)(pv) = *(const float4*)(Pf + tt * 64 + oct * 8); *(float4*)(pv + 4) = *(const float4*)(Pf + tt * 64 + oct * 8 + 4);
      *(float4*)(qv) = *(const float4*)(Qf + tt * 64 + oct * 8); *(float4*)(qv + 4) = *(const float4*)(Qf + tt * 64 + oct * 8 + 4);
      *(float4*)(kv) = *(const float4*)(Kd + tt * 64 + oct * 8); *(float4*)(kv + 4) = *(const float4*)(Kd + tt * 64 + oct * 8 + 4);
      *(float4*)(rv) = *(const float4*)(Rr + tt * 64 + oct * 8); *(float4*)(rv + 4) = *(const float4*)(Rr + tt * 64 + oct * 8 + 4);
#pragma unroll
      for (int i = 0; i < 8; i++) {
        const int k = oct * 8 + i;
        float pp = prm[k] + pv[i];
        dec[i] = __expf(-0.6065306597f * sigm(pp));
        float a = sigm(prm[64 + k] + qv[i]);
        float kr = kv[i];
        kdv[i] = kr * (1.f + (a - 1.f) * prm[128 + k]);
        kkr[i] = kr * prm[192 + k];
        ss += kkr[i] * kkr[i];
        cf += rv[i] * kdv[i] * prm[256 + k];
        aa[i] = a;
      }
      ss = red8_sum(ss);
      cf = red8_sum(cf);
      float inv = frcp(fmaxf(__builtin_amdgcn_sqrtf(ss), 1e-12f));
      float av[8], bv[8];
#pragma unroll
      for (int i = 0; i < 8; i++) { float kk = kkr[i] * inv; av[i] = -kk; bv[i] = kk * aa[i]; }
      *(float4*)(Wd + tt * 64 + oct * 8) = *(float4*)(dec); *(float4*)(Wd + tt * 64 + oct * 8 + 4) = *(float4*)(dec + 4);
      *(float4*)(Kd + tt * 64 + oct * 8) = *(float4*)(kdv); *(float4*)(Kd + tt * 64 + oct * 8 + 4) = *(float4*)(kdv + 4);
      *(float4*)(Av + tt * 64 + oct * 8) = *(float4*)(av); *(float4*)(Av + tt * 64 + oct * 8 + 4) = *(float4*)(av + 4);
      *(float4*)(Bv + tt * 64 + oct * 8) = *(float4*)(bv); *(float4*)(Bv + tt * 64 + oct * 8 + 4) = *(float4*)(bv + 4);
      if (rq == 0 && oct == 0) p.coef[((size_t)d * NTOK + rowbase + t0 + tt) * 4 + h] = cf;
    }
    lds_barrier();
    {
      const int step = d ? -1 : 1;
      int tt = d ? 31 : 0;
      float4 w = *(const float4*)(Wd + tt * 64 + kseg * 4);
      float4 a = *(const float4*)(Av + tt * 64 + kseg * 4);
      float4 bb = *(const float4*)(Bv + tt * 64 + kseg * 4);
      float4 kd = *(const float4*)(Kd + tt * 64 + kseg * 4);
      float4 r = *(const float4*)(Rr + tt * 64 + kseg * 4);
      float2 v = *(const float2*)(Vv + tt * 32 + rowl);
      float ysel0 = 0.f, ysel1 = 0.f;
#pragma unroll 16
      for (int i = 0; i < 32; i++) {
        const int tn = (i < 31) ? tt + step : tt;
        float4 w2 = *(const float4*)(Wd + tn * 64 + kseg * 4);
        float4 a2 = *(const float4*)(Av + tn * 64 + kseg * 4);
        float4 b2 = *(const float4*)(Bv + tn * 64 + kseg * 4);
        float4 k2 = *(const float4*)(Kd + tn * 64 + kseg * 4);
        float4 r2 = *(const float4*)(Rr + tn * 64 + kseg * 4);
        float2 v2 = *(const float2*)(Vv + tn * 32 + rowl);
        float sa = (s0 * a.x + s1 * a.y) + (s2 * a.z + s3 * a.w);
        float ua = (u0 * a.x + u1 * a.y) + (u2 * a.z + u3 * a.w);
        red16_sum2(sa, ua);
        s0 = s0 * w.x + sa * bb.x + v.x * kd.x;
        s1 = s1 * w.y + sa * bb.y + v.x * kd.y;
        s2 = s2 * w.z + sa * bb.z + v.x * kd.z;
        s3 = s3 * w.w + sa * bb.w + v.x * kd.w;
        u0 = u0 * w.x + ua * bb.x + v.y * kd.x;
        u1 = u1 * w.y + ua * bb.y + v.y * kd.y;
        u2 = u2 * w.z + ua * bb.z + v.y * kd.z;
        u3 = u3 * w.w + ua * bb.w + v.y * kd.w;
        float y0 = (s0 * r.x + s1 * r.y) + (s2 * r.z + s3 * r.w);
        float y1 = (u0 * r.x + u1 * r.y) + (u2 * r.z + u3 * r.w);
        red16_sum2(y0, y1);
        ysel0 = ((i & 15) == kseg) ? y0 : ysel0;
        ysel1 = ((i & 15) == kseg) ? y1 : ysel1;
        if ((i & 15) == 15) {
          const int si = (i - 15) + kseg;
          const int ts = d ? 31 - si : si;
          *(float2*)(Yb + ts * 32 + rowl) = make_float2(ysel0, ysel1);
        }
        w = w2; a = a2; bb = b2; kd = k2; r = r2; v = v2; tt = tn;
      }
    }
    lds_barrier();
    {
      const int tt = t >> 3, q4 = t & 7;
      float4 yv = *(const float4*)(Yb + tt * 32 + q4 * 4);
      *(float4*)(p.yscan + ((size_t)d * NTOK + rowbase + t0 + tt) * 256 + h * 64 + rq * 32 + q4 * 4) = yv;
    }
  }
  __builtin_amdgcn_s_setprio(0);
  __syncthreads();
}

template <int nband>
__device__ void natten_item(const Params& p, int l, int b, int h, size_t qrow0, int r, char* smem) {
  const int t = tid_op(), lane = t & 63, wave = t >> 6, fr = lane & 15, fq = lane >> 4;
  float* rpb = (float*)smem;
  bf16_t* Ps = (bf16_t*)(smem + 2048) + wave * 16 * 72;
  for (int i = t; i < 465; i += NTHR) rpb[i] = p.na_rpb[(l * 4 + h) * 465 + i];
  __syncthreads();
  const int qloc = wave * 16;
  bf16x8 qf[2];
#pragma unroll
  for (int ks = 0; ks < 2; ks++) qf[ks] = *(const bf16x8*)(p.z + (qrow0 + qloc + fr) * ZW + Z_NAQ + h * 64 + ks * 32 + fq * 8);
  float mrow[4], lrow[4];
  f32x4 o[4];
#pragma unroll
  for (int j = 0; j < 4; j++) { mrow[j] = -1e30f; lrow[j] = 0.f; o[j] = f32x4{0.f, 0.f, 0.f, 0.f}; }
  const int rstart = min(max(r - 4, 0), 56);
  const int c0w = wave == 0 ? 0 : wave == 1 ? 8 : wave == 2 ? 24 : 32;
#define LDF(PTR) (*(const bf16x8*)(PTR))
  const bf16_t* kcp = p.z + ((size_t)NLAT + b * CTXL + fr) * ZW + Z_NAK + h * 64 + fq * 8;
  const bf16_t* vcp = p.zvTc + ((size_t)(b * 256 + h * 64 + fr)) * 256 + fq * 8;
  bf16x8 kc0 = LDF(kcp), kc1 = LDF(kcp + 32), kc2 = LDF(kcp + 16 * ZW), kc3 = LDF(kcp + 16 * ZW + 32);
  bf16x8 kc4 = LDF(kcp + 32 * ZW), kc5 = LDF(kcp + 32 * ZW + 32), kc6 = LDF(kcp + 48 * ZW), kc7 = LDF(kcp + 48 * ZW + 32);
  if (nband > 0) {
    const bf16_t* kp = p.z + ((size_t)b * SEQ + rstart * 64 + c0w + fr) * ZW + Z_NAK + h * 64 + fq * 8;
    const bf16_t* vp = p.zvT + ((size_t)(b * 256 + h * 64 + fr)) * 4096 + rstart * 64 + c0w + fq * 8;
    bf16x8 kb0 = LDF(kp), kb1 = LDF(kp + 32), kb2 = LDF(kp + 16 * ZW), kb3 = LDF(kp + 16 * ZW + 32);
    bf16x8 vb0 = LDF(vp), vb1 = LDF(vp + 16 * 4096), vb2 = LDF(vp + 32 * 4096), vb3 = LDF(vp + 48 * 4096);
#pragma unroll 1
    for (int kt = 0; kt < nband; kt++) {
      const int rr = rstart + kt;
      kp += 64 * ZW; vp += 64;
      bf16x8 kn0 = kb0, kn1 = kb1, kn2 = kb2, kn3 = kb3, vn0 = vb0, vn1 = vb1, vn2 = vb2, vn3 = vb3;
      if (kt + 1 < nband) {
        kn0 = LDF(kp); kn1 = LDF(kp + 32); kn2 = LDF(kp + 16 * ZW); kn3 = LDF(kp + 16 * ZW + 32);
        vn0 = LDF(vp); vn1 = LDF(vp + 16 * 4096); vn2 = LDF(vp + 32 * 4096); vn3 = LDF(vp + 48 * 4096);
      }
      f32x4 s[2];
      s[0] = mfma16(qf[0], kb0, f32x4{0.f, 0.f, 0.f, 0.f}); s[0] = mfma16(qf[1], kb1, s[0]);
      s[1] = mfma16(qf[0], kb2, f32x4{0.f, 0.f, 0.f, 0.f}); s[1] = mfma16(qf[1], kb3, s[1]);
      float pj[2][4];
#pragma unroll
      for (int j = 0; j < 4; j++) {
        const int q = qloc + fq * 4 + j;
        float mx = -1e30f;
#pragma unroll
        for (int nt = 0; nt < 2; nt++) {
          const int kc = c0w + nt * 16 + fr;
          const int cs = min(max(q - 8, 0), 48);
          const bool ok = (kc >= cs) && (kc < cs + 16);
          const int dc = min(max(kc - q, -15), 15);
          float bias = rpb[(rr - r + 7) * 31 + dc + 15];
          float val = ok ? s[nt][j] * 0.125f + bias : -1e30f;
          pj[nt][j] = val;
          mx = fmaxf(mx, val);
        }
        mx = red16_max(mx);
        const float mnew = fmaxf(mrow[j], mx);
        const float alpha = __expf(mrow[j] - mnew);
        float sum = 0.f;
#pragma unroll
        for (int nt = 0; nt < 2; nt++) { float e = __expf(pj[nt][j] - mnew); pj[nt][j] = e; sum += e; }
        sum = red16_sum(sum);
        lrow[j] = lrow[j] * alpha + sum;
        mrow[j] = mnew;
#pragma unroll
        for (int nt = 0; nt < 4; nt++) o[nt][j] *= alpha;
      }
#pragma unroll
      for (int nt = 0; nt < 2; nt++)
#pragma unroll
        for (int j = 0; j < 4; j++) Ps[(fq * 4 + j) * 72 + nt * 16 + fr] = f2bf(pj[nt][j]);
      __builtin_amdgcn_fence(__ATOMIC_RELEASE, "wavefront");
      __builtin_amdgcn_wave_barrier();
      __builtin_amdgcn_fence(__ATOMIC_ACQUIRE, "wavefront");
      bf16x8 pf = *(const bf16x8*)(Ps + fr * 72 + fq * 8);
      o[0] = mfma16(pf, vb0, o[0]); o[1] = mfma16(pf, vb1, o[1]); o[2] = mfma16(pf, vb2, o[2]); o[3] = mfma16(pf, vb3, o[3]);
      __builtin_amdgcn_fence(__ATOMIC_RELEASE, "wavefront");
      __builtin_amdgcn_wave_barrier();
      kb0 = kn0; kb1 = kn1; kb2 = kn2; kb3 = kn3; vb0 = vn0; vb1 = vn1; vb2 = vn2; vb3 = vn3;
    }
  }
#pragma unroll 1
  for (int cc = 0; cc < 4; cc++) {
    bf16x8 vfc[4][2];
#pragma unroll
    for (int nt = 0; nt < 4; nt++)
#pragma unroll
      for (int ks = 0; ks < 2; ks++) vfc[nt][ks] = *(const bf16x8*)(vcp + (size_t)(nt * 16) * 256 + ks * 32);
    vcp += 64;
    kcp += 64 * ZW;
    bf16x8 kn0 = kc0, kn1 = kc1, kn2 = kc2, kn3 = kc3, kn4 = kc4, kn5 = kc5, kn6 = kc6, kn7 = kc7;
    if (cc + 1 < 4) {
      kn0 = LDF(kcp); kn1 = LDF(kcp + 32); kn2 = LDF(kcp + 16 * ZW); kn3 = LDF(kcp + 16 * ZW + 32);
      kn4 = LDF(kcp + 32 * ZW); kn5 = LDF(kcp + 32 * ZW + 32); kn6 = LDF(kcp + 48 * ZW); kn7 = LDF(kcp + 48 * ZW + 32);
    }
    f32x4 s[4];
    s[0] = mfma16(qf[0], kc0, f32x4{0.f, 0.f, 0.f, 0.f}); s[0] = mfma16(qf[1], kc1, s[0]);
    s[1] = mfma16(qf[0], kc2, f32x4{0.f, 0.f, 0.f, 0.f}); s[1] = mfma16(qf[1], kc3, s[1]);
    s[2] = mfma16(qf[0], kc4, f32x4{0.f, 0.f, 0.f, 0.f}); s[2] = mfma16(qf[1], kc5, s[2]);
    s[3] = mfma16(qf[0], kc6, f32x4{0.f, 0.f, 0.f, 0.f}); s[3] = mfma16(qf[1], kc7, s[3]);
    float pj[4][4];
#pragma unroll
    for (int j = 0; j < 4; j++) {
      float mx = -1e30f;
#pragma unroll
      for (int nt = 0; nt < 4; nt++) { float val = s[nt][j] * 0.125f; pj[nt][j] = val; mx = fmaxf(mx, val); }
      mx = red16_max(mx);
      const float mnew = fmaxf(mrow[j], mx);
      const float alpha = __expf(mrow[j] - mnew);
      float sum = 0.f;
#pragma unroll
      for (int nt = 0; nt < 4; nt++) { float e = __expf(pj[nt][j] - mnew); pj[nt][j] = e; sum += e; }
      sum = red16_sum(sum);
      lrow[j] = lrow[j] * alpha + sum;
      mrow[j] = mnew;
#pragma unroll
      for (int nt = 0; nt < 4; nt++) o[nt][j] *= alpha;
    }
#pragma unroll
    for (int nt = 0; nt < 4; nt++)
#pragma unroll
      for (int j = 0; j < 4; j++) Ps[(fq * 4 + j) * 72 + nt * 16 + fr] = f2bf(pj[nt][j]);
    __builtin_amdgcn_fence(__ATOMIC_RELEASE, "wavefront");
    __builtin_amdgcn_wave_barrier();
    __builtin_amdgcn_fence(__ATOMIC_ACQUIRE, "wavefront");
    bf16x8 pf[2];
#pragma unroll
    for (int ks = 0; ks < 2; ks++) pf[ks] = *(const bf16x8*)(Ps + fr * 72 + ks * 32 + fq * 8);
#pragma unroll
    for (int nt = 0; nt < 4; nt++)
#pragma unroll
      for (int ks = 0; ks < 2; ks++) o[nt] = mfma16(pf[ks], vfc[nt][ks], o[nt]);
    __builtin_amdgcn_fence(__ATOMIC_RELEASE, "wavefront");
    __builtin_amdgcn_wave_barrier();
    kc0 = kn0; kc1 = kn1; kc2 = kn2; kc3 = kn3; kc4 = kn4; kc5 = kn5; kc6 = kn6; kc7 = kn7;
  }
#undef LDF
#pragma unroll
  for (int j = 0; j < 4; j++) {
    const size_t row = qrow0 + qloc + fq * 4 + j;
    const float inv = frcp(lrow[j]);
#pragma unroll
    for (int nt = 0; nt < 4; nt++) {
      const int dcol = nt * 16 + fr;
      float g = silu_(bf2f(p.z[row * ZW + Z_NAG + h * 64 + dcol]));
      p.br[row * 1024 + 256 + h * 64 + dcol] = f2bf(o[nt][j] * inv * g);
    }
  }
  __syncthreads();
}

__device__ void gmlp_item(const Params& p, int l, size_t row0, int g, char* smem) {
  const int t = tid_op(), lane = t & 63, wave = t >> 6, fr = lane & 15, fq = lane >> 4;
  bf16_t* Ws = (bf16_t*)smem;
  bf16_t* VhT = Ws + 128 * 136;
  const float* ws = p.gm_ws + (size_t)(l * 4 + g) * 128 * 128;
#pragma unroll
  for (int i = 0; i < 16; i++) {
    int e = (i * NTHR + t) * 4;
    int pr = e >> 7, q = e & 127;
    float4 v = *(const float4*)(ws + e);
    *(uint2*)(Ws + pr * 136 + q) = make_uint2(pack2(v.x, v.y), pack2(v.z, v.w));
  }
  {
    const int q = t >> 1, half = t & 1;
    const bf16_t* zr = p.z + (row0 + q) * ZW + Z_GMV + g * 64 + half * 32;
    float v[32];
#pragma unroll
    for (int i = 0; i < 4; i++) { uint4 u = *(const uint4*)(zr + i * 8); unpack8(u, v + i * 8); }
    float sum = 0.f;
#pragma unroll
    for (int i = 0; i < 32; i++) { v[i] = gelu_(v[i]); sum += v[i]; }
    sum += dppf<0xB1>(sum);
    const float mu = sum * (1.f / 64.f);
    float vs = 0.f;
#pragma unroll
    for (int i = 0; i < 32; i++) { float dd = v[i] - mu; vs += dd * dd; }
    vs += dppf<0xB1>(vs);
    const float rs = rsqrtf(vs * (1.f / 64.f) + 1e-6f);
    const float* lg = p.gm_ln_g + (l * 4 + g) * 64 + half * 32;
    const float* lb = p.gm_ln_b + (l * 4 + g) * 64 + half * 32;
#pragma unroll
    for (int i = 0; i < 32; i++) VhT[(half * 32 + i) * 136 + q] = f2bf((v[i] - mu) * rs * lg[i] + lb[i]);
  }
  __syncthreads();
  f32x4 acc[2][4];
#pragma unroll
  for (int mt = 0; mt < 2; mt++)
#pragma unroll
    for (int nt = 0; nt < 4; nt++) acc[mt][nt] = f32x4{0.f, 0.f, 0.f, 0.f};
#pragma unroll
  for (int ks = 0; ks < 4; ks++) {
    bf16x8 af[2], bfr[4];
#pragma unroll
    for (int mt = 0; mt < 2; mt++) af[mt] = *(const bf16x8*)(Ws + (wave * 32 + mt * 16 + fr) * 136 + ks * 32 + fq * 8);
#pragma unroll
    for (int nt = 0; nt < 4; nt++) bfr[nt] = *(const bf16x8*)(VhT + (nt * 16 + fr) * 136 + ks * 32 + fq * 8);
#pragma unroll
    for (int mt = 0; mt < 2; mt++)
#pragma unroll
      for (int nt = 0; nt < 4; nt++) acc[mt][nt] = mfma16(bfr[nt], af[mt], acc[mt][nt]);
  }
#pragma unroll
  for (int mt = 0; mt < 2; mt++) {
    const int pr = wave * 32 + mt * 16 + fr;
    const float bs = p.gm_bs[(l * 4 + g) * 128 + pr];
    const bf16_t* zr = p.z + (row0 + pr) * ZW;
#pragma unroll
    for (int nt = 0; nt < 4; nt++) {
      const int c = nt * 16 + fq * 4;
      uint2 uu = *(const uint2*)(zr + Z_GMU + g * 64 + c);
      uint2 gg = *(const uint2*)(zr + Z_GMG + g * 64 + c);
      float o0 = gelu_(bflo(uu.x)) * (acc[mt][nt][0] + bs) * silu_(bflo(gg.x));
      float o1 = gelu_(bfhi(uu.x)) * (acc[mt][nt][1] + bs) * silu_(bfhi(gg.x));
      float o2 = gelu_(bflo(uu.y)) * (acc[mt][nt][2] + bs) * silu_(bflo(gg.y));
      float o3 = gelu_(bfhi(uu.y)) * (acc[mt][nt][3] + bs) * silu_(bfhi(gg.y));
      *(uint2*)(p.br + (row0 + pr) * 1024 + g * 64 + c) = make_uint2(pack2(o0, o1), pack2(o2, o3));
    }
  }
  __syncthreads();
}

__device__ void pool_item(const Params& p, int l, size_t seqrow0, int T, int t0, int g, char* smem) {
  const int t = tid_op(), lane = t & 63, wave = t >> 6, fr = lane & 15, fq = lane >> 4;
  float* Pp = (float*)smem;
  bf16_t* Dd = (bf16_t*)(Pp + 80 * 64);
  bf16_t* WT = Dd + 64 * 72;
  const int hw = 1 << g;
  for (int i = t; i < 80 * 8; i += NTHR) {
    int rr = i >> 3, oc = i & 7;
    int tok = t0 - 8 + rr;
    float f[8];
    if (tok >= 0 && tok < T) { uint4 u = *(const uint4*)(p.z + (seqrow0 + tok) * ZW + Z_PLP + g * 64 + oc * 8); unpack8(u, f); }
    else {
#pragma unroll
      for (int k = 0; k < 8; k++) f[k] = 0.f;
    }
#pragma unroll
    for (int k = 0; k < 8; k++) Pp[rr * 64 + oc * 8 + k] = f[k];
  }
  {
    const float* w = p.pl_w + (size_t)(l * 4 + g) * 64 * 64;
#pragma unroll
    for (int i = 0; i < 16; i++) {
      int e = i * NTHR + t;
      int c = e >> 6, dd = e & 63;
      WT[dd * 72 + c] = f2bf(w[e]);
    }
  }
  __syncthreads();
  {
    const int c = t & 63, tq = t >> 6;
    for (int i = 0; i < 16; i++) {
      const int tl = tq * 16 + i;
      const int tok = t0 + tl;
      const int lo = max(tok - hw, 0), hi = min(tok + hw, T);
      float s = 0.f;
      for (int u = lo; u < hi; u++) s += Pp[(u - t0 + 8) * 64 + c];
      float dv = s / (float)(hi - lo) - Pp[(tl + 8) * 64 + c];
      Dd[tl * 72 + c] = f2bf(dv);
    }
  }
  __syncthreads();
  f32x4 acc[4];
#pragma unroll
  for (int nt = 0; nt < 4; nt++) acc[nt] = f32x4{0.f, 0.f, 0.f, 0.f};
#pragma unroll
  for (int ks = 0; ks < 2; ks++) {
    bf16x8 af = *(const bf16x8*)(Dd + (wave * 16 + fr) * 72 + ks * 32 + fq * 8);
#pragma unroll
    for (int nt = 0; nt < 4; nt++) {
      bf16x8 bw = *(const bf16x8*)(WT + (nt * 16 + fr) * 72 + ks * 32 + fq * 8);
      acc[nt] = mfma16(bw, af, acc[nt]);
    }
  }
  {
    const size_t row = seqrow0 + t0 + wave * 16 + fr;
#pragma unroll
    for (int nt = 0; nt < 4; nt++) {
      const int dd = g * 64 + nt * 16 + fq * 4;
      float4 sc = *(const float4*)(p.pl_scale + l * 256 + dd);
      uint2 gg = *(const uint2*)(p.z + row * ZW + Z_PLG + dd);
      float o0 = acc[nt][0] * sc.x * silu_(bflo(gg.x));
      float o1 = acc[nt][1] * sc.y * silu_(bfhi(gg.x));
      float o2 = acc[nt][2] * sc.z * silu_(bflo(gg.y));
      float o3 = acc[nt][3] * sc.w * silu_(bfhi(gg.y));
      *(uint2*)(p.br + row * 1024 + 768 + dd) = make_uint2(pack2(o0, o1), pack2(o2, o3));
    }
  }
  __syncthreads();
}


constexpr unsigned ROLE_IDLE = 0xFFFF0001u, ROLE_WORK = 0x10000u;
__device__ void publish_cu(const Params& p) {
  if (threadIdx.x == 0 && gridDim.x == 512) {
    unsigned hw = __builtin_amdgcn_s_getreg(63492);
    unsigned xcc = __builtin_amdgcn_s_getreg(63508);
    p.cuinfo[blockIdx.x] = ((xcc & 0xfu) << 16) | (hw & 0xff00u);
  }
}
__device__ void compute_roles(const Params& p, char* smem) {
  const int t = tid_op();
  if (gridDim.x != 512) { if (t == 0) p.cuinfo[1024] = 1u; return; }
  unsigned* keys = (unsigned*)smem;
  unsigned* mate = keys + 512;
  unsigned* prim = mate + 512;
  for (int i = t; i < 512; i += NTHR) keys[i] = p.cuinfo[i];
  __syncthreads();
  int bad = 0;
  for (int i = t; i < 512; i += NTHR) {
    int cnt = 0, m = 0;
    for (int j = 0; j < 512; j++) if (j != i && keys[j] == keys[i]) { cnt++; m = j; }
    if (cnt != 1) bad = 1;
    mate[i] = (unsigned)m;
    prim[i] = (cnt == 1 && i < m) ? 1u : 0u;
  }
  bad = __syncthreads_or(bad);
  for (int i = t; i < 512; i += NTHR) {
    const int pi = prim[i] ? i : (int)mate[i];
    int rank = 0;
    for (int j = 0; j < pi; j++) rank += (int)prim[j];
    unsigned role;
    if (rank < 128) role = prim[i] ? (unsigned)rank : ROLE_IDLE;
    else role = ROLE_WORK + (unsigned)((rank - 128) * 2 + (prim[i] ? 0 : 1));
    p.cuinfo[512 + i] = role;
  }
  if (t == 0) p.cuinfo[1024] = bad ? 1u : 0u;
  __syncthreads();
}

__device__ void worker_barrier(unsigned* cnt, unsigned target) {
  asm volatile("s_waitcnt vmcnt(0)" ::: "memory");
  __syncthreads();
  if (threadIdx.x == 0) {
    __builtin_amdgcn_fence(__ATOMIC_RELEASE, "agent");
    atomicAdd(cnt, 1u);
    while (__hip_atomic_load(cnt, __ATOMIC_RELAXED, __HIP_MEMORY_SCOPE_AGENT) < target) __builtin_amdgcn_s_sleep(2);
    __builtin_amdgcn_fence(__ATOMIC_ACQUIRE, "agent");
    asm volatile("s_waitcnt vmcnt(0)" ::: "memory");
  }
  __syncthreads();
}
__device__ void phase_mix(const Params& p, int l, char* smem, int cslot) {
  __shared__ unsigned s_item;
  if (!(cslot & 4)) for (int it = blockIdx.x; it < 128; it += gridDim.x) scan_item(p, l, it, smem);
  cslot &= 3;
  const int n_na = 2048, n_ca = (l == 0 ? 128 : 0), n_gm = 1024, n_gc = (l == 0 ? 64 : 0), n_pl = 2048, n_pc = (l == 0 ? 128 : 0);
  const int total = n_na + n_ca + n_gm + n_gc + n_pl + n_pc;
  while (true) {
    if (threadIdx.x == 0) s_item = atomicAdd(p.ctr + cslot, 1u);
    __syncthreads();
    int it = (int)s_item;
    __syncthreads();
    if (it >= total) break;
    if (it < n_na) {
      int r = it & 63, h = (it >> 6) & 3, b = it >> 8;
      natten_item<8>(p, l, b, h, (size_t)b * SEQ + r * 64, r, smem);
      continue;
    }
    it -= n_na;
    if (it < n_ca) {
      int qt = it & 3, h = (it >> 2) & 3, b = it >> 4;
      natten_item<0>(p, l, b, h, (size_t)NLAT + b * CTXL + qt * 64, 0, smem);
      continue;
    }
    it -= n_ca;
    if (it < n_gm) {
      int g = it & 3, ch = (it >> 2) & 31, b = it >> 7;
      gmlp_item(p, l, (size_t)b * SEQ + ch * 128, g, smem);
      continue;
    }
    it -= n_gm;
    if (it < n_gc) {
      int g = it & 3, ch = (it >> 2) & 1, b = it >> 3;
      gmlp_item(p, l, (size_t)NLAT + b * CTXL + ch * 128, g, smem);
      continue;
    }
    it -= n_gc;
    if (it < n_pl) {
      int g = it & 3, tl = (it >> 2) & 63, b = it >> 8;
      pool_item(p, l, (size_t)b * SEQ, SEQ, tl * 64, g, smem);
      continue;
    }
    it -= n_pl;
    {
      int g = it & 3, tl = (it >> 2) & 3, b = it >> 4;
      pool_item(p, l, (size_t)NLAT + b * CTXL, CTXL, tl * 64, g, smem);
    }
  }
}

__device__ void phase_rwfin(const Params& p, int l) {
  const int t_ = tid_op();
  const int lane = t_ & 63;
  const int gw = blockIdx.x * 4 + (t_ >> 6), nw = gridDim.x * 4;
  const int nrow = (l == 0 ? NTOK : NLAT);
  const int hh = lane >> 4, c0 = lane * 4;
  float4 gg = *(const float4*)(p.rw_gn_g + l * 256 + c0);
  float4 gb = *(const float4*)(p.rw_gn_b + l * 256 + c0);
  for (int r = gw; r < nrow; r += nw) {
    float4 y0 = *(const float4*)(p.yscan + (size_t)r * 256 + c0);
    float4 y1 = *(const float4*)(p.yscan + ((size_t)NTOK + r) * 256 + c0);
    float o0 = y0.x + y1.x, o1 = y0.y + y1.y, o2 = y0.z + y1.z, o3 = y0.w + y1.w;
    float mu = red16_sum(o0 + o1 + o2 + o3) * (1.f / 64.f);
    float d0 = o0 - mu, d1 = o1 - mu, d2 = o2 - mu, d3 = o3 - mu;
    float var = red16_sum(d0 * d0 + d1 * d1 + d2 * d2 + d3 * d3) * (1.f / 64.f);
    float rs = rsqrtf(var + 64e-5f);
    float cf = p.coef[(size_t)r * 4 + hh] + p.coef[((size_t)NTOK + r) * 4 + hh];
    uint2 vm = *(const uint2*)(p.vmix + (size_t)r * 256 + c0);
    uint2 zg = *(const uint2*)(p.z + (size_t)r * ZW + Z_RWG + c0);
    float r0 = (d0 * rs * gg.x + gb.x + cf * bflo(vm.x)) * silu_(bflo(zg.x));
    float r1 = (d1 * rs * gg.y + gb.y + cf * bfhi(vm.x)) * silu_(bfhi(zg.x));
    float r2 = (d2 * rs * gg.z + gb.z + cf * bflo(vm.y)) * silu_(bflo(zg.y));
    float r3 = (d3 * rs * gg.w + gb.w + cf * bfhi(vm.y)) * silu_(bfhi(zg.y));
    *(uint2*)(p.br + (size_t)r * 1024 + 512 + c0) = make_uint2(pack2(r0, r1), pack2(r2, r3));
  }
}

__device__ __forceinline__ void gsync(cg::grid_group& grid) {
  asm volatile("s_waitcnt vmcnt(0)" ::: "memory");
  grid.sync();
}

#define XB_XCNT(j) (64 * (j))
#define XB_XSUB(j) (1024 + 64 * (j))
#define XB_XGEN(j) (2048 + 64 * (j))
#define XB_TOP 3072
#define XB_TOPGEN 3136
constexpr int XB_WORDS = 3200;
__device__ __forceinline__ unsigned xb_ld(unsigned* q) { return __hip_atomic_load(q, __ATOMIC_RELAXED, __HIP_MEMORY_SCOPE_AGENT); }
__device__ __forceinline__ unsigned xb_add(unsigned* q, unsigned v) { return __hip_atomic_fetch_add(q, v, __ATOMIC_RELAXED, __HIP_MEMORY_SCOPE_AGENT); }
#define XB_SPIN(cond) do { unsigned _sp = 0; while (cond) { __builtin_amdgcn_s_sleep(1); if (++_sp > (1u << 24)) break; } } while (0)
__device__ __forceinline__ void xsync(unsigned* bar, volatile unsigned* st) {
  asm volatile("s_waitcnt vmcnt(0)" ::: "memory");
  __syncthreads();
  if (threadIdx.x == 0) {
    __builtin_amdgcn_s_waitcnt(0);
    const unsigned nloc = st[0], nx = st[1], x = st[2];
    const unsigned old = xb_add(&bar[XB_XSUB(x)], 1u);
    const unsigned gen = old / nloc;
    if (old + 1u == (gen + 1u) * nloc) {
      __builtin_amdgcn_fence(__ATOMIC_RELEASE, "agent");
      asm volatile("s_waitcnt vmcnt(0)" ::: "memory");
      const unsigned og = xb_add(&bar[XB_TOP], 1u);
      const unsigned tg = og / nx;
      if (og + 1u == (tg + 1u) * nx) xb_add(&bar[XB_TOPGEN], 1u);
      else XB_SPIN(xb_ld(&bar[XB_TOPGEN]) == tg);
      __builtin_amdgcn_fence(__ATOMIC_ACQUIRE, "agent");
      xb_add(&bar[XB_XGEN(x)], 1u);
      asm volatile("s_waitcnt vmcnt(0)" ::: "memory");
    } else {
      XB_SPIN(xb_ld(&bar[XB_XGEN(x)]) == gen);
      __builtin_amdgcn_fence(__ATOMIC_ACQUIRE, "agent");
      asm volatile("s_waitcnt vmcnt(0)" ::: "memory");
    }
  }
  __syncthreads();
}
__global__ void __launch_bounds__(NTHR, 2) hybrid_mega(Params p) {
  extern __shared__ __attribute__((aligned(16))) char smem[];
  cg::grid_group grid = cg::this_grid();
  __shared__ unsigned xb_st[4];
  const unsigned my_xcc = (unsigned)__builtin_amdgcn_s_getreg((3 << 11) | 20) & 0xFu;
  if (threadIdx.x == 0) (void)xb_add(&p.xbar[XB_XCNT(my_xcc)], 1u);
  publish_cu(p);
  phase0(p, smem);
  if (p.xbar == nullptr) gsync(grid);
  if (threadIdx.x == 0) {
    unsigned mine = 0, cnt = 0, sum = 0, sp = 0;
    for (;;) {
      mine = 0; cnt = 0; sum = 0;
      for (unsigned j = 0; j < 16; j++) { const unsigned c = xb_ld(&p.xbar[XB_XCNT(j)]); sum += c; cnt += c > 0u ? 1u : 0u; mine = j == my_xcc ? c : mine; }
      if (sum == gridDim.x || ++sp > (1u << 22)) break;
      __builtin_amdgcn_s_sleep(1);
    }
    xb_st[0] = mine > 0u ? mine : 1u; xb_st[1] = cnt > 0u ? cnt : 1u; xb_st[2] = my_xcc;
  }
  __syncthreads();
  xsync(p.xbar, xb_st);
  if (blockIdx.x == 0) compute_roles(p, smem);
#pragma unroll 1
  for (int l = 0; l < 2; l++) {
    phase_norm(p, l, l == 0 ? p.x : p.out, l == 0 ? p.ctx : p.ctx1);
    xsync(p.xbar, xb_st);
    const bool overlap = (gridDim.x == 512) && (p.cuinfo[1024] == 0u);
    phase_g1(p, l, smem, overlap ? 1 : 0, -1, 0);
    xsync(p.xbar, xb_st);
    {
      if (overlap) {
        const unsigned role = p.cuinfo[512 + blockIdx.x];
        if (role < 128u) scan_item(p, l, (int)role, smem);
        else if (role >= ROLE_WORK && role < ROLE_WORK + 256u) {
          phase_g1(p, l, smem, 2, (int)(role - ROLE_WORK), 256);
          worker_barrier(p.ctr + 4 + l, 256u);
          phase_mix(p, l, smem, l | 4);
        }
      } else {
        for (int it = blockIdx.x; it < 128; it += gridDim.x) scan_item(p, l, it, smem);
      }
      xsync(p.xbar, xb_st);
      if (!overlap) phase_mix(p, l, smem, l | 4);
      phase_rwfin(p, l);
      xsync(p.xbar, xb_st);
    }
    phase_g2(p, l, smem);
    xsync(p.xbar, xb_st);
    if (DUP_MASK & 2) { phase_g2(p, l, smem); xsync(p.xbar, xb_st); }
    phase_g3(p, l, smem);
    xsync(p.xbar, xb_st);
    if ((DUP_MASK & 8) && l == 0) { phase_g3(p, l, smem); xsync(p.xbar, xb_st); }
  }
  phase_final(p);
}

extern "C" void kernel_launch(void* const* d_in, const int* in_sizes, int n_in, void* d_out, int out_size, void* d_ws,
                              size_t ws_size, hipStream_t stream) {
  static int grid_blocks = 0;
  if (!grid_blocks) {
    int dev = 0, cus = 0, per_cu = 0;
    hipGetDevice(&dev);
    hipDeviceGetAttribute(&cus, hipDeviceAttributeMultiprocessorCount, dev);
    hipFuncSetAttribute((const void*)hybrid_mega, hipFuncAttributeMaxDynamicSharedMemorySize, LDS_BYTES);
    hipOccupancyMaxActiveBlocksPerMultiprocessor(&per_cu, hybrid_mega, NTHR, LDS_BYTES);
    if (per_cu > 2) per_cu = 2;
    if (per_cu < 1) per_cu = 1;
    grid_blocks = cus * per_cu;
  }
  Params p{};
  const float* const* in = (const float* const*)d_in;
  p.x = in[0]; p.c = in[1]; p.ctx = in[2]; p.c_ctx = in[3]; p.ada_w = in[4]; p.ada_b = in[5]; p.norm_g = in[6]; p.w_in = in[7];
  p.gm_ln_g = in[8]; p.gm_ln_b = in[9]; p.gm_ws = in[10]; p.gm_bs = in[11]; p.na_rpb = in[12]; p.rw_mu = in[13]; p.rw_w0 = in[14];
  p.rw_w2 = in[15]; p.rw_a0 = in[16]; p.rw_a2 = in[17]; p.rw_kk = in[18]; p.rw_ka = in[19]; p.rw_rk = in[20]; p.rw_gn_g = in[21];
  p.rw_gn_b = in[22]; p.pl_w = in[23]; p.pl_scale = in[24]; p.w_br = in[25]; p.w_out = in[26]; p.final_g = in[27];
  p.out = (float*)d_out;
  char* w = (char*)d_ws;
  size_t off = 0;
  auto take = [&](size_t bytes) { char* r = w + off; off += (bytes + 255) & ~(size_t)255; return r; };
  p.ctr = (unsigned*)take(256);
  p.cuinfo = (unsigned*)take(8192);
  p.xbar = (unsigned*)take(XB_WORDS * 4);
  p.mod = (float*)take((size_t)2 * 9 * 3072 * 4);
  p.WtIn = (bf16_t*)take((size_t)2 * INC * 1024 * 2);
  p.WtBr = (bf16_t*)take((size_t)2 * 4 * 1024 * 256 * 2);
  p.WtOut = (bf16_t*)take((size_t)2 * 1024 * 1024 * 2);
  p.h = (bf16_t*)take((size_t)NTOK * 1024 * 2);
  p.z = (bf16_t*)take((size_t)NTOK * ZW * 2);
  p.zvT = (bf16_t*)take((size_t)NB * 256 * SEQ * 2);
  p.zvTc = (bf16_t*)take((size_t)NB * 256 * CTXL * 2);
  p.br = (bf16_t*)take((size_t)NTOK * 1024 * 2);
  p.yscan = (float*)take((size_t)2 * NTOK * 256 * 4);
  p.vmix = (bf16_t*)take((size_t)NTOK * 256 * 2);
  p.coef = (float*)take((size_t)2 * NTOK * 4 * 4);
  p.ctx1 = (float*)take((size_t)NCTX * 1024 * 4);
  if (off > ws_size) fprintf(stderr, "workspace too small: need %zu have %zu\n", off, ws_size);
  hipMemsetAsync(p.xbar, 0, XB_WORDS * 4, stream);
  void* args[] = {&p};
  hipError_t e = hipLaunchCooperativeKernel((const void*)hybrid_mega, dim3(grid_blocks), dim3(NTHR), args, LDS_BYTES, stream);
  if (e != hipSuccess) fprintf(stderr, "cooperative launch failed: %s (grid %d)\n", hipGetErrorString(e), grid_blocks);
}
```

```cpp
#include <hip/hip_runtime.h>
#include <hip/hip_cooperative_groups.h>
#include <cstdio>
namespace cg = cooperative_groups;

typedef unsigned short bf16_t;
using bf16x8 = __attribute__((ext_vector_type(8))) short;
using f32x4 = __attribute__((ext_vector_type(4))) float;
using f32x2 = __attribute__((ext_vector_type(2))) float;

constexpr int D = 1024;
constexpr int NB = 8;
constexpr int SEQ = 4096;
constexpr int CTXL = 256;
constexpr int NLAT = NB * SEQ;
constexpr int NCTX = NB * CTXL;
constexpr int NTOK = NLAT + NCTX;
constexpr int INC = 7552;
constexpr int ZW = 3200;
constexpr int Z_GMU = 0, Z_GMV = 256, Z_GMG = 512, Z_NAQ = 768, Z_NAK = 1024, Z_NAG = 1280;
constexpr int Z_RWR = 1536, Z_RWK = 1792, Z_RWV = 2048, Z_RWW = 2304, Z_RWA = 2368, Z_RWG = 2432, Z_PLP = 2688, Z_PLG = 2944;
constexpr int LDS_BYTES = 73728;
constexpr int NTHR = 256;
#ifndef DUP_MASK
#define DUP_MASK 0
#endif

struct Params {
  const float *x, *c, *ctx, *c_ctx, *ada_w, *ada_b, *norm_g, *w_in, *gm_ln_g, *gm_ln_b, *gm_ws, *gm_bs, *na_rpb,
      *rw_mu, *rw_w0, *rw_w2, *rw_a0, *rw_a2, *rw_kk, *rw_ka, *rw_rk, *rw_gn_g, *rw_gn_b, *pl_w, *pl_scale, *w_br, *w_out, *final_g;
  float* out;
  bf16_t *WtIn, *WtBr, *WtOut, *h, *z, *zvT, *zvTc, *br, *vmix;
  float *mod, *yscan, *coef, *ctx1;
  unsigned* ctr;
  unsigned* xbar;
  unsigned* cuinfo;
};

__device__ __forceinline__ bf16_t f2bf(float f) {
  unsigned u = __float_as_uint(f);
  u += 0x7fffu + ((u >> 16) & 1u);
  return (bf16_t)(u >> 16);
}
__device__ __forceinline__ float bf2f(unsigned v) { return __uint_as_float(v << 16); }
__device__ __forceinline__ unsigned pack2(float a, float b) { return (unsigned)f2bf(a) | ((unsigned)f2bf(b) << 16); }
__device__ __forceinline__ float bflo(unsigned w) { return __uint_as_float(w << 16); }
__device__ __forceinline__ float bfhi(unsigned w) { return __uint_as_float(w & 0xffff0000u); }
__device__ __forceinline__ float frcp(float x) { return __builtin_amdgcn_rcpf(x); }
__device__ __forceinline__ float sigm(float x) { return frcp(1.f + __expf(-x)); }
__device__ __forceinline__ float silu_(float x) { return x * frcp(1.f + __expf(-x)); }
__device__ __forceinline__ float gelu_(float x) {
  float u = 1.5957691216f * (x + 0.044715f * x * x * x);
  return x * frcp(1.f + __expf(-u));
}
template <int CTRL>
__device__ __forceinline__ float dppf(float v) {
  return __int_as_float(__builtin_amdgcn_update_dpp(0, __float_as_int(v), CTRL, 0xf, 0xf, false));
}
__device__ __forceinline__ float red16_sum(float v) {
  v += dppf<0xB1>(v); v += dppf<0x4E>(v); v += dppf<0x141>(v); v += dppf<0x140>(v); return v;
}
__device__ __forceinline__ void red16_sum2(float& a, float& b) {
  a += dppf<0xB1>(a); asm volatile("" : "+v"(a));
  b += dppf<0xB1>(b); asm volatile("" : "+v"(b));
  a += dppf<0x4E>(a); asm volatile("" : "+v"(a));
  b += dppf<0x4E>(b); asm volatile("" : "+v"(b));
  a += dppf<0x141>(a); asm volatile("" : "+v"(a));
  b += dppf<0x141>(b); asm volatile("" : "+v"(b));
  a += dppf<0x140>(a); asm volatile("" : "+v"(a));
  b += dppf<0x140>(b); asm volatile("" : "+v"(b));
}
__device__ __forceinline__ float red16_max(float v) {
  v = fmaxf(v, dppf<0xB1>(v)); v = fmaxf(v, dppf<0x4E>(v)); v = fmaxf(v, dppf<0x141>(v)); v = fmaxf(v, dppf<0x140>(v)); return v;
}
__device__ __forceinline__ float red8_sum(float v) {
  v += dppf<0xB1>(v); v += dppf<0x4E>(v); v += dppf<0x141>(v); return v;
}
__device__ __forceinline__ float wave_sum(float v) {
#pragma unroll
  for (int o = 32; o > 0; o >>= 1) v += __shfl_xor(v, o);
  return v;
}
__device__ __forceinline__ int tid_op() {
  int t = threadIdx.x;
  asm volatile("" : "+v"(t));
  return t;
}
__device__ __forceinline__ void lds_barrier() {
  asm volatile("s_waitcnt lgkmcnt(0)" ::: "memory");
  __builtin_amdgcn_s_barrier();
  asm volatile("" ::: "memory");
}
__device__ __forceinline__ f32x4 mfma16(bf16x8 a, bf16x8 b, f32x4 c) {
  return __builtin_amdgcn_mfma_f32_16x16x32_bf16(a, b, c, 0, 0, 0);
}
__device__ __forceinline__ void unpack8(uint4 v, float* f) {
  f[0] = bflo(v.x); f[1] = bfhi(v.x); f[2] = bflo(v.y); f[3] = bfhi(v.y);
  f[4] = bflo(v.z); f[5] = bfhi(v.z); f[6] = bflo(v.w); f[7] = bfhi(v.w);
}

__device__ void transpose_tile(const float* __restrict__ src, int N, bf16_t* __restrict__ dst, int K, int k0, int n0, float* tile) {
  const int t = tid_op();
  const int r = t >> 4, c4 = (t & 15) * 4;
#pragma unroll
  for (int i = 0; i < 4; i++) {
    int k = r + 16 * i;
    float4 v = *(const float4*)(src + (size_t)(k0 + k) * N + n0 + c4);
    tile[k * 65 + c4 + 0] = v.x; tile[k * 65 + c4 + 1] = v.y; tile[k * 65 + c4 + 2] = v.z; tile[k * 65 + c4 + 3] = v.w;
  }
  __syncthreads();
  const int n = t >> 2, ks = (t & 3) * 16;
  unsigned pk[8];
#pragma unroll
  for (int i = 0; i < 8; i++) pk[i] = pack2(tile[(ks + 2 * i) * 65 + n], tile[(ks + 2 * i + 1) * 65 + n]);
  uint4* dp = (uint4*)(dst + (size_t)(n0 + n) * K + k0 + ks);
  dp[0] = make_uint4(pk[0], pk[1], pk[2], pk[3]);
  dp[1] = make_uint4(pk[4], pk[5], pk[6], pk[7]);
  __syncthreads();
}

__device__ void mod_item(const Params& p, int l, int jc, char* smem) {
  float* sil = (float*)smem;
  float* red = sil + 9 * 1024;
  const int t = tid_op();
  for (int i = t; i < 9 * 1024; i += NTHR) {
    int r = i >> 10, k = i & 1023;
    float v = r < 8 ? p.c[r * 1024 + k] : p.c_ctx[k];
    sil[i] = silu_(v);
  }
  __syncthreads();
  const int col = t & 63, q = t >> 6;
  float acc[9];
#pragma unroll
  for (int r = 0; r < 9; r++) acc[r] = 0.f;
  const float* w = p.ada_w + (size_t)l * 1024 * 3072 + jc * 64 + col;
  for (int k = q * 256; k < q * 256 + 256; k++) {
    float wv = w[(size_t)k * 3072];
#pragma unroll
    for (int r = 0; r < 9; r++) acc[r] += sil[r * 1024 + k] * wv;
  }
#pragma unroll
  for (int r = 0; r < 9; r++) red[(q * 9 + r) * 64 + col] = acc[r];
  __syncthreads();
  if (t < 64) {
    float bb = p.ada_b[l * 3072 + jc * 64 + t];
#pragma unroll
    for (int r = 0; r < 9; r++) {
      float s = red[(0 * 9 + r) * 64 + t] + red[(1 * 9 + r) * 64 + t] + red[(2 * 9 + r) * 64 + t] + red[(3 * 9 + r) * 64 + t];
      p.mod[(l * 9 + r) * 3072 + jc * 64 + t] = s + bb;
    }
  }
  __syncthreads();
}

__device__ void phase0(const Params& p, char* smem) {
  if (blockIdx.x == 0 && threadIdx.x < 8) p.ctr[threadIdx.x] = 0u;
  constexpr int PER_L = 2400 + 48;
  for (int it = blockIdx.x; it < 2 * PER_L; it += gridDim.x) {
    int l = it / PER_L, r = it % PER_L;
    if (r < 1888) {
      int kt = r & 15, nt = r >> 4;
      transpose_tile(p.w_in + (size_t)l * 1024 * INC, INC, p.WtIn + (size_t)l * INC * 1024, 1024, kt * 64, nt * 64, (float*)smem);
    } else if (r < 2144) {
      int q = r - 1888; int i = q >> 6; int kt = q & 3, nt = (q >> 2) & 15;
      transpose_tile(p.w_br + ((size_t)l * 4 + i) * 256 * 1024, 1024, p.WtBr + ((size_t)l * 4 + i) * 1024 * 256, 256, kt * 64, nt * 64, (float*)smem);
    } else if (r < 2400) {
      int q = r - 2144; int kt = q & 15, nt = q >> 4;
      transpose_tile(p.w_out + (size_t)l * 1024 * 1024, 1024, p.WtOut + (size_t)l * 1024 * 1024, 1024, kt * 64, nt * 64, (float*)smem);
    } else {
      mod_item(p, l, r - 2400, smem);
    }
  }
}

__device__ void phase_norm(const Params& p, int l, const float* xsrc, const float* csrc) {
  const int t_ = tid_op();
  const int lane = t_ & 63;
  const int gw = blockIdx.x * 4 + (t_ >> 6), nw = gridDim.x * 4;
  const float* g = p.norm_g + l * 1024;
  for (int r = gw; r < NTOK; r += nw) {
    const float* src; int mb;
    if (r < NLAT) { src = xsrc + (size_t)r * 1024; mb = r >> 12; } else { src = csrc + (size_t)(r - NLAT) * 1024; mb = 8; }
    const float* md = p.mod + (l * 9 + mb) * 3072;
    float4 v[4]; float ss = 0.f;
#pragma unroll
    for (int i = 0; i < 4; i++) {
      v[i] = *(const float4*)(src + lane * 4 + 256 * i);
      ss += v[i].x * v[i].x + v[i].y * v[i].y + v[i].z * v[i].z + v[i].w * v[i].w;
    }
    ss = wave_sum(ss);
    float rs = rsqrtf(ss * (1.f / 1024.f) + 1e-6f);
#pragma unroll
    for (int i = 0; i < 4; i++) {
      int col = lane * 4 + 256 * i;
      float4 gg = *(const float4*)(g + col);
      float4 sh = *(const float4*)(md + col);
      float4 sc = *(const float4*)(md + 1024 + col);
      float a0 = v[i].x * rs * gg.x * (1.f + sc.x) + sh.x;
      float a1 = v[i].y * rs * gg.y * (1.f + sc.y) + sh.y;
      float a2 = v[i].z * rs * gg.z * (1.f + sc.z) + sh.z;
      float a3 = v[i].w * rs * gg.w * (1.f + sc.w) + sh.w;
      *(uint2*)(p.h + (size_t)r * 1024 + col) = make_uint2(pack2(a0, a1), pack2(a2, a3));
    }
  }
}

__device__ void phase_final(const Params& p) {
  const int t_ = tid_op();
  const int lane = t_ & 63;
  const int gw = blockIdx.x * 4 + (t_ >> 6), nw = gridDim.x * 4;
  for (int r = gw; r < NLAT; r += nw) {
    float* src = p.out + (size_t)r * 1024;
    float4 v[4]; float ss = 0.f;
#pragma unroll
    for (int i = 0; i < 4; i++) {
      v[i] = *(const float4*)(src + lane * 4 + 256 * i);
      ss += v[i].x * v[i].x + v[i].y * v[i].y + v[i].z * v[i].z + v[i].w * v[i].w;
    }
    ss = wave_sum(ss);
    float rs = rsqrtf(ss * (1.f / 1024.f) + 1e-6f);
#pragma unroll
    for (int i = 0; i < 4; i++) {
      int col = lane * 4 + 256 * i;
      float4 gg = *(const float4*)(p.final_g + col);
      float4 o = make_float4(v[i].x * rs * gg.x, v[i].y * rs * gg.y, v[i].z * rs * gg.z, v[i].w * rs * gg.w);
      *(float4*)(src + col) = o;
    }
  }
}

template <int NT, bool SWAP>
__device__ __forceinline__ void gemm_compute(const bf16_t* a_s, const bf16_t* b_s, int o0, f32x4 (&acc)[4][NT]) {
#pragma unroll
  for (int ks = 0; ks < 2; ks++) {
    const int off = ks == 0 ? o0 : (o0 ^ 32);
    bf16x8 af[4], bfr[NT];
#pragma unroll
    for (int mt = 0; mt < 4; mt++) af[mt] = *(const bf16x8*)(a_s + mt * 16 * 64 + off);
#pragma unroll
    for (int nt = 0; nt < NT; nt++) bfr[nt] = *(const bf16x8*)(b_s + nt * 16 * 64 + off);
#pragma unroll
    for (int mt = 0; mt < 4; mt++)
#pragma unroll
      for (int nt = 0; nt < NT; nt++)
        acc[mt][nt] = SWAP ? mfma16(bfr[nt], af[mt], acc[mt][nt]) : mfma16(af[mt], bfr[nt], acc[mt][nt]);
  }
}

template <int NT, bool SWAP, int DEEP = 2>
__device__ __forceinline__ void gemm_mainloop(const bf16_t* __restrict__ A, int lda, const bf16_t* __restrict__ Bm, int ldb,
                                              int nk, f32x4 (&acc)[4][NT], bf16_t* sm) {
  constexpr int ASZ = 128 * 64, BSZ = NT * 32 * 64;
  bf16_t* sA = sm;
  bf16_t* sB = sm + 2 * ASZ;
  const int t = tid_op(), lane = t & 63, wave = t >> 6, wm = wave >> 1, wn = wave & 1;
  const int lr = t >> 3, lc = (t & 7) * 8;
  const int lcs = ((t & 7) ^ ((lr >> 1) & 7)) * 8;
  const int fr = lane & 15, fq = lane >> 4;
  uint4 p0a0, p0a1, p0a2, p0a3, p0b0, p0b1, p0b2, p0b3;
  uint4 p1a0, p1a1, p1a2, p1a3, p1b0, p1b1, p1b2, p1b3;
  p0b2 = p0b3 = p1b2 = p1b3 = make_uint4(0, 0, 0, 0);
  const bf16_t* Ap = A + (size_t)lr * lda + lc;
  const bf16_t* Bp = Bm + (size_t)lr * ldb + lc;
#define GLD(P, R, I, KT) *(const uint4*)(P + (size_t)(32 * I) * R + (KT) * 64)
#define GLOAD(S, KT)                                                         \
  {                                                                          \
    S##a0 = GLD(Ap, lda, 0, KT); S##a1 = GLD(Ap, lda, 1, KT);                \
    S##a2 = GLD(Ap, lda, 2, KT); S##a3 = GLD(Ap, lda, 3, KT);                \
    S##b0 = GLD(Bp, ldb, 0, KT); S##b1 = GLD(Bp, ldb, 1, KT);                \
    if constexpr (NT == 4) { S##b2 = GLD(Bp, ldb, 2, KT); S##b3 = GLD(Bp, ldb, 3, KT); } \
  }
#define SST(BASE, I) *(uint4*)(BASE + (lr + 32 * I) * 64 + lcs)
#define SWRITE(S, BUF)                                                       \
  {                                                                          \
    SST(sA + (BUF) * ASZ, 0) = S##a0; SST(sA + (BUF) * ASZ, 1) = S##a1;      \
    SST(sA + (BUF) * ASZ, 2) = S##a2; SST(sA + (BUF) * ASZ, 3) = S##a3;      \
    SST(sB + (BUF) * BSZ, 0) = S##b0; SST(sB + (BUF) * BSZ, 1) = S##b1;      \
    if constexpr (NT == 4) { SST(sB + (BUF) * BSZ, 2) = S##b2; SST(sB + (BUF) * BSZ, 3) = S##b3; } \
  }
  const bf16_t* a_s0 = sA + (wm * 64 + fr) * 64;
  const bf16_t* b_s0 = sB + (wn * (NT * 16) + fr) * 64;
  const int o0 = (fq ^ ((fr >> 1) & 7)) * 8;
  if (DEEP == 2) {
    GLOAD(p0, 0);
    GLOAD(p1, 1);
    SWRITE(p0, 0);
    __syncthreads();
#pragma unroll 1
    for (int kt = 0; kt < nk; kt += 2) {
      const bool m2 = kt + 2 < nk;
      if (m2) GLOAD(p0, kt + 2);
      gemm_compute<NT, SWAP>(a_s0, b_s0, o0, acc);
      SWRITE(p1, 1);
      __syncthreads();
      if (m2) GLOAD(p1, kt + 3);
      gemm_compute<NT, SWAP>(a_s0 + ASZ, b_s0 + BSZ, o0, acc);
      if (m2) SWRITE(p0, 0);
      __syncthreads();
    }
  } else {
    GLOAD(p0, 0);
    SWRITE(p0, 0);
    __syncthreads();
#pragma unroll 1
    for (int kt = 0; kt < nk; kt += 2) {
      const bool m2 = kt + 2 < nk;
      GLOAD(p0, kt + 1);
      gemm_compute<NT, SWAP>(a_s0, b_s0, o0, acc);
      SWRITE(p0, 1);
      __syncthreads();
      if (m2) GLOAD(p0, kt + 2);
      gemm_compute<NT, SWAP>(a_s0 + ASZ, b_s0 + BSZ, o0, acc);
      if (m2) SWRITE(p0, 0);
      __syncthreads();
    }
  }
#undef GLOAD
#undef SWRITE
#undef GLD
#undef SST
}

template <int NT>
__device__ __forceinline__ void zero_acc(f32x4 (&acc)[4][NT]) {
#pragma unroll
  for (int i = 0; i < 4; i++)
#pragma unroll
    for (int j = 0; j < NT; j++) acc[i][j] = f32x4{0.f, 0.f, 0.f, 0.f};
}

struct TileIter {
  int total, TN, per_x, base, lim, nslot, slot;
  __device__ __forceinline__ void init(int TM, int TN_, int vb = -1, int nvb = 0) {
    TN = TN_; total = TM * TN_;
    const int nx = 8;
    if (vb < 0) { vb = blockIdx.x; nvb = gridDim.x; }
    per_x = (total + nx - 1) / nx;
    const int xcd = vb % nx;
    slot = vb / nx;
    nslot = (nvb + nx - 1) / nx;
    base = xcd * per_x;
    lim = min(total, base + per_x);
  }
  __device__ __forceinline__ bool get(int iter, int& m, int& n) const {
    const int T = base + iter * nslot + slot;
    if (T >= lim) return false;
    const int grp = T / (8 * TN), r = T % (8 * TN);
    m = grp * 8 + (r & 7); n = r >> 3;
    return true;
  }
};

__device__ void phase_g1(const Params& p, int l, char* smem, int part, int vb, int nvb) {
  const int t_ = tid_op(); const int lane = t_ & 63, wave = t_ >> 6, wm = wave >> 1, wn = wave & 1, fr = lane & 15, fq = lane >> 4;
  const bf16_t* W = p.WtIn + (size_t)l * INC * 1024;
  constexpr int NTILE_N = 27, NTILE_M = NTOK / 128;
  TileIter ti; ti.init(NTILE_M, part == 0 ? NTILE_N : part == 1 ? 7 : 20, vb, nvb);
  for (int iter = 0;; iter++) {
    int mtile, ntile;
    if (!ti.get(iter, mtile, ntile)) break;
    if (part == 1) ntile += 14; else if (part == 2) ntile = ntile < 14 ? ntile : ntile + 7;
    const int m0 = mtile * 128, n0 = ntile * 128;
    f32x4 acc[4][4];
    zero_acc<4>(acc);
    if (ntile == 10 || ntile == 11) {
      gemm_mainloop<4, false>(p.h + (size_t)m0 * 1024, 1024, W + (size_t)n0 * 1024, 1024, 16, acc, (bf16_t*)smem);
#pragma unroll
      for (int mt = 0; mt < 4; mt++)
#pragma unroll
        for (int nt = 0; nt < 4; nt++) {
          int m = m0 + wm * 64 + mt * 16 + fq * 4;
          int ch = n0 + wn * 64 + nt * 16 + fr - 1280;
          bf16_t* dst;
          if (m0 < NLAT) { int b = m0 >> 12; dst = p.zvT + ((size_t)(b * 256 + ch)) * 4096 + (m - b * 4096); }
          else { int mm = m - NLAT; int b = mm >> 8; dst = p.zvTc + ((size_t)(b * 256 + ch)) * 256 + (mm & 255); }
          *(uint2*)dst = make_uint2(pack2(acc[mt][nt][0], acc[mt][nt][1]), pack2(acc[mt][nt][2], acc[mt][nt][3]));
        }
    } else {
      gemm_mainloop<4, true>(p.h + (size_t)m0 * 1024, 1024, W + (size_t)n0 * 1024, 1024, 16, acc, (bf16_t*)smem);
      const int zoff = n0 < 1280 ? 0 : -256;
#pragma unroll
      for (int mt = 0; mt < 4; mt++)
#pragma unroll
        for (int nt = 0; nt < 4; nt++) {
          int m = m0 + wm * 64 + mt * 16 + fr;
          int n = n0 + wn * 64 + nt * 16 + fq * 4 + zoff;
          *(uint2*)(p.z + (size_t)m * ZW + n) = make_uint2(pack2(acc[mt][nt][0], acc[mt][nt][1]), pack2(acc[mt][nt][2], acc[mt][nt][3]));
        }
    }
  }
}

template <int NT>
__device__ __forceinline__ void g2_tile(const Params& p, int l, char* smem, int m0, int n0) {
  const int t_ = tid_op(); const int lane = t_ & 63, wave = t_ >> 6, wm = wave >> 1, wn = wave & 1, fr = lane & 15, fq = lane >> 4;
  const bf16_t* W = p.WtIn + (size_t)l * INC * 1024;
  const bf16_t* Wb = p.WtBr + (size_t)l * 4 * 1024 * 256;
  bf16_t* y = p.z;
#pragma unroll 1
  for (int i = 0; i < 4; i++) {
    f32x4 acc[4][NT];
    unsigned ppk[4][NT][2];
    zero_acc<NT>(acc);
    gemm_mainloop<NT, true, 1>(p.br + (size_t)m0 * 1024 + i * 256, 1024, Wb + ((size_t)i * 1024 + n0) * 256, 256, 4, acc, (bf16_t*)smem);
#pragma unroll
    for (int mt = 0; mt < 4; mt++)
#pragma unroll
      for (int nt = 0; nt < NT; nt++) {
        ppk[mt][nt][0] = pack2(acc[mt][nt][0], acc[mt][nt][1]);
        ppk[mt][nt][1] = pack2(acc[mt][nt][2], acc[mt][nt][3]);
      }
    zero_acc<NT>(acc);
    gemm_mainloop<NT, true, 1>(p.h + (size_t)m0 * 1024, 1024, W + (size_t)(3456 + i * 1024 + n0) * 1024, 1024, 16, acc, (bf16_t*)smem);
#pragma unroll
    for (int mt = 0; mt < 4; mt++)
#pragma unroll
      for (int nt = 0; nt < NT; nt++) {
        const int m = m0 + wm * 64 + mt * 16 + fr;
        const int n = n0 + wn * (NT * 16) + nt * 16 + fq * 4;
        uint2* yp = (uint2*)(y + (size_t)m * 1024 + n);
        uint2 yo = make_uint2(0u, 0u);
        if (i > 0) yo = *yp;
        float y0 = bflo(yo.x) + sigm(acc[mt][nt][0]) * bflo(ppk[mt][nt][0]);
        float y1 = bfhi(yo.x) + sigm(acc[mt][nt][1]) * bfhi(ppk[mt][nt][0]);
        float y2 = bflo(yo.y) + sigm(acc[mt][nt][2]) * bflo(ppk[mt][nt][1]);
        float y3 = bfhi(yo.y) + sigm(acc[mt][nt][3]) * bfhi(ppk[mt][nt][1]);
        *yp = make_uint2(pack2(y0, y1), pack2(y2, y3));
      }
  }
}
__device__ void phase_g2(const Params& p, int l, char* smem) {
  {
    TileIter ti; ti.init(NLAT / 128, 8);
    for (int iter = 0;; iter++) {
      int mtile, ntile;
      if (!ti.get(iter, mtile, ntile)) break;
      g2_tile<4>(p, l, smem, mtile * 128, ntile * 128);
    }
  }
  if (l == 0) {
    TileIter ti; ti.init(NCTX / 128, 16);
    for (int iter = 0;; iter++) {
      int mtile, ntile;
      if (!ti.get(iter, mtile, ntile)) break;
      g2_tile<2>(p, l, smem, NLAT + mtile * 128, ntile * 64);
    }
  }
}

__device__ void phase_g3(const Params& p, int l, char* smem) {
  const int t_ = tid_op(); const int lane = t_ & 63, wave = t_ >> 6, wm = wave >> 1, wn = wave & 1, fr = lane & 15, fq = lane >> 4;
  const bf16_t* W = p.WtOut + (size_t)l * 1024 * 1024;
  const bf16_t* y = p.z;
  const int ntm = (l == 0 ? NTOK : NLAT) / 128;
  TileIter ti; ti.init(ntm, 8);
  for (int iter = 0;; iter++) {
    int mtile, ntile;
    if (!ti.get(iter, mtile, ntile)) break;
    const int m0 = mtile * 128, n0 = ntile * 128;
    f32x4 acc[4][4];
    zero_acc<4>(acc);
    gemm_mainloop<4, true>(y + (size_t)m0 * 1024, 1024, W + (size_t)n0 * 1024, 1024, 16, acc, (bf16_t*)smem);
    const float* src; float* dst; int mb;
    if (m0 < NLAT) { src = (l == 0 ? p.x : p.out) + (size_t)m0 * 1024; dst = p.out + (size_t)m0 * 1024; mb = m0 >> 12; }
    else { src = p.ctx + (size_t)(m0 - NLAT) * 1024; dst = p.ctx1 + (size_t)(m0 - NLAT) * 1024; mb = 8; }
    const float* gate = p.mod + (l * 9 + mb) * 3072 + 2048;
#pragma unroll
    for (int mt = 0; mt < 4; mt++)
#pragma unroll
      for (int nt = 0; nt < 4; nt++) {
        int mr = wm * 64 + mt * 16 + fr;
        int n = n0 + wn * 64 + nt * 16 + fq * 4;
        float4 xv = *(const float4*)(src + (size_t)mr * 1024 + n);
        float4 gv = *(const float4*)(gate + n);
        float4 o = make_float4(xv.x + gv.x * acc[mt][nt][0], xv.y + gv.y * acc[mt][nt][1], xv.z + gv.z * acc[mt][nt][2], xv.w + gv.w * acc[mt][nt][3]);
        *(float4*)(dst + (size_t)mr * 1024 + n) = o;
      }
  }
}

__device__ void scan_item(const Params& p, int l, int item, char* smem) {
  const int rq = item & 1, d = (item >> 1) & 1, h = (item >> 2) & 3, b = item >> 4;
  const int t = tid_op(), lane = t & 63, wave = t >> 6, fr = lane & 15, fq = lane >> 4;
  float* Wd = (float*)smem;
  float* Av = Wd + 2048;
  float* Bv = Av + 2048;
  float* Kd = Bv + 2048;
  float* Rr = Kd + 2048;
  float* Vv = Rr + 2048;
  float* Pf = Vv + 1024;
  float* Yb = Pf;
  float* Qf = Pf + 2048;
  float* prm = Qf + 2048;
  bf16_t* wl = (bf16_t*)(prm + 320);
  bf16_t* al = wl + 32 * 72;

  for (int i = t; i < 320; i += NTHR) {
    int which = i >> 6, k = i & 63;
    float v;
    if (which == 0) v = p.rw_w0[(l * 2 + d) * 256 + h * 64 + k];
    else if (which == 1) v = p.rw_a0[(l * 2 + d) * 256 + h * 64 + k];
    else if (which == 2) v = p.rw_ka[l * 256 + h * 64 + k];
    else if (which == 3) v = p.rw_kk[l * 256 + h * 64 + k];
    else v = p.rw_rk[(l * 4 + h) * 64 + k];
    prm[i] = v;
  }
  bf16x8 w2f[2], a2f[2];
  {
    const int n = h * 64 + 16 * wave + fr;
    const float* w2 = p.rw_w2 + (size_t)(l * 2 + d) * 64 * 256 + n;
    const float* a2 = p.rw_a2 + (size_t)(l * 2 + d) * 64 * 256 + n;
#pragma unroll
    for (int ks = 0; ks < 2; ks++)
#pragma unroll
      for (int j = 0; j < 8; j++) {
        int kk = ks * 32 + fq * 8 + j;
        w2f[ks][j] = (short)f2bf(w2[kk * 256]);
        a2f[ks][j] = (short)f2bf(a2[kk * 256]);
      }
  }
  __syncthreads();

  f32x2 su0 = {0.f, 0.f}, su1 = {0.f, 0.f}, su2 = {0.f, 0.f}, su3 = {0.f, 0.f};
  const int kseg = lane & 15, rowl = wave * 8 + (lane >> 4) * 2;
  const int tt1 = t >> 3, oct = t & 7;
  constexpr int NCH_C = CTXL / 32, NCH_L = SEQ / 32, NCH = NCH_C + NCH_L;
  uint4 rcu[5], rpv[5], rnx[5];
  auto load_raw = [&](int gc) {
    const bool isc = gc < NCH_C;
    const int T = isc ? CTXL : SEQ;
    const int nch = isc ? NCH_C : NCH_L;
    const int ci = isc ? gc : gc - NCH_C;
    const int c = d ? nch - 1 - ci : ci;
    const size_t rowbase = isc ? (size_t)NLAT + b * CTXL : (size_t)b * SEQ;
    const int tok = c * 32 + tt1;
    const bf16_t* zr = p.z + (rowbase + tok) * ZW;
    const bool hp = tok > 0, hn = tok < T - 1;
#pragma unroll
    for (int g = 0; g < 5; g++) {
      const int colbase = g == 0 ? Z_RWR + h * 64 : g == 1 ? Z_RWK + h * 64 : g == 2 ? Z_RWV + h * 64 : g == 3 ? Z_RWW : Z_RWA;
      const int col = colbase + oct * 8;
      rcu[g] = *(const uint4*)(zr + col);
      rpv[g] = make_uint4(0, 0, 0, 0);
      rnx[g] = make_uint4(0, 0, 0, 0);
      if (hp) rpv[g] = *(const uint4*)(zr - ZW + col);
      if (hn) rnx[g] = *(const uint4*)(zr + ZW + col);
    }
  };
  float mureg[5][8];
#pragma unroll
  for (int g = 0; g < 5; g++) {
    const int colbase = g == 0 ? Z_RWR + h * 64 : g == 1 ? Z_RWK + h * 64 : g == 2 ? Z_RWV + h * 64 : g == 3 ? Z_RWW : Z_RWA;
    const float* mup = p.rw_mu + l * 896 + (colbase + oct * 8 - Z_RWR);
    float4 m0 = *(const float4*)mup, m1 = *(const float4*)(mup + 4);
    mureg[g][0] = m0.x; mureg[g][1] = m0.y; mureg[g][2] = m0.z; mureg[g][3] = m0.w;
    mureg[g][4] = m1.x; mureg[g][5] = m1.y; mureg[g][6] = m1.z; mureg[g][7] = m1.w;
  }
  load_raw(0);
  __builtin_amdgcn_s_setprio(2);
#pragma unroll 1
  for (int gc = 0; gc < NCH; gc++) {
    const bool isc = gc < NCH_C;
    const int nch = isc ? NCH_C : NCH_L;
    const int ci = isc ? gc : gc - NCH_C;
    const int c = d ? nch - 1 - ci : ci;
    const size_t rowbase = isc ? (size_t)NLAT + b * CTXL : (size_t)b * SEQ;
    const int t0 = c * 32;
    {
      const int tt = tt1;
      const int tok = t0 + tt;
#pragma unroll
      for (int g = 0; g < 5; g++) {
        const int colbase = g == 0 ? Z_RWR + h * 64 : g == 1 ? Z_RWK + h * 64 : g == 2 ? Z_RWV + h * 64 : g == 3 ? Z_RWW : Z_RWA;
        const int col = colbase + oct * 8;
        float fc[8], fp[8], fn[8], mix[8];
        unpack8(rcu[g], fc); unpack8(rpv[g], fp); unpack8(rnx[g], fn);
#pragma unroll
        for (int i = 0; i < 8; i++) mix[i] = fc[i] + (0.5f * (fp[i] + fn[i]) - fc[i]) * mureg[g][i];
        if (g == 0) {
          *(float4*)(Rr + tt * 64 + oct * 8) = make_float4(mix[0], mix[1], mix[2], mix[3]);
          *(float4*)(Rr + tt * 64 + oct * 8 + 4) = make_float4(mix[4], mix[5], mix[6], mix[7]);
        } else if (g == 1) {
          *(float4*)(Kd + tt * 64 + oct * 8) = make_float4(mix[0], mix[1], mix[2], mix[3]);
          *(float4*)(Kd + tt * 64 + oct * 8 + 4) = make_float4(mix[4], mix[5], mix[6], mix[7]);
        } else if (g == 2) {
          if ((oct >> 2) == rq) {
            *(float4*)(Vv + tt * 32 + (oct & 3) * 8) = make_float4(mix[0], mix[1], mix[2], mix[3]);
            *(float4*)(Vv + tt * 32 + (oct & 3) * 8 + 4) = make_float4(mix[4], mix[5], mix[6], mix[7]);
            if (d == 0) {
              *(uint4*)(p.vmix + (rowbase + tok) * 256 + h * 64 + oct * 8) =
                  make_uint4(pack2(mix[0], mix[1]), pack2(mix[2], mix[3]), pack2(mix[4], mix[5]), pack2(mix[6], mix[7]));
            }
          }
        } else if (g == 3) {
          float th[8];
#pragma unroll
          for (int i = 0; i < 8; i++) th[i] = 1.f - 2.f * frcp(1.f + __expf(2.f * mix[i]));
          *(uint4*)(wl + tt * 72 + oct * 8) = make_uint4(pack2(th[0], th[1]), pack2(th[2], th[3]), pack2(th[4], th[5]), pack2(th[6], th[7]));
        } else {
          *(uint4*)(al + tt * 72 + oct * 8) = make_uint4(pack2(mix[0], mix[1]), pack2(mix[2], mix[3]), pack2(mix[4], mix[5]), pack2(mix[6], mix[7]));
        }
      }
    }
    if (gc + 1 < NCH) load_raw(gc + 1);
    lds_barrier();
    {
#pragma unroll
      for (int mt = 0; mt < 2; mt++) {
        f32x4 ap = {0.f, 0.f, 0.f, 0.f}, aq = {0.f, 0.f, 0.f, 0.f};
#pragma unroll
        for (int ks = 0; ks < 2; ks++) {
          bf16x8 fa = *(const bf16x8*)(wl + (mt * 16 + fr) * 72 + ks * 32 + fq * 8);
          bf16x8 fb = *(const bf16x8*)(al + (mt * 16 + fr) * 72 + ks * 32 + fq * 8);
          ap = mfma16(fa, w2f[ks], ap);
          aq = mfma16(fb, a2f[ks], aq);
        }
#pragma unroll
        for (int j = 0; j < 4; j++) {
          Pf[(mt * 16 + fq * 4 + j) * 64 + wave * 16 + fr] = ap[j];
          Qf[(mt * 16 + fq * 4 + j) * 64 + wave * 16 + fr] = aq[j];
        }
      }
    }
    lds_barrier();
    {
      const int tt = tt1;
      float ss = 0.f, cf = 0.f;
      float kkr[8], aa[8], pv[8], qv[8], kv[8], rv[8], dec[8], kdv[8];
      *(float4*)(pv) = *(const float4*)(Pf + tt * 64 + oct * 8); *(float4*)(pv + 4) = *(const float4*)(Pf + tt * 64 + oct * 8 + 4);
      *(float4*)(qv) = *(const float4*)(Qf + tt * 64 + oct * 8); *(float4*)(qv + 4) = *(const float4*)(Qf + tt * 64 + oct * 8 + 4);
      *(float4*)(kv) = *(const float4*)(Kd + tt * 64 + oct * 8); *(float4*)(kv + 4) = *(const float4*)(Kd + tt * 64 + oct * 8 + 4);
      *(float4*)(rv) = *(const float4*)(Rr + tt * 64 + oct * 8); *(float4*)(rv + 4) = *(const float4*)(Rr + tt * 64 + oct * 8 + 4);
#pragma unroll
      for (int i = 0; i < 8; i++) {
        const int k = oct * 8 + i;
        float pp = prm[k] + pv[i];
        dec[i] = __expf(-0.6065306597f * sigm(pp));
        float a = sigm(prm[64 + k] + qv[i]);
        float kr = kv[i];
        kdv[i] = kr * (1.f + (a - 1.f) * prm[128 + k]);
        kkr[i] = kr * prm[192 + k];
        ss += kkr[i] * kkr[i];
        cf += rv[i] * kdv[i] * prm[256 + k];
        aa[i] = a;
      }
      ss = red8_sum(ss);
      cf = red8_sum(cf);
      float inv = frcp(fmaxf(__builtin_amdgcn_sqrtf(ss), 1e-12f));
      float av[8], bv[8];
#pragma unroll
      for (int i = 0; i < 8; i++) { float kk = kkr[i] * inv; av[i] = -kk; bv[i] = kk * aa[i]; }
      *(float4*)(Wd + tt * 64 + oct * 8) = *(float4*)(dec); *(float4*)(Wd + tt * 64 + oct * 8 + 4) = *(float4*)(dec + 4);
      *(float4*)(Kd + tt * 64 + oct * 8) = *(float4*)(kdv); *(float4*)(Kd + tt * 64 + oct * 8 + 4) = *(float4*)(kdv + 4);
      *(float4*)(Av + tt * 64 + oct * 8) = *(float4*)(av); *(float4*)(Av + tt * 64 + oct * 8 + 4) = *(float4*)(av + 4);
      *(float4*)(Bv + tt * 64 + oct * 8) = *(float4*)(bv); *(float4*)(Bv + tt * 64 + oct * 8 + 4) = *(float4*)(bv + 4);
      if (rq == 0 && oct == 0) p.coef[((size_t)d * NTOK + rowbase + t0 + tt) * 4 + h] = cf;
    }
    lds_barrier();
    {
      const int step = d ? -1 : 1;
      int tt = d ? 31 : 0;
      float4 w = *(const float4*)(Wd + tt * 64 + kseg * 4);
      float4 a = *(const float4*)(Av + tt * 64 + kseg * 4);
      float4 bb = *(const float4*)(Bv + tt * 64 + kseg * 4);
      float4 kd = *(const float4*)(Kd + tt * 64 + kseg * 4);
      float4 r = *(const float4*)(Rr + tt * 64 + kseg * 4);
      float2 v = *(const float2*)(Vv + tt * 32 + rowl);
      float ysel0 = 0.f, ysel1 = 0.f;
#pragma unroll 16
      for (int i = 0; i < 32; i++) {
        const int tn = (i < 31) ? tt + step : tt;
        float4 w2 = *(const float4*)(Wd + tn * 64 + kseg * 4);
        float4 a2 = *(const float4*)(Av + tn * 64 + kseg * 4);
        float4 b2 = *(const float4*)(Bv + tn * 64 + kseg * 4);
        float4 k2 = *(const float4*)(Kd + tn * 64 + kseg * 4);
        float4 r2 = *(const float4*)(Rr + tn * 64 + kseg * 4);
        float2 v2 = *(const float2*)(Vv + tn * 32 + rowl);
        f32x2 sau = (su0 * a.x + su1 * a.y) + (su2 * a.z + su3 * a.w);
        float sa = sau.x, ua = sau.y;
        red16_sum2(sa, ua);
        sau = f32x2{sa, ua};
        const f32x2 vv = f32x2{v.x, v.y};
        su0 = su0 * w.x + sau * bb.x + vv * kd.x;
        su1 = su1 * w.y + sau * bb.y + vv * kd.y;
        su2 = su2 * w.z + sau * bb.z + vv * kd.z;
        su3 = su3 * w.w + sau * bb.w + vv * kd.w;
        const f32x2 yy = (su0 * r.x + su1 * r.y) + (su2 * r.z + su3 * r.w);
        float y0 = yy.x, y1 = yy.y;
        red16_sum2(y0, y1);
        ysel0 = ((i & 15) == kseg) ? y0 : ysel0;
        ysel1 = ((i & 15) == kseg) ? y1 : ysel1;
        if ((i & 15) == 15) {
          const int si = (i - 15) + kseg;
          const int ts = d ? 31 - si : si;
          *(float2*)(Yb + ts * 32 + rowl) = make_float2(ysel0, ysel1);
        }
        w = w2; a = a2; bb = b2; kd = k2; r = r2; v = v2; tt = tn;
      }
    }
    lds_barrier();
    {
      const int tt = t >> 3, q4 = t & 7;
      float4 yv = *(const float4*)(Yb + tt * 32 + q4 * 4);
      *(float4*)(p.yscan + ((size_t)d * NTOK + rowbase + t0 + tt) * 256 + h * 64 + rq * 32 + q4 * 4) = yv;
    }
  }
  __builtin_amdgcn_s_setprio(0);
  __syncthreads();
}

template <int nband>
__device__ void natten_item(const Params& p, int l, int b, int h, size_t qrow0, int r, char* smem) {
  const int t = tid_op(), lane = t & 63, wave = t >> 6, fr = lane & 15, fq = lane >> 4;
  float* rpb = (float*)smem;
  bf16_t* Ps = (bf16_t*)(smem + 2048) + wave * 16 * 72;
  for (int i = t; i < 465; i += NTHR) rpb[i] = p.na_rpb[(l * 4 + h) * 465 + i];
  __syncthreads();
  const int qloc = wave * 16;
  bf16x8 qf[2];
#pragma unroll
  for (int ks = 0; ks < 2; ks++) qf[ks] = *(const bf16x8*)(p.z + (qrow0 + qloc + fr) * ZW + Z_NAQ + h * 64 + ks * 32 + fq * 8);
  float mrow[4], lrow[4];
  f32x4 o[4];
#pragma unroll
  for (int j = 0; j < 4; j++) { mrow[j] = -1e30f; lrow[j] = 0.f; o[j] = f32x4{0.f, 0.f, 0.f, 0.f}; }
  const int rstart = min(max(r - 4, 0), 56);
  const int c0w = wave == 0 ? 0 : wave == 1 ? 8 : wave == 2 ? 24 : 32;
#define LDF(PTR) (*(const bf16x8*)(PTR))
  const bf16_t* kcp = p.z + ((size_t)NLAT + b * CTXL + fr) * ZW + Z_NAK + h * 64 + fq * 8;
  const bf16_t* vcp = p.zvTc + ((size_t)(b * 256 + h * 64 + fr)) * 256 + fq * 8;
  bf16x8 kc0 = LDF(kcp), kc1 = LDF(kcp + 32), kc2 = LDF(kcp + 16 * ZW), kc3 = LDF(kcp + 16 * ZW + 32);
  bf16x8 kc4 = LDF(kcp + 32 * ZW), kc5 = LDF(kcp + 32 * ZW + 32), kc6 = LDF(kcp + 48 * ZW), kc7 = LDF(kcp + 48 * ZW + 32);
  if (nband > 0) {
    const bf16_t* kp = p.z + ((size_t)b * SEQ + rstart * 64 + c0w + fr) * ZW + Z_NAK + h * 64 + fq * 8;
    const bf16_t* vp = p.zvT + ((size_t)(b * 256 + h * 64 + fr)) * 4096 + rstart * 64 + c0w + fq * 8;
    bf16x8 kb0 = LDF(kp), kb1 = LDF(kp + 32), kb2 = LDF(kp + 16 * ZW), kb3 = LDF(kp + 16 * ZW + 32);
    bf16x8 vb0 = LDF(vp), vb1 = LDF(vp + 16 * 4096), vb2 = LDF(vp + 32 * 4096), vb3 = LDF(vp + 48 * 4096);
#pragma unroll 1
    for (int kt = 0; kt < nband; kt++) {
      const int rr = rstart + kt;
      kp += 64 * ZW; vp += 64;
      bf16x8 kn0 = kb0, kn1 = kb1, kn2 = kb2, kn3 = kb3, vn0 = vb0, vn1 = vb1, vn2 = vb2, vn3 = vb3;
      if (kt + 1 < nband) {
        kn0 = LDF(kp); kn1 = LDF(kp + 32); kn2 = LDF(kp + 16 * ZW); kn3 = LDF(kp + 16 * ZW + 32);
        vn0 = LDF(vp); vn1 = LDF(vp + 16 * 4096); vn2 = LDF(vp + 32 * 4096); vn3 = LDF(vp + 48 * 4096);
      }
      f32x4 s[2];
      s[0] = mfma16(qf[0], kb0, f32x4{0.f, 0.f, 0.f, 0.f}); s[0] = mfma16(qf[1], kb1, s[0]);
      s[1] = mfma16(qf[0], kb2, f32x4{0.f, 0.f, 0.f, 0.f}); s[1] = mfma16(qf[1], kb3, s[1]);
      float pj[2][4];
#pragma unroll
      for (int j = 0; j < 4; j++) {
        const int q = qloc + fq * 4 + j;
        float mx = -1e30f;
#pragma unroll
        for (int nt = 0; nt < 2; nt++) {
          const int kc = c0w + nt * 16 + fr;
          const int cs = min(max(q - 8, 0), 48);
          const bool ok = (kc >= cs) && (kc < cs + 16);
          const int dc = min(max(kc - q, -15), 15);
          float bias = rpb[(rr - r + 7) * 31 + dc + 15];
          float val = ok ? s[nt][j] * 0.125f + bias : -1e30f;
          pj[nt][j] = val;
          mx = fmaxf(mx, val);
        }
        mx = red16_max(mx);
        const float mnew = fmaxf(mrow[j], mx);
        const float alpha = __expf(mrow[j] - mnew);
        float sum = 0.f;
#pragma unroll
        for (int nt = 0; nt < 2; nt++) { float e = __expf(pj[nt][j] - mnew); pj[nt][j] = e; sum += e; }
        sum = red16_sum(sum);
        lrow[j] = lrow[j] * alpha + sum;
        mrow[j] = mnew;
#pragma unroll
        for (int nt = 0; nt < 4; nt++) o[nt][j] *= alpha;
      }
#pragma unroll
      for (int nt = 0; nt < 2; nt++)
#pragma unroll
        for (int j = 0; j < 4; j++) Ps[(fq * 4 + j) * 72 + nt * 16 + fr] = f2bf(pj[nt][j]);
      __builtin_amdgcn_fence(__ATOMIC_RELEASE, "wavefront");
      __builtin_amdgcn_wave_barrier();
      __builtin_amdgcn_fence(__ATOMIC_ACQUIRE, "wavefront");
      bf16x8 pf = *(const bf16x8*)(Ps + fr * 72 + fq * 8);
      o[0] = mfma16(pf, vb0, o[0]); o[1] = mfma16(pf, vb1, o[1]); o[2] = mfma16(pf, vb2, o[2]); o[3] = mfma16(pf, vb3, o[3]);
      __builtin_amdgcn_fence(__ATOMIC_RELEASE, "wavefront");
      __builtin_amdgcn_wave_barrier();
      kb0 = kn0; kb1 = kn1; kb2 = kn2; kb3 = kn3; vb0 = vn0; vb1 = vn1; vb2 = vn2; vb3 = vn3;
    }
  }
#pragma unroll 1
  for (int cc = 0; cc < 4; cc++) {
    bf16x8 vfc[4][2];
#pragma unroll
    for (int nt = 0; nt < 4; nt++)
#pragma unroll
      for (int ks = 0; ks < 2; ks++) vfc[nt][ks] = *(const bf16x8*)(vcp + (size_t)(nt * 16) * 256 + ks * 32);
    vcp += 64;
    kcp += 64 * ZW;
    bf16x8 kn0 = kc0, kn1 = kc1, kn2 = kc2, kn3 = kc3, kn4 = kc4, kn5 = kc5, kn6 = kc6, kn7 = kc7;
    if (cc + 1 < 4) {
      kn0 = LDF(kcp); kn1 = LDF(kcp + 32); kn2 = LDF(kcp + 16 * ZW); kn3 = LDF(kcp + 16 * ZW + 32);
      kn4 = LDF(kcp + 32 * ZW); kn5 = LDF(kcp + 32 * ZW + 32); kn6 = LDF(kcp + 48 * ZW); kn7 = LDF(kcp + 48 * ZW + 32);
    }
    f32x4 s[4];
    s[0] = mfma16(qf[0], kc0, f32x4{0.f, 0.f, 0.f, 0.f}); s[0] = mfma16(qf[1], kc1, s[0]);
    s[1] = mfma16(qf[0], kc2, f32x4{0.f, 0.f, 0.f, 0.f}); s[1] = mfma16(qf[1], kc3, s[1]);
    s[2] = mfma16(qf[0], kc4, f32x4{0.f, 0.f, 0.f, 0.f}); s[2] = mfma16(qf[1], kc5, s[2]);
    s[3] = mfma16(qf[0], kc6, f32x4{0.f, 0.f, 0.f, 0.f}); s[3] = mfma16(qf[1], kc7, s[3]);
    float pj[4][4];
#pragma unroll
    for (int j = 0; j < 4; j++) {
      float mx = -1e30f;
#pragma unroll
      for (int nt = 0; nt < 4; nt++) { float val = s[nt][j] * 0.125f; pj[nt][j] = val; mx = fmaxf(mx, val); }
      mx = red16_max(mx);
      const float mnew = fmaxf(mrow[j], mx);
      const float alpha = __expf(mrow[j] - mnew);
      float sum = 0.f;
#pragma unroll
      for (int nt = 0; nt < 4; nt++) { float e = __expf(pj[nt][j] - mnew); pj[nt][j] = e; sum += e; }
      sum = red16_sum(sum);
      lrow[j] = lrow[j] * alpha + sum;
      mrow[j] = mnew;
#pragma unroll
      for (int nt = 0; nt < 4; nt++) o[nt][j] *= alpha;
    }
#pragma unroll
    for (int nt = 0; nt < 4; nt++)
#pragma unroll
      for (int j = 0; j < 4; j++) Ps[(fq * 4 + j) * 72 + nt * 16 + fr] = f2bf(pj[nt][j]);
    __builtin_amdgcn_fence(__ATOMIC_RELEASE, "wavefront");
    __builtin_amdgcn_wave_barrier();
    __builtin_amdgcn_fence(__ATOMIC_ACQUIRE, "wavefront");
    bf16x8 pf[2];
#pragma unroll
    for (int ks = 0; ks < 2; ks++) pf[ks] = *(const bf16x8*)(Ps + fr * 72 + ks * 32 + fq * 8);
#pragma unroll
    for (int nt = 0; nt < 4; nt++)
#pragma unroll
      for (int ks = 0; ks < 2; ks++) o[nt] = mfma16(pf[ks], vfc[nt][ks], o[nt]);
    __builtin_amdgcn_fence(__ATOMIC_RELEASE, "wavefront");
    __builtin_amdgcn_wave_barrier();
    kc0 = kn0; kc1 = kn1; kc2 = kn2; kc3 = kn3; kc4 = kn4; kc5 = kn5; kc6 = kn6; kc7 = kn7;
  }
#undef LDF
#pragma unroll
  for (int j = 0; j < 4; j++) {
    const size_t row = qrow0 + qloc + fq * 4 + j;
    const float inv = frcp(lrow[j]);
#pragma unroll
    for (int nt = 0; nt < 4; nt++) {
      const int dcol = nt * 16 + fr;
      float g = silu_(bf2f(p.z[row * ZW + Z_NAG + h * 64 + dcol]));
      p.br[row * 1024 + 256 + h * 64 + dcol] = f2bf(o[nt][j] * inv * g);
    }
  }
  __syncthreads();
}

__device__ void gmlp_item(const Params& p, int l, size_t row0, int g, char* smem) {
  const int t = tid_op(), lane = t & 63, wave = t >> 6, fr = lane & 15, fq = lane >> 4;
  bf16_t* Ws = (bf16_t*)smem;
  bf16_t* VhT = Ws + 128 * 136;
  const float* ws = p.gm_ws + (size_t)(l * 4 + g) * 128 * 128;
#pragma unroll
  for (int i = 0; i < 16; i++) {
    int e = (i * NTHR + t) * 4;
    int pr = e >> 7, q = e & 127;
    float4 v = *(const float4*)(ws + e);
    *(uint2*)(Ws + pr * 136 + q) = make_uint2(pack2(v.x, v.y), pack2(v.z, v.w));
  }
  {
    const int q = t >> 1, half = t & 1;
    const bf16_t* zr = p.z + (row0 + q) * ZW + Z_GMV + g * 64 + half * 32;
    float v[32];
#pragma unroll
    for (int i = 0; i < 4; i++) { uint4 u = *(const uint4*)(zr + i * 8); unpack8(u, v + i * 8); }
    float sum = 0.f;
#pragma unroll
    for (int i = 0; i < 32; i++) { v[i] = gelu_(v[i]); sum += v[i]; }
    sum += dppf<0xB1>(sum);
    const float mu = sum * (1.f / 64.f);
    float vs = 0.f;
#pragma unroll
    for (int i = 0; i < 32; i++) { float dd = v[i] - mu; vs += dd * dd; }
    vs += dppf<0xB1>(vs);
    const float rs = rsqrtf(vs * (1.f / 64.f) + 1e-6f);
    const float* lg = p.gm_ln_g + (l * 4 + g) * 64 + half * 32;
    const float* lb = p.gm_ln_b + (l * 4 + g) * 64 + half * 32;
#pragma unroll
    for (int i = 0; i < 32; i++) VhT[(half * 32 + i) * 136 + q] = f2bf((v[i] - mu) * rs * lg[i] + lb[i]);
  }
  __syncthreads();
  f32x4 acc[2][4];
#pragma unroll
  for (int mt = 0; mt < 2; mt++)
#pragma unroll
    for (int nt = 0; nt < 4; nt++) acc[mt][nt] = f32x4{0.f, 0.f, 0.f, 0.f};
#pragma unroll
  for (int ks = 0; ks < 4; ks++) {
    bf16x8 af[2], bfr[4];
#pragma unroll
    for (int mt = 0; mt < 2; mt++) af[mt] = *(const bf16x8*)(Ws + (wave * 32 + mt * 16 + fr) * 136 + ks * 32 + fq * 8);
#pragma unroll
    for (int nt = 0; nt < 4; nt++) bfr[nt] = *(const bf16x8*)(VhT + (nt * 16 + fr) * 136 + ks * 32 + fq * 8);
#pragma unroll
    for (int mt = 0; mt < 2; mt++)
#pragma unroll
      for (int nt = 0; nt < 4; nt++) acc[mt][nt] = mfma16(bfr[nt], af[mt], acc[mt][nt]);
  }
#pragma unroll
  for (int mt = 0; mt < 2; mt++) {
    const int pr = wave * 32 + mt * 16 + fr;
    const float bs = p.gm_bs[(l * 4 + g) * 128 + pr];
    const bf16_t* zr = p.z + (row0 + pr) * ZW;
#pragma unroll
    for (int nt = 0; nt < 4; nt++) {
      const int c = nt * 16 + fq * 4;
      uint2 uu = *(const uint2*)(zr + Z_GMU + g * 64 + c);
      uint2 gg = *(const uint2*)(zr + Z_GMG + g * 64 + c);
      float o0 = gelu_(bflo(uu.x)) * (acc[mt][nt][0] + bs) * silu_(bflo(gg.x));
      float o1 = gelu_(bfhi(uu.x)) * (acc[mt][nt][1] + bs) * silu_(bfhi(gg.x));
      float o2 = gelu_(bflo(uu.y)) * (acc[mt][nt][2] + bs) * silu_(bflo(gg.y));
      float o3 = gelu_(bfhi(uu.y)) * (acc[mt][nt][3] + bs) * silu_(bfhi(gg.y));
      *(uint2*)(p.br + (row0 + pr) * 1024 + g * 64 + c) = make_uint2(pack2(o0, o1), pack2(o2, o3));
    }
  }
  __syncthreads();
}

__device__ void pool_item(const Params& p, int l, size_t seqrow0, int T, int t0, int g, char* smem) {
  const int t = tid_op(), lane = t & 63, wave = t >> 6, fr = lane & 15, fq = lane >> 4;
  float* Pp = (float*)smem;
  bf16_t* Dd = (bf16_t*)(Pp + 80 * 64);
  bf16_t* WT = Dd + 64 * 72;
  const int hw = 1 << g;
  for (int i = t; i < 80 * 8; i += NTHR) {
    int rr = i >> 3, oc = i & 7;
    int tok = t0 - 8 + rr;
    float f[8];
    if (tok >= 0 && tok < T) { uint4 u = *(const uint4*)(p.z + (seqrow0 + tok) * ZW + Z_PLP + g * 64 + oc * 8); unpack8(u, f); }
    else {
#pragma unroll
      for (int k = 0; k < 8; k++) f[k] = 0.f;
    }
#pragma unroll
    for (int k = 0; k < 8; k++) Pp[rr * 64 + oc * 8 + k] = f[k];
  }
  {
    const float* w = p.pl_w + (size_t)(l * 4 + g) * 64 * 64;
#pragma unroll
    for (int i = 0; i < 16; i++) {
      int e = i * NTHR + t;
      int c = e >> 6, dd = e & 63;
      WT[dd * 72 + c] = f2bf(w[e]);
    }
  }
  __syncthreads();
  {
    const int c = t & 63, tq = t >> 6;
    for (int i = 0; i < 16; i++) {
      const int tl = tq * 16 + i;
      const int tok = t0 + tl;
      const int lo = max(tok - hw, 0), hi = min(tok + hw, T);
      float s = 0.f;
      for (int u = lo; u < hi; u++) s += Pp[(u - t0 + 8) * 64 + c];
      float dv = s / (float)(hi - lo) - Pp[(tl + 8) * 64 + c];
      Dd[tl * 72 + c] = f2bf(dv);
    }
  }
  __syncthreads();
  f32x4 acc[4];
#pragma unroll
  for (int nt = 0; nt < 4; nt++) acc[nt] = f32x4{0.f, 0.f, 0.f, 0.f};
#pragma unroll
  for (int ks = 0; ks < 2; ks++) {
    bf16x8 af = *(const bf16x8*)(Dd + (wave * 16 + fr) * 72 + ks * 32 + fq * 8);
#pragma unroll
    for (int nt = 0; nt < 4; nt++) {
      bf16x8 bw = *(const bf16x8*)(WT + (nt * 16 + fr) * 72 + ks * 32 + fq * 8);
      acc[nt] = mfma16(bw, af, acc[nt]);
    }
  }
  {
    const size_t row = seqrow0 + t0 + wave * 16 + fr;
#pragma unroll
    for (int nt = 0; nt < 4; nt++) {
      const int dd = g * 64 + nt * 16 + fq * 4;
      float4 sc = *(const float4*)(p.pl_scale + l * 256 + dd);
      uint2 gg = *(const uint2*)(p.z + row * ZW + Z_PLG + dd);
      float o0 = acc[nt][0] * sc.x * silu_(bflo(gg.x));
      float o1 = acc[nt][1] * sc.y * silu_(bfhi(gg.x));
      float o2 = acc[nt][2] * sc.z * silu_(bflo(gg.y));
      float o3 = acc[nt][3] * sc.w * silu_(bfhi(gg.y));
      *(uint2*)(p.br + row * 1024 + 768 + dd) = make_uint2(pack2(o0, o1), pack2(o2, o3));
    }
  }
  __syncthreads();
}


constexpr unsigned ROLE_IDLE = 0xFFFF0001u, ROLE_WORK = 0x10000u;
__device__ void publish_cu(const Params& p) {
  if (threadIdx.x == 0 && gridDim.x == 512) {
    unsigned hw = __builtin_amdgcn_s_getreg(63492);
    unsigned xcc = __builtin_amdgcn_s_getreg(63508);
    p.cuinfo[blockIdx.x] = ((xcc & 0xfu) << 16) | (hw & 0xff00u);
  }
}
__device__ void compute_roles(const Params& p, char* smem) {
  const int t = tid_op();
  if (gridDim.x != 512) { if (t == 0) p.cuinfo[1024] = 1u; return; }
  unsigned* keys = (unsigned*)smem;
  unsigned* mate = keys + 512;
  unsigned* prim = mate + 512;
  for (int i = t; i < 512; i += NTHR) keys[i] = p.cuinfo[i];
  __syncthreads();
  int bad = 0;
  for (int i = t; i < 512; i += NTHR) {
    int cnt = 0, m = 0;
    for (int j = 0; j < 512; j++) if (j != i && keys[j] == keys[i]) { cnt++; m = j; }
    if (cnt != 1) bad = 1;
    mate[i] = (unsigned)m;
    prim[i] = (cnt == 1 && i < m) ? 1u : 0u;
  }
  bad = __syncthreads_or(bad);
  for (int i = t; i < 512; i += NTHR) {
    const int pi = prim[i] ? i : (int)mate[i];
    int rank = 0;
    for (int j = 0; j < pi; j++) rank += (int)prim[j];
    unsigned role;
    if (rank < 128) role = prim[i] ? (unsigned)rank : ROLE_IDLE;
    else role = ROLE_WORK + (unsigned)((rank - 128) * 2 + (prim[i] ? 0 : 1));
    p.cuinfo[512 + i] = role;
  }
  if (t == 0) p.cuinfo[1024] = bad ? 1u : 0u;
  __syncthreads();
}

__device__ void worker_barrier(unsigned* cnt, unsigned target) {
  asm volatile("s_waitcnt vmcnt(0)" ::: "memory");
  __syncthreads();
  if (threadIdx.x == 0) {
    __builtin_amdgcn_fence(__ATOMIC_RELEASE, "agent");
    atomicAdd(cnt, 1u);
    while (__hip_atomic_load(cnt, __ATOMIC_RELAXED, __HIP_MEMORY_SCOPE_AGENT) < target) __builtin_amdgcn_s_sleep(2);
    __builtin_amdgcn_fence(__ATOMIC_ACQUIRE, "agent");
    asm volatile("s_waitcnt vmcnt(0)" ::: "memory");
  }
  __syncthreads();
}
__device__ void phase_mix(const Params& p, int l, char* smem, int cslot) {
  __shared__ unsigned s_item;
  if (!(cslot & 4)) for (int it = blockIdx.x; it < 128; it += gridDim.x) scan_item(p, l, it, smem);
  cslot &= 3;
  const int n_na = 2048, n_ca = (l == 0 ? 128 : 0), n_gm = 1024, n_gc = (l == 0 ? 64 : 0), n_pl = 2048, n_pc = (l == 0 ? 128 : 0);
  const int total = n_na + n_ca + n_gm + n_gc + n_pl + n_pc;
  while (true) {
    if (threadIdx.x == 0) s_item = atomicAdd(p.ctr + cslot, 1u);
    __syncthreads();
    int it = (int)s_item;
    __syncthreads();
    if (it >= total) break;
    if (it < n_na) {
      int r = it & 63, h = (it >> 6) & 3, b = it >> 8;
      natten_item<8>(p, l, b, h, (size_t)b * SEQ + r * 64, r, smem);
      continue;
    }
    it -= n_na;
    if (it < n_ca) {
      int qt = it & 3, h = (it >> 2) & 3, b = it >> 4;
      natten_item<0>(p, l, b, h, (size_t)NLAT + b * CTXL + qt * 64, 0, smem);
      continue;
    }
    it -= n_ca;
    if (it < n_gm) {
      int g = it & 3, ch = (it >> 2) & 31, b = it >> 7;
      gmlp_item(p, l, (size_t)b * SEQ + ch * 128, g, smem);
      continue;
    }
    it -= n_gm;
    if (it < n_gc) {
      int g = it & 3, ch = (it >> 2) & 1, b = it >> 3;
      gmlp_item(p, l, (size_t)NLAT + b * CTXL + ch * 128, g, smem);
      continue;
    }
    it -= n_gc;
    if (it < n_pl) {
      int g = it & 3, tl = (it >> 2) & 63, b = it >> 8;
      pool_item(p, l, (size_t)b * SEQ, SEQ, tl * 64, g, smem);
      continue;
    }
    it -= n_pl;
    {
      int g = it & 3, tl = (it >> 2) & 3, b = it >> 4;
      pool_item(p, l, (size_t)NLAT + b * CTXL, CTXL, tl * 64, g, smem);
    }
  }
}

__device__ void phase_rwfin(const Params& p, int l) {
  const int t_ = tid_op();
  const int lane = t_ & 63;
  const int gw = blockIdx.x * 4 + (t_ >> 6), nw = gridDim.x * 4;
  const int nrow = (l == 0 ? NTOK : NLAT);
  const int hh = lane >> 4, c0 = lane * 4;
  float4 gg = *(const float4*)(p.rw_gn_g + l * 256 + c0);
  float4 gb = *(const float4*)(p.rw_gn_b + l * 256 + c0);
  for (int r = gw; r < nrow; r += nw) {
    float4 y0 = *(const float4*)(p.yscan + (size_t)r * 256 + c0);
    float4 y1 = *(const float4*)(p.yscan + ((size_t)NTOK + r) * 256 + c0);
    float o0 = y0.x + y1.x, o1 = y0.y + y1.y, o2 = y0.z + y1.z, o3 = y0.w + y1.w;
    float mu = red16_sum(o0 + o1 + o2 + o3) * (1.f / 64.f);
    float d0 = o0 - mu, d1 = o1 - mu, d2 = o2 - mu, d3 = o3 - mu;
    float var = red16_sum(d0 * d0 + d1 * d1 + d2 * d2 + d3 * d3) * (1.f / 64.f);
    float rs = rsqrtf(var + 64e-5f);
    float cf = p.coef[(size_t)r * 4 + hh] + p.coef[((size_t)NTOK + r) * 4 + hh];
    uint2 vm = *(const uint2*)(p.vmix + (size_t)r * 256 + c0);
    uint2 zg = *(const uint2*)(p.z + (size_t)r * ZW + Z_RWG + c0);
    float r0 = (d0 * rs * gg.x + gb.x + cf * bflo(vm.x)) * silu_(bflo(zg.x));
    float r1 = (d1 * rs * gg.y + gb.y + cf * bfhi(vm.x)) * silu_(bfhi(zg.x));
    float r2 = (d2 * rs * gg.z + gb.z + cf * bflo(vm.y)) * silu_(bflo(zg.y));
    float r3 = (d3 * rs * gg.w + gb.w + cf * bfhi(vm.y)) * silu_(bfhi(zg.y));
    *(uint2*)(p.br + (size_t)r * 1024 + 512 + c0) = make_uint2(pack2(r0, r1), pack2(r2, r3));
  }
}

__device__ __forceinline__ void gsync(cg::grid_group& grid) {
  asm volatile("s_waitcnt vmcnt(0)" ::: "memory");
  grid.sync();
}

#define XB_XCNT(j) (64 * (j))
#define XB_XSUB(j) (1024 + 64 * (j))
#define XB_XGEN(j) (2048 + 64 * (j))
#define XB_TOP 3072
#define XB_TOPGEN 3136
constexpr int XB_WORDS = 3200;
__device__ __forceinline__ unsigned xb_ld(unsigned* q) { return __hip_atomic_load(q, __ATOMIC_RELAXED, __HIP_MEMORY_SCOPE_AGENT); }
__device__ __forceinline__ unsigned xb_add(unsigned* q, unsigned v) { return __hip_atomic_fetch_add(q, v, __ATOMIC_RELAXED, __HIP_MEMORY_SCOPE_AGENT); }
#define XB_SPIN(cond) do { unsigned _sp = 0; while (cond) { __builtin_amdgcn_s_sleep(1); if (++_sp > (1u << 24)) break; } } while (0)
__device__ __forceinline__ void xsync(unsigned* bar, volatile unsigned* st) {
  asm volatile("s_waitcnt vmcnt(0)" ::: "memory");
  __syncthreads();
  if (threadIdx.x == 0) {
    __builtin_amdgcn_s_waitcnt(0);
    const unsigned nloc = st[0], nx = st[1], x = st[2];
    const unsigned old = xb_add(&bar[XB_XSUB(x)], 1u);
    const unsigned gen = old / nloc;
    if (old + 1u == (gen + 1u) * nloc) {
      __builtin_amdgcn_fence(__ATOMIC_RELEASE, "agent");
      asm volatile("s_waitcnt vmcnt(0)" ::: "memory");
      const unsigned og = xb_add(&bar[XB_TOP], 1u);
      const unsigned tg = og / nx;
      if (og + 1u == (tg + 1u) * nx) xb_add(&bar[XB_TOPGEN], 1u);
      else XB_SPIN(xb_ld(&bar[XB_TOPGEN]) == tg);
      __builtin_amdgcn_fence(__ATOMIC_ACQUIRE, "agent");
      xb_add(&bar[XB_XGEN(x)], 1u);
      asm volatile("s_waitcnt vmcnt(0)" ::: "memory");
    } else {
      XB_SPIN(xb_ld(&bar[XB_XGEN(x)]) == gen);
      __builtin_amdgcn_fence(__ATOMIC_ACQUIRE, "agent");
      asm volatile("s_waitcnt vmcnt(0)" ::: "memory");
    }
  }
  __syncthreads();
}
__global__ void __launch_bounds__(NTHR, 2) hybrid_mega(Params p) {
  extern __shared__ __attribute__((aligned(16))) char smem[];
  cg::grid_group grid = cg::this_grid();
  __shared__ unsigned xb_st[4];
  const unsigned my_xcc = (unsigned)__builtin_amdgcn_s_getreg((3 << 11) | 20) & 0xFu;
  if (threadIdx.x == 0) (void)xb_add(&p.xbar[XB_XCNT(my_xcc)], 1u);
  publish_cu(p);
  phase0(p, smem);
  if (p.xbar == nullptr) gsync(grid);
  if (threadIdx.x == 0) {
    unsigned mine = 0, cnt = 0, sum = 0, sp = 0;
    for (;;) {
      mine = 0; cnt = 0; sum = 0;
      for (unsigned j = 0; j < 16; j++) { const unsigned c = xb_ld(&p.xbar[XB_XCNT(j)]); sum += c; cnt += c > 0u ? 1u : 0u; mine = j == my_xcc ? c : mine; }
      if (sum == gridDim.x || ++sp > (1u << 22)) break;
      __builtin_amdgcn_s_sleep(1);
    }
    xb_st[0] = mine > 0u ? mine : 1u; xb_st[1] = cnt > 0u ? cnt : 1u; xb_st[2] = my_xcc;
  }
  __syncthreads();
  xsync(p.xbar, xb_st);
  if (blockIdx.x == 0) compute_roles(p, smem);
#pragma unroll 1
  for (int l = 0; l < 2; l++) {
    phase_norm(p, l, l == 0 ? p.x : p.out, l == 0 ? p.ctx : p.ctx1);
    xsync(p.xbar, xb_st);
    const bool overlap = (gridDim.x == 512) && (p.cuinfo[1024] == 0u);
    phase_g1(p, l, smem, overlap ? 1 : 0, -1, 0);
    xsync(p.xbar, xb_st);
    {
      if (overlap) {
        const unsigned role = p.cuinfo[512 + blockIdx.x];
        if (role < 128u) scan_item(p, l, (int)role, smem);
        else if (role >= ROLE_WORK && role < ROLE_WORK + 256u) {
          phase_g1(p, l, smem, 2, (int)(role - ROLE_WORK), 256);
          worker_barrier(p.ctr + 4 + l, 256u);
          phase_mix(p, l, smem, l | 4);
        }
      } else {
        for (int it = blockIdx.x; it < 128; it += gridDim.x) scan_item(p, l, it, smem);
      }
      xsync(p.xbar, xb_st);
      if (!overlap) phase_mix(p, l, smem, l | 4);
      phase_rwfin(p, l);
      xsync(p.xbar, xb_st);
    }
    phase_g2(p, l, smem);
    xsync(p.xbar, xb_st);
    if (DUP_MASK & 2) { phase_g2(p, l, smem); xsync(p.xbar, xb_st); }
    phase_g3(p, l, smem);
    xsync(p.xbar, xb_st);
    if ((DUP_MASK & 8) && l == 0) { phase_g3(p, l, smem); xsync(p.xbar, xb_st); }
  }
  phase_final(p);
}

extern "C" void kernel_launch(void* const* d_in, const int* in_sizes, int n_in, void* d_out, int out_size, void* d_ws,
                              size_t ws_size, hipStream_t stream) {
  static int grid_blocks = 0;
  if (!grid_blocks) {
    int dev = 0, cus = 0, per_cu = 0;
    hipGetDevice(&dev);
    hipDeviceGetAttribute(&cus, hipDeviceAttributeMultiprocessorCount, dev);
    hipFuncSetAttribute((const void*)hybrid_mega, hipFuncAttributeMaxDynamicSharedMemorySize, LDS_BYTES);
    hipOccupancyMaxActiveBlocksPerMultiprocessor(&per_cu, hybrid_mega, NTHR, LDS_BYTES);
    if (per_cu > 2) per_cu = 2;
    if (per_cu < 1) per_cu = 1;
    grid_blocks = cus * per_cu;
  }
  Params p{};
  const float* const* in = (const float* const*)d_in;
  p.x = in[0]; p.c = in[1]; p.ctx = in[2]; p.c_ctx = in[3]; p.ada_w = in[4]; p.ada_b = in[5]; p.norm_g = in[6]; p.w_in = in[7];
  p.gm_ln_g = in[8]; p.gm_ln_b = in[9]; p.gm_ws = in[10]; p.gm_bs = in[11]; p.na_rpb = in[12]; p.rw_mu = in[13]; p.rw_w0 = in[14];
  p.rw_w2 = in[15]; p.rw_a0 = in[16]; p.rw_a2 = in[17]; p.rw_kk = in[18]; p.rw_ka = in[19]; p.rw_rk = in[20]; p.rw_gn_g = in[21];
  p.rw_gn_b = in[22]; p.pl_w = in[23]; p.pl_scale = in[24]; p.w_br = in[25]; p.w_out = in[26]; p.final_g = in[27];
  p.out = (float*)d_out;
  char* w = (char*)d_ws;
  size_t off = 0;
  auto take = [&](size_t bytes) { char* r = w + off; off += (bytes + 255) & ~(size_t)255; return r; };
  p.ctr = (unsigned*)take(256);
  p.cuinfo = (unsigned*)take(8192);
  p.xbar = (unsigned*)take(XB_WORDS * 4);
  p.mod = (float*)take((size_t)2 * 9 * 3072 * 4);
  p.WtIn = (bf16_t*)take((size_t)2 * INC * 1024 * 2);
  p.WtBr = (bf16_t*)take((size_t)2 * 4 * 1024 * 256 * 2);
  p.WtOut = (bf16_t*)take((size_t)2 * 1024 * 1024 * 2);
  p.h = (bf16_t*)take((size_t)NTOK * 1024 * 2);
  p.z = (bf16_t*)take((size_t)NTOK * ZW * 2);
  p.zvT = (bf16_t*)take((size_t)NB * 256 * SEQ * 2);
  p.zvTc = (bf16_t*)take((size_t)NB * 256 * CTXL * 2);
  p.br = (bf16_t*)take((size_t)NTOK * 1024 * 2);
  p.yscan = (float*)take((size_t)2 * NTOK * 256 * 4);
  p.vmix = (bf16_t*)take((size_t)NTOK * 256 * 2);
  p.coef = (float*)take((size_t)2 * NTOK * 4 * 4);
  p.ctx1 = (float*)take((size_t)NCTX * 1024 * 4);
  if (off > ws_size) fprintf(stderr, "workspace too small: need %zu have %zu\n", off, ws_size);
  hipMemsetAsync(p.xbar, 0, XB_WORDS * 4, stream);
  void* args[] = {&p};
  hipError_t e = hipLaunchCooperativeKernel((const void*)hybrid_mega, dim3(grid_blocks), dim3(NTHR), args, LDS_BYTES, stream);
  if (e != hipSuccess) fprintf(stderr, "cooperative launch failed: %s (grid %d)\n", hipGetErrorString(e), grid_blocks);
}
```

```cpp
#include <hip/hip_runtime.h>
#include <hip/hip_cooperative_groups.h>
#include <cstdio>
namespace cg = cooperative_groups;

typedef unsigned short bf16_t;
using bf16x8 = __attribute__((ext_vector_type(8))) short;
using f32x4 = __attribute__((ext_vector_type(4))) float;
using f32x2 = __attribute__((ext_vector_type(2))) float;

constexpr int D = 1024;
constexpr int NB = 8;
constexpr int SEQ = 4096;
constexpr int CTXL = 256;
constexpr int NLAT = NB * SEQ;
constexpr int NCTX = NB * CTXL;
constexpr int NTOK = NLAT + NCTX;
constexpr int INC = 7552;
constexpr int ZW = 3200;
constexpr int Z_GMU = 0, Z_GMV = 256, Z_GMG = 512, Z_NAQ = 768, Z_NAK = 1024, Z_NAG = 1280;
constexpr int Z_RWR = 1536, Z_RWK = 1792, Z_RWV = 2048, Z_RWW = 2304, Z_RWA = 2368, Z_RWG = 2432, Z_PLP = 2688, Z_PLG = 2944;
constexpr int LDS_BYTES = 73728;
constexpr int NTHR = 256;
#ifndef DUP_MASK
#define DUP_MASK 0
#endif

struct Params {
  const float *x, *c, *ctx, *c_ctx, *ada_w, *ada_b, *norm_g, *w_in, *gm_ln_g, *gm_ln_b, *gm_ws, *gm_bs, *na_rpb,
      *rw_mu, *rw_w0, *rw_w2, *rw_a0, *rw_a2, *rw_kk, *rw_ka, *rw_rk, *rw_gn_g, *rw_gn_b, *pl_w, *pl_scale, *w_br, *w_out, *final_g;
  float* out;
  bf16_t *WtIn, *WtBr, *WtOut, *h, *z, *zvT, *zvTc, *br, *vmix;
  float *mod, *yscan, *coef, *ctx1;
  unsigned* ctr;
  unsigned* xbar;
  unsigned* cuinfo;
};

__device__ __forceinline__ bf16_t f2bf(float f) {
  unsigned u = __float_as_uint(f);
  u += 0x7fffu + ((u >> 16) & 1u);
  return (bf16_t)(u >> 16);
}
__device__ __forceinline__ float bf2f(unsigned v) { return __uint_as_float(v << 16); }
__device__ __forceinline__ unsigned pack2(float a, float b) { return (unsigned)f2bf(a) | ((unsigned)f2bf(b) << 16); }
__device__ __forceinline__ float bflo(unsigned w) { return __uint_as_float(w << 16); }
__device__ __forceinline__ float bfhi(unsigned w) { return __uint_as_float(w & 0xffff0000u); }
__device__ __forceinline__ float frcp(float x) { return __builtin_amdgcn_rcpf(x); }
__device__ __forceinline__ float sigm(float x) { return frcp(1.f + __expf(-x)); }
__device__ __forceinline__ float silu_(float x) { return x * frcp(1.f + __expf(-x)); }
__device__ __forceinline__ float gelu_(float x) {
  float u = 1.5957691216f * (x + 0.044715f * x * x * x);
  return x * frcp(1.f + __expf(-u));
}
template <int CTRL>
__device__ __forceinline__ float dppf(float v) {
  return __int_as_float(__builtin_amdgcn_update_dpp(0, __float_as_int(v), CTRL, 0xf, 0xf, false));
}
__device__ __forceinline__ float red16_sum(float v) {
  v += dppf<0xB1>(v); v += dppf<0x4E>(v); v += dppf<0x141>(v); v += dppf<0x140>(v); return v;
}
__device__ __forceinline__ void red16_sum2(float& a, float& b) {
  a += dppf<0xB1>(a); asm volatile("" : "+v"(a));
  b += dppf<0xB1>(b); asm volatile("" : "+v"(b));
  a += dppf<0x4E>(a); asm volatile("" : "+v"(a));
  b += dppf<0x4E>(b); asm volatile("" : "+v"(b));
  a += dppf<0x141>(a); asm volatile("" : "+v"(a));
  b += dppf<0x141>(b); asm volatile("" : "+v"(b));
  a += dppf<0x140>(a); asm volatile("" : "+v"(a));
  b += dppf<0x140>(b); asm volatile("" : "+v"(b));
}
__device__ __forceinline__ float red16_max(float v) {
  v = fmaxf(v, dppf<0xB1>(v)); v = fmaxf(v, dppf<0x4E>(v)); v = fmaxf(v, dppf<0x141>(v)); v = fmaxf(v, dppf<0x140>(v)); return v;
}
__device__ __forceinline__ float red8_sum(float v) {
  v += dppf<0xB1>(v); v += dppf<0x4E>(v); v += dppf<0x141>(v); return v;
}
__device__ __forceinline__ float wave_sum(float v) {
#pragma unroll
  for (int o = 32; o > 0; o >>= 1) v += __shfl_xor(v, o);
  return v;
}
__device__ __forceinline__ int tid_op() {
  int t = threadIdx.x;
  asm volatile("" : "+v"(t));
  return t;
}
__device__ __forceinline__ void lds_barrier() {
  asm volatile("s_waitcnt lgkmcnt(0)" ::: "memory");
  __builtin_amdgcn_s_barrier();
  asm volatile("" ::: "memory");
}
__device__ __forceinline__ f32x4 mfma16(bf16x8 a, bf16x8 b, f32x4 c) {
  return __builtin_amdgcn_mfma_f32_16x16x32_bf16(a, b, c, 0, 0, 0);
}
__device__ __forceinline__ void unpack8(uint4 v, float* f) {
  f[0] = bflo(v.x); f[1] = bfhi(v.x); f[2] = bflo(v.y); f[3] = bfhi(v.y);
  f[4] = bflo(v.z); f[5] = bfhi(v.z); f[6] = bflo(v.w); f[7] = bfhi(v.w);
}

__device__ void transpose_tile(const float* __restrict__ src, int N, bf16_t* __restrict__ dst, int K, int k0, int n0, float* tile) {
  const int t = tid_op();
  const int r = t >> 4, c4 = (t & 15) * 4;
#pragma unroll
  for (int i = 0; i < 4; i++) {
    int k = r + 16 * i;
    float4 v = *(const float4*)(src + (size_t)(k0 + k) * N + n0 + c4);
    tile[k * 65 + c4 + 0] = v.x; tile[k * 65 + c4 + 1] = v.y; tile[k * 65 + c4 + 2] = v.z; tile[k * 65 + c4 + 3] = v.w;
  }
  __syncthreads();
  const int n = t >> 2, ks = (t & 3) * 16;
  unsigned pk[8];
#pragma unroll
  for (int i = 0; i < 8; i++) pk[i] = pack2(tile[(ks + 2 * i) * 65 + n], tile[(ks + 2 * i + 1) * 65 + n]);
  uint4* dp = (uint4*)(dst + (size_t)(n0 + n) * K + k0 + ks);
  dp[0] = make_uint4(pk[0], pk[1], pk[2], pk[3]);
  dp[1] = make_uint4(pk[4], pk[5], pk[6], pk[7]);
  __syncthreads();
}

__device__ void mod_item(const Params& p, int l, int jc, char* smem) {
  float* sil = (float*)smem;
  float* red = sil + 9 * 1024;
  const int t = tid_op();
  for (int i = t; i < 9 * 1024; i += NTHR) {
    int r = i >> 10, k = i & 1023;
    float v = r < 8 ? p.c[r * 1024 + k] : p.c_ctx[k];
    sil[i] = silu_(v);
  }
  __syncthreads();
  const int col = t & 63, q = t >> 6;
  float acc[9];
#pragma unroll
  for (int r = 0; r < 9; r++) acc[r] = 0.f;
  const float* w = p.ada_w + (size_t)l * 1024 * 3072 + jc * 64 + col;
  for (int k = q * 256; k < q * 256 + 256; k++) {
    float wv = w[(size_t)k * 3072];
#pragma unroll
    for (int r = 0; r < 9; r++) acc[r] += sil[r * 1024 + k] * wv;
  }
#pragma unroll
  for (int r = 0; r < 9; r++) red[(q * 9 + r) * 64 + col] = acc[r];
  __syncthreads();
  if (t < 64) {
    float bb = p.ada_b[l * 3072 + jc * 64 + t];
#pragma unroll
    for (int r = 0; r < 9; r++) {
      float s = red[(0 * 9 + r) * 64 + t] + red[(1 * 9 + r) * 64 + t] + red[(2 * 9 + r) * 64 + t] + red[(3 * 9 + r) * 64 + t];
      p.mod[(l * 9 + r) * 3072 + jc * 64 + t] = s + bb;
    }
  }
  __syncthreads();
}

__device__ void phase0(const Params& p, char* smem) {
  if (blockIdx.x == 0 && threadIdx.x < 8) p.ctr[threadIdx.x] = 0u;
  constexpr int PER_L = 2400 + 48;
  for (int it = blockIdx.x; it < 2 * PER_L; it += gridDim.x) {
    int l = it / PER_L, r = it % PER_L;
    if (r < 1888) {
      int kt = r & 15, nt = r >> 4;
      transpose_tile(p.w_in + (size_t)l * 1024 * INC, INC, p.WtIn + (size_t)l * INC * 1024, 1024, kt * 64, nt * 64, (float*)smem);
    } else if (r < 2144) {
      int q = r - 1888; int i = q >> 6; int kt = q & 3, nt = (q >> 2) & 15;
      transpose_tile(p.w_br + ((size_t)l * 4 + i) * 256 * 1024, 1024, p.WtBr + ((size_t)l * 4 + i) * 1024 * 256, 256, kt * 64, nt * 64, (float*)smem);
    } else if (r < 2400) {
      int q = r - 2144; int kt = q & 15, nt = q >> 4;
      transpose_tile(p.w_out + (size_t)l * 1024 * 1024, 1024, p.WtOut + (size_t)l * 1024 * 1024, 1024, kt * 64, nt * 64, (float*)smem);
    } else {
      mod_item(p, l, r - 2400, smem);
    }
  }
}

__device__ void phase_norm(const Params& p, int l, const float* xsrc, const float* csrc) {
  const int t_ = tid_op();
  const int lane = t_ & 63;
  const int gw = blockIdx.x * 4 + (t_ >> 6), nw = gridDim.x * 4;
  const float* g = p.norm_g + l * 1024;
  for (int r = gw; r < NTOK; r += nw) {
    const float* src; int mb;
    if (r < NLAT) { src = xsrc + (size_t)r * 1024; mb = r >> 12; } else { src = csrc + (size_t)(r - NLAT) * 1024; mb = 8; }
    const float* md = p.mod + (l * 9 + mb) * 3072;
    float4 v[4]; float ss = 0.f;
#pragma unroll
    for (int i = 0; i < 4; i++) {
      v[i] = *(const float4*)(src + lane * 4 + 256 * i);
      ss += v[i].x * v[i].x + v[i].y * v[i].y + v[i].z * v[i].z + v[i].w * v[i].w;
    }
    ss = wave_sum(ss);
    float rs = rsqrtf(ss * (1.f / 1024.f) + 1e-6f);
#pragma unroll
    for (int i = 0; i < 4; i++) {
      int col = lane * 4 + 256 * i;
      float4 gg = *(const float4*)(g + col);
      float4 sh = *(const float4*)(md + col);
      float4 sc = *(const float4*)(md + 1024 + col);
      float a0 = v[i].x * rs * gg.x * (1.f + sc.x) + sh.x;
      float a1 = v[i].y * rs * gg.y * (1.f + sc.y) + sh.y;
      float a2 = v[i].z * rs * gg.z * (1.f + sc.z) + sh.z;
      float a3 = v[i].w * rs * gg.w * (1.f + sc.w) + sh.w;
      *(uint2*)(p.h + (size_t)r * 1024 + col) = make_uint2(pack2(a0, a1), pack2(a2, a3));
    }
  }
}

__device__ void phase_final(const Params& p) {
  const int t_ = tid_op();
  const int lane = t_ & 63;
  const int gw = blockIdx.x * 4 + (t_ >> 6), nw = gridDim.x * 4;
  for (int r = gw; r < NLAT; r += nw) {
    float* src = p.out + (size_t)r * 1024;
    float4 v[4]; float ss = 0.f;
#pragma unroll
    for (int i = 0; i < 4; i++) {
      v[i] = *(const float4*)(src + lane * 4 + 256 * i);
      ss += v[i].x * v[i].x + v[i].y * v[i].y + v[i].z * v[i].z + v[i].w * v[i].w;
    }
    ss = wave_sum(ss);
    float rs = rsqrtf(ss * (1.f / 1024.f) + 1e-6f);
#pragma unroll
    for (int i = 0; i < 4; i++) {
      int col = lane * 4 + 256 * i;
      float4 gg = *(const float4*)(p.final_g + col);
      float4 o = make_float4(v[i].x * rs * gg.x, v[i].y * rs * gg.y, v[i].z * rs * gg.z, v[i].w * rs * gg.w);
      *(float4*)(src + col) = o;
    }
  }
}

template <int NT, bool SWAP>
__device__ __forceinline__ void gemm_compute(const bf16_t* a_s, const bf16_t* b_s, int o0, f32x4 (&acc)[4][NT]) {
#pragma unroll
  for (int ks = 0; ks < 2; ks++) {
    const int off = ks == 0 ? o0 : (o0 ^ 32);
    bf16x8 af[4], bfr[NT];
#pragma unroll
    for (int mt = 0; mt < 4; mt++) af[mt] = *(const bf16x8*)(a_s + mt * 16 * 64 + off);
#pragma unroll
    for (int nt = 0; nt < NT; nt++) bfr[nt] = *(const bf16x8*)(b_s + nt * 16 * 64 + off);
#pragma unroll
    for (int mt = 0; mt < 4; mt++)
#pragma unroll
      for (int nt = 0; nt < NT; nt++)
        acc[mt][nt] = SWAP ? mfma16(bfr[nt], af[mt], acc[mt][nt]) : mfma16(af[mt], bfr[nt], acc[mt][nt]);
  }
}

template <int NT, bool SWAP, int DEEP = 2>
__device__ __forceinline__ void gemm_mainloop(const bf16_t* __restrict__ A, int lda, const bf16_t* __restrict__ Bm, int ldb,
                                              int nk, f32x4 (&acc)[4][NT], bf16_t* sm) {
  constexpr int ASZ = 128 * 64, BSZ = NT * 32 * 64;
  bf16_t* sA = sm;
  bf16_t* sB = sm + 2 * ASZ;
  const int t = tid_op(), lane = t & 63, wave = t >> 6, wm = wave >> 1, wn = wave & 1;
  const int lr = t >> 3, lc = (t & 7) * 8;
  const int lcs = ((t & 7) ^ ((lr >> 1) & 7)) * 8;
  const int fr = lane & 15, fq = lane >> 4;
  uint4 p0a0, p0a1, p0a2, p0a3, p0b0, p0b1, p0b2, p0b3;
  uint4 p1a0, p1a1, p1a2, p1a3, p1b0, p1b1, p1b2, p1b3;
  p0b2 = p0b3 = p1b2 = p1b3 = make_uint4(0, 0, 0, 0);
  const bf16_t* Ap = A + (size_t)lr * lda + lc;
  const bf16_t* Bp = Bm + (size_t)lr * ldb + lc;
#define GLD(P, R, I, KT) *(const uint4*)(P + (size_t)(32 * I) * R + (KT) * 64)
#define GLOAD(S, KT)                                                         \
  {                                                                          \
    S##a0 = GLD(Ap, lda, 0, KT); S##a1 = GLD(Ap, lda, 1, KT);                \
    S##a2 = GLD(Ap, lda, 2, KT); S##a3 = GLD(Ap, lda, 3, KT);                \
    S##b0 = GLD(Bp, ldb, 0, KT); S##b1 = GLD(Bp, ldb, 1, KT);                \
    if constexpr (NT == 4) { S##b2 = GLD(Bp, ldb, 2, KT); S##b3 = GLD(Bp, ldb, 3, KT); } \
  }
#define SST(BASE, I) *(uint4*)(BASE + (lr + 32 * I) * 64 + lcs)
#define SWRITE(S, BUF)                                                       \
  {                                                                          \
    SST(sA + (BUF) * ASZ, 0) = S##a0; SST(sA + (BUF) * ASZ, 1) = S##a1;      \
    SST(sA + (BUF) * ASZ, 2) = S##a2; SST(sA + (BUF) * ASZ, 3) = S##a3;      \
    SST(sB + (BUF) * BSZ, 0) = S##b0; SST(sB + (BUF) * BSZ, 1) = S##b1;      \
    if constexpr (NT == 4) { SST(sB + (BUF) * BSZ, 2) = S##b2; SST(sB + (BUF) * BSZ, 3) = S##b3; } \
  }
  const bf16_t* a_s0 = sA + (wm * 64 + fr) * 64;
  const bf16_t* b_s0 = sB + (wn * (NT * 16) + fr) * 64;
  const int o0 = (fq ^ ((fr >> 1) & 7)) * 8;
  if (DEEP == 2) {
    GLOAD(p0, 0);
    GLOAD(p1, 1);
    SWRITE(p0, 0);
    __syncthreads();
#pragma unroll 1
    for (int kt = 0; kt < nk; kt += 2) {
      const bool m2 = kt + 2 < nk;
      if (m2) GLOAD(p0, kt + 2);
      gemm_compute<NT, SWAP>(a_s0, b_s0, o0, acc);
      SWRITE(p1, 1);
      __syncthreads();
      if (m2) GLOAD(p1, kt + 3);
      gemm_compute<NT, SWAP>(a_s0 + ASZ, b_s0 + BSZ, o0, acc);
      if (m2) SWRITE(p0, 0);
      __syncthreads();
    }
  } else {
    GLOAD(p0, 0);
    SWRITE(p0, 0);
    __syncthreads();
#pragma unroll 1
    for (int kt = 0; kt < nk; kt += 2) {
      const bool m2 = kt + 2 < nk;
      GLOAD(p0, kt + 1);
      gemm_compute<NT, SWAP>(a_s0, b_s0, o0, acc);
      SWRITE(p0, 1);
      __syncthreads();
      if (m2) GLOAD(p0, kt + 2);
      gemm_compute<NT, SWAP>(a_s0 + ASZ, b_s0 + BSZ, o0, acc);
      if (m2) SWRITE(p0, 0);
      __syncthreads();
    }
  }
#undef GLOAD
#undef SWRITE
#undef GLD
#undef SST
}

template <int NT>
__device__ __forceinline__ void zero_acc(f32x4 (&acc)[4][NT]) {
#pragma unroll
  for (int i = 0; i < 4; i++)
#pragma unroll
    for (int j = 0; j < NT; j++) acc[i][j] = f32x4{0.f, 0.f, 0.f, 0.f};
}

struct TileIter {
  int total, TN, per_x, base, lim, nslot, slot;
  __device__ __forceinline__ void init(int TM, int TN_, int vb = -1, int nvb = 0) {
    TN = TN_; total = TM * TN_;
    const int nx = 8;
    if (vb < 0) { vb = blockIdx.x; nvb = gridDim.x; }
    per_x = (total + nx - 1) / nx;
    const int xcd = vb % nx;
    slot = vb / nx;
    nslot = (nvb + nx - 1) / nx;
    base = xcd * per_x;
    lim = min(total, base + per_x);
  }
  __device__ __forceinline__ bool get(int iter, int& m, int& n) const {
    const int T = base + iter * nslot + slot;
    if (T >= lim) return false;
    const int grp = T / (8 * TN), r = T % (8 * TN);
    m = grp * 8 + (r & 7); n = r >> 3;
    return true;
  }
};

__device__ void phase_g1(const Params& p, int l, char* smem, int part, int vb, int nvb) {
  const int t_ = tid_op(); const int lane = t_ & 63, wave = t_ >> 6, wm = wave >> 1, wn = wave & 1, fr = lane & 15, fq = lane >> 4;
  const bf16_t* W = p.WtIn + (size_t)l * INC * 1024;
  constexpr int NTILE_N = 27, NTILE_M = NTOK / 128;
  TileIter ti; ti.init(NTILE_M, part == 0 ? NTILE_N : part == 1 ? 9 : 18, vb, nvb);
  for (int iter = 0;; iter++) {
    int mtile, ntile;
    if (!ti.get(iter, mtile, ntile)) break;
    if (part == 1) ntile += 12; else if (part == 2) ntile = ntile < 12 ? ntile : ntile + 9;
    const int m0 = mtile * 128, n0 = ntile * 128;
    f32x4 acc[4][4];
    zero_acc<4>(acc);
    if (ntile == 10 || ntile == 11) {
      gemm_mainloop<4, false>(p.h + (size_t)m0 * 1024, 1024, W + (size_t)n0 * 1024, 1024, 16, acc, (bf16_t*)smem);
#pragma unroll
      for (int mt = 0; mt < 4; mt++)
#pragma unroll
        for (int nt = 0; nt < 4; nt++) {
          int m = m0 + wm * 64 + mt * 16 + fq * 4;
          int ch = n0 + wn * 64 + nt * 16 + fr - 1280;
          bf16_t* dst;
          if (m0 < NLAT) { int b = m0 >> 12; dst = p.zvT + ((size_t)(b * 256 + ch)) * 4096 + (m - b * 4096); }
          else { int mm = m - NLAT; int b = mm >> 8; dst = p.zvTc + ((size_t)(b * 256 + ch)) * 256 + (mm & 255); }
          *(uint2*)dst = make_uint2(pack2(acc[mt][nt][0], acc[mt][nt][1]), pack2(acc[mt][nt][2], acc[mt][nt][3]));
        }
    } else {
      gemm_mainloop<4, true>(p.h + (size_t)m0 * 1024, 1024, W + (size_t)n0 * 1024, 1024, 16, acc, (bf16_t*)smem);
      const int zoff = n0 < 1280 ? 0 : -256;
#pragma unroll
      for (int mt = 0; mt < 4; mt++)
#pragma unroll
        for (int nt = 0; nt < 4; nt++) {
          int m = m0 + wm * 64 + mt * 16 + fr;
          int n = n0 + wn * 64 + nt * 16 + fq * 4 + zoff;
          *(uint2*)(p.z + (size_t)m * ZW + n) = make_uint2(pack2(acc[mt][nt][0], acc[mt][nt][1]), pack2(acc[mt][nt][2], acc[mt][nt][3]));
        }
    }
  }
}

template <int NT>
__device__ __forceinline__ void g2_tile(const Params& p, int l, char* smem, int m0, int n0) {
  const int t_ = tid_op(); const int lane = t_ & 63, wave = t_ >> 6, wm = wave >> 1, wn = wave & 1, fr = lane & 15, fq = lane >> 4;
  const bf16_t* W = p.WtIn + (size_t)l * INC * 1024;
  const bf16_t* Wb = p.WtBr + (size_t)l * 4 * 1024 * 256;
  bf16_t* y = p.z;
#pragma unroll 1
  for (int i = 0; i < 4; i++) {
    f32x4 acc[4][NT];
    unsigned ppk[4][NT][2];
    zero_acc<NT>(acc);
    gemm_mainloop<NT, true, 1>(p.br + (size_t)m0 * 1024 + i * 256, 1024, Wb + ((size_t)i * 1024 + n0) * 256, 256, 4, acc, (bf16_t*)smem);
#pragma unroll
    for (int mt = 0; mt < 4; mt++)
#pragma unroll
      for (int nt = 0; nt < NT; nt++) {
        ppk[mt][nt][0] = pack2(acc[mt][nt][0], acc[mt][nt][1]);
        ppk[mt][nt][1] = pack2(acc[mt][nt][2], acc[mt][nt][3]);
      }
    zero_acc<NT>(acc);
    gemm_mainloop<NT, true, 1>(p.h + (size_t)m0 * 1024, 1024, W + (size_t)(3456 + i * 1024 + n0) * 1024, 1024, 16, acc, (bf16_t*)smem);
#pragma unroll
    for (int mt = 0; mt < 4; mt++)
#pragma unroll
      for (int nt = 0; nt < NT; nt++) {
        const int m = m0 + wm * 64 + mt * 16 + fr;
        const int n = n0 + wn * (NT * 16) + nt * 16 + fq * 4;
        uint2* yp = (uint2*)(y + (size_t)m * 1024 + n);
        uint2 yo = make_uint2(0u, 0u);
        if (i > 0) yo = *yp;
        float y0 = bflo(yo.x) + sigm(acc[mt][nt][0]) * bflo(ppk[mt][nt][0]);
        float y1 = bfhi(yo.x) + sigm(acc[mt][nt][1]) * bfhi(ppk[mt][nt][0]);
        float y2 = bflo(yo.y) + sigm(acc[mt][nt][2]) * bflo(ppk[mt][nt][1]);
        float y3 = bfhi(yo.y) + sigm(acc[mt][nt][3]) * bfhi(ppk[mt][nt][1]);
        *yp = make_uint2(pack2(y0, y1), pack2(y2, y3));
      }
  }
}
__device__ void phase_g2(const Params& p, int l, char* smem) {
  {
    TileIter ti; ti.init(NLAT / 128, 8);
    for (int iter = 0;; iter++) {
      int mtile, ntile;
      if (!ti.get(iter, mtile, ntile)) break;
      g2_tile<4>(p, l, smem, mtile * 128, ntile * 128);
    }
  }
  if (l == 0) {
    TileIter ti; ti.init(NCTX / 128, 16);
    for (int iter = 0;; iter++) {
      int mtile, ntile;
      if (!ti.get(iter, mtile, ntile)) break;
      g2_tile<2>(p, l, smem, NLAT + mtile * 128, ntile * 64);
    }
  }
}

__device__ void phase_g3(const Params& p, int l, char* smem) {
  const int t_ = tid_op(); const int lane = t_ & 63, wave = t_ >> 6, wm = wave >> 1, wn = wave & 1, fr = lane & 15, fq = lane >> 4;
  const bf16_t* W = p.WtOut + (size_t)l * 1024 * 1024;
  const bf16_t* y = p.z;
  const int ntm = (l == 0 ? NTOK : NLAT) / 128;
  TileIter ti; ti.init(ntm, 8);
  for (int iter = 0;; iter++) {
    int mtile, ntile;
    if (!ti.get(iter, mtile, ntile)) break;
    const int m0 = mtile * 128, n0 = ntile * 128;
    f32x4 acc[4][4];
    zero_acc<4>(acc);
    gemm_mainloop<4, true>(y + (size_t)m0 * 1024, 1024, W + (size_t)n0 * 1024, 1024, 16, acc, (bf16_t*)smem);
    const float* src; float* dst; int mb;
    if (m0 < NLAT) { src = (l == 0 ? p.x : p.out) + (size_t)m0 * 1024; dst = p.out + (size_t)m0 * 1024; mb = m0 >> 12; }
    else { src = p.ctx + (size_t)(m0 - NLAT) * 1024; dst = p.ctx1 + (size_t)(m0 - NLAT) * 1024; mb = 8; }
    const float* gate = p.mod + (l * 9 + mb) * 3072 + 2048;
#pragma unroll
    for (int mt = 0; mt < 4; mt++)
#pragma unroll
      for (int nt = 0; nt < 4; nt++) {
        int mr = wm * 64 + mt * 16 + fr;
        int n = n0 + wn * 64 + nt * 16 + fq * 4;
        float4 xv = *(const float4*)(src + (size_t)mr * 1024 + n);
        float4 gv = *(const float4*)(gate + n);
        float4 o = make_float4(xv.x + gv.x * acc[mt][nt][0], xv.y + gv.y * acc[mt][nt][1], xv.z + gv.z * acc[mt][nt][2], xv.w + gv.w * acc[mt][nt][3]);
        *(float4*)(dst + (size_t)mr * 1024 + n) = o;
      }
  }
}

__device__ void scan_item(const Params& p, int l, int item, char* smem) {
  const int rq = item & 1, d = (item >> 1) & 1, h = (item >> 2) & 3, b = item >> 4;
  const int t = tid_op(), lane = t & 63, wave = t >> 6, fr = lane & 15, fq = lane >> 4;
  float* Wd = (float*)smem;
  float* Av = Wd + 2048;
  float* Bv = Av + 2048;
  float* Kd = Bv + 2048;
  float* Rr = Kd + 2048;
  float* Vv = Rr + 2048;
  float* Pf = Vv + 1024;
  float* Yb = Pf;
  float* Qf = Pf + 2048;
  float* prm = Qf + 2048;
  bf16_t* wl = (bf16_t*)(prm + 320);
  bf16_t* al = wl + 32 * 72;

  for (int i = t; i < 320; i += NTHR) {
    int which = i >> 6, k = i & 63;
    float v;
    if (which == 0) v = p.rw_w0[(l * 2 + d) * 256 + h * 64 + k];
    else if (which == 1) v = p.rw_a0[(l * 2 + d) * 256 + h * 64 + k];
    else if (which == 2) v = p.rw_ka[l * 256 + h * 64 + k];
    else if (which == 3) v = p.rw_kk[l * 256 + h * 64 + k];
    else v = p.rw_rk[(l * 4 + h) * 64 + k];
    prm[i] = v;
  }
  bf16x8 w2f[2], a2f[2];
  {
    const int n = h * 64 + 16 * wave + fr;
    const float* w2 = p.rw_w2 + (size_t)(l * 2 + d) * 64 * 256 + n;
    const float* a2 = p.rw_a2 + (size_t)(l * 2 + d) * 64 * 256 + n;
#pragma unroll
    for (int ks = 0; ks < 2; ks++)
#pragma unroll
      for (int j = 0; j < 8; j++) {
        int kk = ks * 32 + fq * 8 + j;
        w2f[ks][j] = (short)f2bf(w2[kk * 256]);
        a2f[ks][j] = (short)f2bf(a2[kk * 256]);
      }
  }
  __syncthreads();

  f32x2 su0 = {0.f, 0.f}, su1 = {0.f, 0.f}, su2 = {0.f, 0.f}, su3 = {0.f, 0.f};
  const int kseg = lane & 15, rowl = wave * 8 + (lane >> 4) * 2;
  const int tt1 = t >> 3, oct = t & 7;
  constexpr int NCH_C = CTXL / 32, NCH_L = SEQ / 32, NCH = NCH_C + NCH_L;
  uint4 rcu[5], rpv[5], rnx[5];
  auto load_raw = [&](int gc) {
    const bool isc = gc < NCH_C;
    const int T = isc ? CTXL : SEQ;
    const int nch = isc ? NCH_C : NCH_L;
    const int ci = isc ? gc : gc - NCH_C;
    const int c = d ? nch - 1 - ci : ci;
    const size_t rowbase = isc ? (size_t)NLAT + b * CTXL : (size_t)b * SEQ;
    const int tok = c * 32 + tt1;
    const bf16_t* zr = p.z + (rowbase + tok) * ZW;
    const bool hp = tok > 0, hn = tok < T - 1;
#pragma unroll
    for (int g = 0; g < 5; g++) {
      const int colbase = g == 0 ? Z_RWR + h * 64 : g == 1 ? Z_RWK + h * 64 : g == 2 ? Z_RWV + h * 64 : g == 3 ? Z_RWW : Z_RWA;
      const int col = colbase + oct * 8;
      rcu[g] = *(const uint4*)(zr + col);
      rpv[g] = make_uint4(0, 0, 0, 0);
      rnx[g] = make_uint4(0, 0, 0, 0);
      if (hp) rpv[g] = *(const uint4*)(zr - ZW + col);
      if (hn) rnx[g] = *(const uint4*)(zr + ZW + col);
    }
  };
  float mureg[5][8];
#pragma unroll
  for (int g = 0; g < 5; g++) {
    const int colbase = g == 0 ? Z_RWR + h * 64 : g == 1 ? Z_RWK + h * 64 : g == 2 ? Z_RWV + h * 64 : g == 3 ? Z_RWW : Z_RWA;
    const float* mup = p.rw_mu + l * 896 + (colbase + oct * 8 - Z_RWR);
    float4 m0 = *(const float4*)mup, m1 = *(const float4*)(mup + 4);
    mureg[g][0] = m0.x; mureg[g][1] = m0.y; mureg[g][2] = m0.z; mureg[g][3] = m0.w;
    mureg[g][4] = m1.x; mureg[g][5] = m1.y; mureg[g][6] = m1.z; mureg[g][7] = m1.w;
  }
  load_raw(0);
  __builtin_amdgcn_s_setprio(2);
#pragma unroll 1
  for (int gc = 0; gc < NCH; gc++) {
    const bool isc = gc < NCH_C;
    const int nch = isc ? NCH_C : NCH_L;
    const int ci = isc ? gc : gc - NCH_C;
    const int c = d ? nch - 1 - ci : ci;
    const size_t rowbase = isc ? (size_t)NLAT + b * CTXL : (size_t)b * SEQ;
    const int t0 = c * 32;
    {
      const int tt = tt1;
      const int tok = t0 + tt;
#pragma unroll
      for (int g = 0; g < 5; g++) {
        const int colbase = g == 0 ? Z_RWR + h * 64 : g == 1 ? Z_RWK + h * 64 : g == 2 ? Z_RWV + h * 64 : g == 3 ? Z_RWW : Z_RWA;
        const int col = colbase + oct * 8;
        float fc[8], fp[8], fn[8], mix[8];
        unpack8(rcu[g], fc); unpack8(rpv[g], fp); unpack8(rnx[g], fn);
#pragma unroll
        for (int i = 0; i < 8; i++) mix[i] = fc[i] + (0.5f * (fp[i] + fn[i]) - fc[i]) * mureg[g][i];
        if (g == 0) {
          *(float4*)(Rr + tt * 64 + oct * 8) = make_float4(mix[0], mix[1], mix[2], mix[3]);
          *(float4*)(Rr + tt * 64 + oct * 8 + 4) = make_float4(mix[4], mix[5], mix[6], mix[7]);
        } else if (g == 1) {
          *(float4*)(Kd + tt * 64 + oct * 8) = make_float4(mix[0], mix[1], mix[2], mix[3]);
          *(float4*)(Kd + tt * 64 + oct * 8 + 4) = make_float4(mix[4], mix[5], mix[6], mix[7]);
        } else if (g == 2) {
          if ((oct >> 2) == rq) {
            *(float4*)(Vv + tt * 32 + (oct & 3) * 8) = make_float4(mix[0], mix[1], mix[2], mix[3]);
            *(float4*)(Vv + tt * 32 + (oct & 3) * 8 + 4) = make_float4(mix[4], mix[5], mix[6], mix[7]);
            if (d == 0) {
              *(uint4*)(p.vmix + (rowbase + tok) * 256 + h * 64 + oct * 8) =
                  make_uint4(pack2(mix[0], mix[1]), pack2(mix[2], mix[3]), pack2(mix[4], mix[5]), pack2(mix[6], mix[7]));
            }
          }
        } else if (g == 3) {
          float th[8];
#pragma unroll
          for (int i = 0; i < 8; i++) th[i] = 1.f - 2.f * frcp(1.f + __expf(2.f * mix[i]));
          *(uint4*)(wl + tt * 72 + oct * 8) = make_uint4(pack2(th[0], th[1]), pack2(th[2], th[3]), pack2(th[4], th[5]), pack2(th[6], th[7]));
        } else {
          *(uint4*)(al + tt * 72 + oct * 8) = make_uint4(pack2(mix[0], mix[1]), pack2(mix[2], mix[3]), pack2(mix[4], mix[5]), pack2(mix[6], mix[7]));
        }
      }
    }
    if (gc + 1 < NCH) load_raw(gc + 1);
    lds_barrier();
    {
#pragma unroll
      for (int mt = 0; mt < 2; mt++) {
        f32x4 ap = {0.f, 0.f, 0.f, 0.f}, aq = {0.f, 0.f, 0.f, 0.f};
#pragma unroll
        for (int ks = 0; ks < 2; ks++) {
          bf16x8 fa = *(const bf16x8*)(wl + (mt * 16 + fr) * 72 + ks * 32 + fq * 8);
          bf16x8 fb = *(const bf16x8*)(al + (mt * 16 + fr) * 72 + ks * 32 + fq * 8);
          ap = mfma16(fa, w2f[ks], ap);
          aq = mfma16(fb, a2f[ks], aq);
        }
#pragma unroll
        for (int j = 0; j < 4; j++) {
          Pf[(mt * 16 + fq * 4 + j) * 64 + wave * 16 + fr] = ap[j];
          Qf[(mt * 16 + fq * 4 + j) * 64 + wave * 16 + fr] = aq[j];
        }
      }
    }
    lds_barrier();
    {
      const int tt = tt1;
      float ss = 0.f, cf = 0.f;
      float kkr[8], aa[8], pv[8], qv[8], kv[8], rv[8], dec[8], kdv[8];
      *(float4*)(pv) = *(const float4*)(Pf + tt * 64 + oct * 8); *(float4*)(pv + 4) = *(const float4*)(Pf + tt * 64 + oct * 8 + 4);
      *(float4*)(qv) = *(const float4*)(Qf + tt * 64 + oct * 8); *(float4*)(qv + 4) = *(const float4*)(Qf + tt * 64 + oct * 8 + 4);
      *(float4*)(kv) = *(const float4*)(Kd + tt * 64 + oct * 8); *(float4*)(kv + 4) = *(const float4*)(Kd + tt * 64 + oct * 8 + 4);
      *(float4*)(rv) = *(const float4*)(Rr + tt * 64 + oct * 8); *(float4*)(rv + 4) = *(const float4*)(Rr + tt * 64 + oct * 8 + 4);
#pragma unroll
      for (int i = 0; i < 8; i++) {
        const int k = oct * 8 + i;
        float pp = prm[k] + pv[i];
        dec[i] = __expf(-0.6065306597f * sigm(pp));
        float a = sigm(prm[64 + k] + qv[i]);
        float kr = kv[i];
        kdv[i] = kr * (1.f + (a - 1.f) * prm[128 + k]);
        kkr[i] = kr * prm[192 + k];
        ss += kkr[i] * kkr[i];
        cf += rv[i] * kdv[i] * prm[256 + k];
        aa[i] = a;
      }
      ss = red8_sum(ss);
      cf = red8_sum(cf);
      float inv = frcp(fmaxf(__builtin_amdgcn_sqrtf(ss), 1e-12f));
      float av[8], bv[8];
#pragma unroll
      for (int i = 0; i < 8; i++) { float kk = kkr[i] * inv; av[i] = -kk; bv[i] = kk * aa[i]; }
      *(float4*)(Wd + tt * 64 + oct * 8) = *(float4*)(dec); *(float4*)(Wd + tt * 64 + oct * 8 + 4) = *(float4*)(dec + 4);
      *(float4*)(Kd + tt * 64 + oct * 8) = *(float4*)(kdv); *(float4*)(Kd + tt * 64 + oct * 8 + 4) = *(float4*)(kdv + 4);
      *(float4*)(Av + tt * 64 + oct * 8) = *(float4*)(av); *(float4*)(Av + tt * 64 + oct * 8 + 4) = *(float4*)(av + 4);
      *(float4*)(Bv + tt * 64 + oct * 8) = *(float4*)(bv); *(float4*)(Bv + tt * 64 + oct * 8 + 4) = *(float4*)(bv + 4);
      if (rq == 0 && oct == 0) p.coef[((size_t)d * NTOK + rowbase + t0 + tt) * 4 + h] = cf;
    }
    lds_barrier();
    {
      const int step = d ? -1 : 1;
      int tt = d ? 31 : 0;
      float4 w = *(const float4*)(Wd + tt * 64 + kseg * 4);
      float4 a = *(const float4*)(Av + tt * 64 + kseg * 4);
      float4 bb = *(const float4*)(Bv + tt * 64 + kseg * 4);
      float4 kd = *(const float4*)(Kd + tt * 64 + kseg * 4);
      float4 r = *(const float4*)(Rr + tt * 64 + kseg * 4);
      float2 v = *(const float2*)(Vv + tt * 32 + rowl);
      float ysel0 = 0.f, ysel1 = 0.f;
#pragma unroll 16
      for (int i = 0; i < 32; i++) {
        const int tn = (i < 31) ? tt + step : tt;
        float4 w2 = *(const float4*)(Wd + tn * 64 + kseg * 4);
        float4 a2 = *(const float4*)(Av + tn * 64 + kseg * 4);
        float4 b2 = *(const float4*)(Bv + tn * 64 + kseg * 4);
        float4 k2 = *(const float4*)(Kd + tn * 64 + kseg * 4);
        float4 r2 = *(const float4*)(Rr + tn * 64 + kseg * 4);
        float2 v2 = *(const float2*)(Vv + tn * 32 + rowl);
        f32x2 sau = (su0 * a.x + su1 * a.y) + (su2 * a.z + su3 * a.w);
        float sa = sau.x, ua = sau.y;
        red16_sum2(sa, ua);
        sau = f32x2{sa, ua};
        const f32x2 vv = f32x2{v.x, v.y};
        su0 = su0 * w.x + sau * bb.x + vv * kd.x;
        su1 = su1 * w.y + sau * bb.y + vv * kd.y;
        su2 = su2 * w.z + sau * bb.z + vv * kd.z;
        su3 = su3 * w.w + sau * bb.w + vv * kd.w;
        const f32x2 yy = (su0 * r.x + su1 * r.y) + (su2 * r.z + su3 * r.w);
        float y0 = yy.x, y1 = yy.y;
        red16_sum2(y0, y1);
        ysel0 = ((i & 15) == kseg) ? y0 : ysel0;
        ysel1 = ((i & 15) == kseg) ? y1 : ysel1;
        if ((i & 15) == 15) {
          const int si = (i - 15) + kseg;
          const int ts = d ? 31 - si : si;
          *(float2*)(Yb + ts * 32 + rowl) = make_float2(ysel0, ysel1);
        }
        w = w2; a = a2; bb = b2; kd = k2; r = r2; v = v2; tt = tn;
      }
    }
    lds_barrier();
    {
      const int tt = t >> 3, q4 = t & 7;
      float4 yv = *(const float4*)(Yb + tt * 32 + q4 * 4);
      *(float4*)(p.yscan + ((size_t)d * NTOK + rowbase + t0 + tt) * 256 + h * 64 + rq * 32 + q4 * 4) = yv;
    }
  }
  __builtin_amdgcn_s_setprio(0);
  __syncthreads();
}

template <int nband>
__device__ void natten_item(const Params& p, int l, int b, int h, size_t qrow0, int r, char* smem) {
  const int t = tid_op(), lane = t & 63, wave = t >> 6, fr = lane & 15, fq = lane >> 4;
  float* rpb = (float*)smem;
  bf16_t* Ps = (bf16_t*)(smem + 2048) + wave * 16 * 72;
  for (int i = t; i < 465; i += NTHR) rpb[i] = p.na_rpb[(l * 4 + h) * 465 + i];
  __syncthreads();
  const int qloc = wave * 16;
  bf16x8 qf[2];
#pragma unroll
  for (int ks = 0; ks < 2; ks++) qf[ks] = *(const bf16x8*)(p.z + (qrow0 + qloc + fr) * ZW + Z_NAQ + h * 64 + ks * 32 + fq * 8);
  float mrow[4], lrow[4];
  f32x4 o[4];
#pragma unroll
  for (int j = 0; j < 4; j++) { mrow[j] = -1e30f; lrow[j] = 0.f; o[j] = f32x4{0.f, 0.f, 0.f, 0.f}; }
  const int rstart = min(max(r - 4, 0), 56);
  const int c0w = wave == 0 ? 0 : wave == 1 ? 8 : wave == 2 ? 24 : 32;
#define LDF(PTR) (*(const bf16x8*)(PTR))
  const bf16_t* kcp = p.z + ((size_t)NLAT + b * CTXL + fr) * ZW + Z_NAK + h * 64 + fq * 8;
  const bf16_t* vcp = p.zvTc + ((size_t)(b * 256 + h * 64 + fr)) * 256 + fq * 8;
  bf16x8 kc0 = LDF(kcp), kc1 = LDF(kcp + 32), kc2 = LDF(kcp + 16 * ZW), kc3 = LDF(kcp + 16 * ZW + 32);
  bf16x8 kc4 = LDF(kcp + 32 * ZW), kc5 = LDF(kcp + 32 * ZW + 32), kc6 = LDF(kcp + 48 * ZW), kc7 = LDF(kcp + 48 * ZW + 32);
  if (nband > 0) {
    const bf16_t* kp = p.z + ((size_t)b * SEQ + rstart * 64 + c0w + fr) * ZW + Z_NAK + h * 64 + fq * 8;
    const bf16_t* vp = p.zvT + ((size_t)(b * 256 + h * 64 + fr)) * 4096 + rstart * 64 + c0w + fq * 8;
    bf16x8 kb0 = LDF(kp), kb1 = LDF(kp + 32), kb2 = LDF(kp + 16 * ZW), kb3 = LDF(kp + 16 * ZW + 32);
    bf16x8 vb0 = LDF(vp), vb1 = LDF(vp + 16 * 4096), vb2 = LDF(vp + 32 * 4096), vb3 = LDF(vp + 48 * 4096);
#pragma unroll 1
    for (int kt = 0; kt < nband; kt++) {
      const int rr = rstart + kt;
      kp += 64 * ZW; vp += 64;
      bf16x8 kn0 = kb0, kn1 = kb1, kn2 = kb2, kn3 = kb3, vn0 = vb0, vn1 = vb1, vn2 = vb2, vn3 = vb3;
      if (kt + 1 < nband) {
        kn0 = LDF(kp); kn1 = LDF(kp + 32); kn2 = LDF(kp + 16 * ZW); kn3 = LDF(kp + 16 * ZW + 32);
        vn0 = LDF(vp); vn1 = LDF(vp + 16 * 4096); vn2 = LDF(vp + 32 * 4096); vn3 = LDF(vp + 48 * 4096);
      }
      f32x4 s[2];
      s[0] = mfma16(qf[0], kb0, f32x4{0.f, 0.f, 0.f, 0.f}); s[0] = mfma16(qf[1], kb1, s[0]);
      s[1] = mfma16(qf[0], kb2, f32x4{0.f, 0.f, 0.f, 0.f}); s[1] = mfma16(qf[1], kb3, s[1]);
      float pj[2][4];
#pragma unroll
      for (int j = 0; j < 4; j++) {
        const int q = qloc + fq * 4 + j;
        float mx = -1e30f;
#pragma unroll
        for (int nt = 0; nt < 2; nt++) {
          const int kc = c0w + nt * 16 + fr;
          const int cs = min(max(q - 8, 0), 48);
          const bool ok = (kc >= cs) && (kc < cs + 16);
          const int dc = min(max(kc - q, -15), 15);
          float bias = rpb[(rr - r + 7) * 31 + dc + 15];
          float val = ok ? s[nt][j] * 0.125f + bias : -1e30f;
          pj[nt][j] = val;
          mx = fmaxf(mx, val);
        }
        mx = red16_max(mx);
        const float mnew = fmaxf(mrow[j], mx);
        const float alpha = __expf(mrow[j] - mnew);
        float sum = 0.f;
#pragma unroll
        for (int nt = 0; nt < 2; nt++) { float e = __expf(pj[nt][j] - mnew); pj[nt][j] = e; sum += e; }
        sum = red16_sum(sum);
        lrow[j] = lrow[j] * alpha + sum;
        mrow[j] = mnew;
#pragma unroll
        for (int nt = 0; nt < 4; nt++) o[nt][j] *= alpha;
      }
#pragma unroll
      for (int nt = 0; nt < 2; nt++)
#pragma unroll
        for (int j = 0; j < 4; j++) Ps[(fq * 4 + j) * 72 + nt * 16 + fr] = f2bf(pj[nt][j]);
      __builtin_amdgcn_fence(__ATOMIC_RELEASE, "wavefront");
      __builtin_amdgcn_wave_barrier();
      __builtin_amdgcn_fence(__ATOMIC_ACQUIRE, "wavefront");
      bf16x8 pf = *(const bf16x8*)(Ps + fr * 72 + fq * 8);
      o[0] = mfma16(pf, vb0, o[0]); o[1] = mfma16(pf, vb1, o[1]); o[2] = mfma16(pf, vb2, o[2]); o[3] = mfma16(pf, vb3, o[3]);
      __builtin_amdgcn_fence(__ATOMIC_RELEASE, "wavefront");
      __builtin_amdgcn_wave_barrier();
      kb0 = kn0; kb1 = kn1; kb2 = kn2; kb3 = kn3; vb0 = vn0; vb1 = vn1; vb2 = vn2; vb3 = vn3;
    }
  }
#pragma unroll 1
  for (int cc = 0; cc < 4; cc++) {
    bf16x8 vfc[4][2];
#pragma unroll
    for (int nt = 0; nt < 4; nt++)
#pragma unroll
      for (int ks = 0; ks < 2; ks++) vfc[nt][ks] = *(const bf16x8*)(vcp + (size_t)(nt * 16) * 256 + ks * 32);
    vcp += 64;
    kcp += 64 * ZW;
    bf16x8 kn0 = kc0, kn1 = kc1, kn2 = kc2, kn3 = kc3, kn4 = kc4, kn5 = kc5, kn6 = kc6, kn7 = kc7;
    if (cc + 1 < 4) {
      kn0 = LDF(kcp); kn1 = LDF(kcp + 32); kn2 = LDF(kcp + 16 * ZW); kn3 = LDF(kcp + 16 * ZW + 32);
      kn4 = LDF(kcp + 32 * ZW); kn5 = LDF(kcp + 32 * ZW + 32); kn6 = LDF(kcp + 48 * ZW); kn7 = LDF(kcp + 48 * ZW + 32);
    }
    f32x4 s[4];
    s[0] = mfma16(qf[0], kc0, f32x4{0.f, 0.f, 0.f, 0.f}); s[0] = mfma16(qf[1], kc1, s[0]);
    s[1] = mfma16(qf[0], kc2, f32x4{0.f, 0.f, 0.f, 0.f}); s[1] = mfma16(qf[1], kc3, s[1]);
    s[2] = mfma16(qf[0], kc4, f32x4{0.f, 0.f, 0.f, 0.f}); s[2] = mfma16(qf[1], kc5, s[2]);
    s[3] = mfma16(qf[0], kc6, f32x4{0.f, 0.f, 0.f, 0.f}); s[3] = mfma16(qf[1], kc7, s[3]);
    float pj[4][4];
#pragma unroll
    for (int j = 0; j < 4; j++) {
      float mx = -1e30f;
#pragma unroll
      for (int nt = 0; nt < 4; nt++) { float val = s[nt][j] * 0.125f; pj[nt][j] = val; mx = fmaxf(mx, val); }
      mx = red16_max(mx);
      const float mnew = fmaxf(mrow[j], mx);
      const float alpha = __expf(mrow[j] - mnew);
      float sum = 0.f;
#pragma unroll
      for (int nt = 0; nt < 4; nt++) { float e = __expf(pj[nt][j] - mnew); pj[nt][j] = e; sum += e; }
      sum = red16_sum(sum);
      lrow[j] = lrow[j] * alpha + sum;
      mrow[j] = mnew;
#pragma unroll
      for (int nt = 0; nt < 4; nt++) o[nt][j] *= alpha;
    }
#pragma unroll
    for (int nt = 0; nt < 4; nt++)
#pragma unroll
      for (int j = 0; j < 4; j++) Ps[(fq * 4 + j) * 72 + nt * 16 + fr] = f2bf(pj[nt][j]);
    __builtin_amdgcn_fence(__ATOMIC_RELEASE, "wavefront");
    __builtin_amdgcn_wave_barrier();
    __builtin_amdgcn_fence(__ATOMIC_ACQUIRE, "wavefront");
    bf16x8 pf[2];
#pragma unroll
    for (int ks = 0; ks < 2; ks++) pf[ks] = *(const bf16x8*)(Ps + fr * 72 + ks * 32 + fq * 8);
#pragma unroll
    for (int nt = 0; nt < 4; nt++)
#pragma unroll
      for (int ks = 0; ks < 2; ks++) o[nt] = mfma16(pf[ks], vfc[nt][ks], o[nt]);
    __builtin_amdgcn_fence(__ATOMIC_RELEASE, "wavefront");
    __builtin_amdgcn_wave_barrier();
    kc0 = kn0; kc1 = kn1; kc2 = kn2; kc3 = kn3; kc4 = kn4; kc5 = kn5; kc6 = kn6; kc7 = kn7;
  }
#undef LDF
#pragma unroll
  for (int j = 0; j < 4; j++) {
    const size_t row = qrow0 + qloc + fq * 4 + j;
    const float inv = frcp(lrow[j]);
#pragma unroll
    for (int nt = 0; nt < 4; nt++) {
      const int dcol = nt * 16 + fr;
      float g = silu_(bf2f(p.z[row * ZW + Z_NAG + h * 64 + dcol]));
      p.br[row * 1024 + 256 + h * 64 + dcol] = f2bf(o[nt][j] * inv * g);
    }
  }
  __syncthreads();
}

__device__ void gmlp_item(const Params& p, int l, size_t row0, int g, char* smem) {
  const int t = tid_op(), lane = t & 63, wave = t >> 6, fr = lane & 15, fq = lane >> 4;
  bf16_t* Ws = (bf16_t*)smem;
  bf16_t* VhT = Ws + 128 * 136;
  const float* ws = p.gm_ws + (size_t)(l * 4 + g) * 128 * 128;
#pragma unroll
  for (int i = 0; i < 16; i++) {
    int e = (i * NTHR + t) * 4;
    int pr = e >> 7, q = e & 127;
    float4 v = *(const float4*)(ws + e);
    *(uint2*)(Ws + pr * 136 + q) = make_uint2(pack2(v.x, v.y), pack2(v.z, v.w));
  }
  {
    const int q = t >> 1, half = t & 1;
    const bf16_t* zr = p.z + (row0 + q) * ZW + Z_GMV + g * 64 + half * 32;
    float v[32];
#pragma unroll
    for (int i = 0; i < 4; i++) { uint4 u = *(const uint4*)(zr + i * 8); unpack8(u, v + i * 8); }
    float sum = 0.f;
#pragma unroll
    for (int i = 0; i < 32; i++) { v[i] = gelu_(v[i]); sum += v[i]; }
    sum += dppf<0xB1>(sum);
    const float mu = sum * (1.f / 64.f);
    float vs = 0.f;
#pragma unroll
    for (int i = 0; i < 32; i++) { float dd = v[i] - mu; vs += dd * dd; }
    vs += dppf<0xB1>(vs);
    const float rs = rsqrtf(vs * (1.f / 64.f) + 1e-6f);
    const float* lg = p.gm_ln_g + (l * 4 + g) * 64 + half * 32;
    const float* lb = p.gm_ln_b + (l * 4 + g) * 64 + half * 32;
#pragma unroll
    for (int i = 0; i < 32; i++) VhT[(half * 32 + i) * 136 + q] = f2bf((v[i] - mu) * rs * lg[i] + lb[i]);
  }
  __syncthreads();
  f32x4 acc[2][4];
#pragma unroll
  for (int mt = 0; mt < 2; mt++)
#pragma unroll
    for (int nt = 0; nt < 4; nt++) acc[mt][nt] = f32x4{0.f, 0.f, 0.f, 0.f};
#pragma unroll
  for (int ks = 0; ks < 4; ks++) {
    bf16x8 af[2], bfr[4];
#pragma unroll
    for (int mt = 0; mt < 2; mt++) af[mt] = *(const bf16x8*)(Ws + (wave * 32 + mt * 16 + fr) * 136 + ks * 32 + fq * 8);
#pragma unroll
    for (int nt = 0; nt < 4; nt++) bfr[nt] = *(const bf16x8*)(VhT + (nt * 16 + fr) * 136 + ks * 32 + fq * 8);
#pragma unroll
    for (int mt = 0; mt < 2; mt++)
#pragma unroll
      for (int nt = 0; nt < 4; nt++) acc[mt][nt] = mfma16(bfr[nt], af[mt], acc[mt][nt]);
  }
#pragma unroll
  for (int mt = 0; mt < 2; mt++) {
    const int pr = wave * 32 + mt * 16 + fr;
    const float bs = p.gm_bs[(l * 4 + g) * 128 + pr];
    const bf16_t* zr = p.z + (row0 + pr) * ZW;
#pragma unroll
    for (int nt = 0; nt < 4; nt++) {
      const int c = nt * 16 + fq * 4;
      uint2 uu = *(const uint2*)(zr + Z_GMU + g * 64 + c);
      uint2 gg = *(const uint2*)(zr + Z_GMG + g * 64 + c);
      float o0 = gelu_(bflo(uu.x)) * (acc[mt][nt][0] + bs) * silu_(bflo(gg.x));
      float o1 = gelu_(bfhi(uu.x)) * (acc[mt][nt][1] + bs) * silu_(bfhi(gg.x));
      float o2 = gelu_(bflo(uu.y)) * (acc[mt][nt][2] + bs) * silu_(bflo(gg.y));
      float o3 = gelu_(bfhi(uu.y)) * (acc[mt][nt][3] + bs) * silu_(bfhi(gg.y));
      *(uint2*)(p.br + (row0 + pr) * 1024 + g * 64 + c) = make_uint2(pack2(o0, o1), pack2(o2, o3));
    }
  }
  __syncthreads();
}

__device__ void pool_item(const Params& p, int l, size_t seqrow0, int T, int t0, int g, char* smem) {
  const int t = tid_op(), lane = t & 63, wave = t >> 6, fr = lane & 15, fq = lane >> 4;
  float* Pp = (float*)smem;
  bf16_t* Dd = (bf16_t*)(Pp + 80 * 64);
  bf16_t* WT = Dd + 64 * 72;
  const int hw = 1 << g;
  for (int i = t; i < 80 * 8; i += NTHR) {
    int rr = i >> 3, oc = i & 7;
    int tok = t0 - 8 + rr;
    float f[8];
    if (tok >= 0 && tok < T) { uint4 u = *(const uint4*)(p.z + (seqrow0 + tok) * ZW + Z_PLP + g * 64 + oc * 8); unpack8(u, f); }
    else {
#pragma unroll
      for (int k = 0; k < 8; k++) f[k] = 0.f;
    }
#pragma unroll
    for (int k = 0; k < 8; k++) Pp[rr * 64 + oc * 8 + k] = f[k];
  }
  {
    const float* w = p.pl_w + (size_t)(l * 4 + g) * 64 * 64;
#pragma unroll
    for (int i = 0; i < 16; i++) {
      int e = i * NTHR + t;
      int c = e >> 6, dd = e & 63;
      WT[dd * 72 + c] = f2bf(w[e]);
    }
  }
  __syncthreads();
  {
    const int c = t & 63, tq = t >> 6;
    for (int i = 0; i < 16; i++) {
      const int tl = tq * 16 + i;
      const int tok = t0 + tl;
      const int lo = max(tok - hw, 0), hi = min(tok + hw, T);
      float s = 0.f;
      for (int u = lo; u < hi; u++) s += Pp[(u - t0 + 8) * 64 + c];
      float dv = s / (float)(hi - lo) - Pp[(tl + 8) * 64 + c];
      Dd[tl * 72 + c] = f2bf(dv);
    }
  }
  __syncthreads();
  f32x4 acc[4];
#pragma unroll
  for (int nt = 0; nt < 4; nt++) acc[nt] = f32x4{0.f, 0.f, 0.f, 0.f};
#pragma unroll
  for (int ks = 0; ks < 2; ks++) {
    bf16x8 af = *(const bf16x8*)(Dd + (wave * 16 + fr) * 72 + ks * 32 + fq * 8);
#pragma unroll
    for (int nt = 0; nt < 4; nt++) {
      bf16x8 bw = *(const bf16x8*)(WT + (nt * 16 + fr) * 72 + ks * 32 + fq * 8);
      acc[nt] = mfma16(bw, af, acc[nt]);
    }
  }
  {
    const size_t row = seqrow0 + t0 + wave * 16 + fr;
#pragma unroll
    for (int nt = 0; nt < 4; nt++) {
      const int dd = g * 64 + nt * 16 + fq * 4;
      float4 sc = *(const float4*)(p.pl_scale + l * 256 + dd);
      uint2 gg = *(const uint2*)(p.z + row * ZW + Z_PLG + dd);
      float o0 = acc[nt][0] * sc.x * silu_(bflo(gg.x));
      float o1 = acc[nt][1] * sc.y * silu_(bfhi(gg.x));
      float o2 = acc[nt][2] * sc.z * silu_(bflo(gg.y));
      float o3 = acc[nt][3] * sc.w * silu_(bfhi(gg.y));
      *(uint2*)(p.br + row * 1024 + 768 + dd) = make_uint2(pack2(o0, o1), pack2(o2, o3));
    }
  }
  __syncthreads();
}


constexpr unsigned ROLE_IDLE = 0xFFFF0001u, ROLE_WORK = 0x10000u;
__device__ void publish_cu(const Params& p) {
  if (threadIdx.x == 0 && gridDim.x == 512) {
    unsigned hw = __builtin_amdgcn_s_getreg(63492);
    unsigned xcc = __builtin_amdgcn_s_getreg(63508);
    p.cuinfo[blockIdx.x] = ((xcc & 0xfu) << 16) | (hw & 0xff00u);
  }
}
__device__ void compute_roles(const Params& p, char* smem) {
  const int t = tid_op();
  if (gridDim.x != 512) { if (t == 0) p.cuinfo[1024] = 1u; return; }
  unsigned* keys = (unsigned*)smem;
  unsigned* mate = keys + 512;
  unsigned* prim = mate + 512;
  for (int i = t; i < 512; i += NTHR) keys[i] = p.cuinfo[i];
  __syncthreads();
  int bad = 0;
  for (int i = t; i < 512; i += NTHR) {
    int cnt = 0, m = 0;
    for (int j = 0; j < 512; j++) if (j != i && keys[j] == keys[i]) { cnt++; m = j; }
    if (cnt != 1) bad = 1;
    mate[i] = (unsigned)m;
    prim[i] = (cnt == 1 && i < m) ? 1u : 0u;
  }
  bad = __syncthreads_or(bad);
  for (int i = t; i < 512; i += NTHR) {
    const int pi = prim[i] ? i : (int)mate[i];
    int rank = 0;
    for (int j = 0; j < pi; j++) rank += (int)prim[j];
    unsigned role;
    if (rank < 128) role = prim[i] ? (unsigned)rank : ROLE_IDLE;
    else role = ROLE_WORK + (unsigned)((rank - 128) * 2 + (prim[i] ? 0 : 1));
    p.cuinfo[512 + i] = role;
  }
  if (t == 0) p.cuinfo[1024] = bad ? 1u : 0u;
  __syncthreads();
}

__device__ void worker_barrier(unsigned* cnt, unsigned target) {
  asm volatile("s_waitcnt vmcnt(0)" ::: "memory");
  __syncthreads();
  if (threadIdx.x == 0) {
    __builtin_amdgcn_fence(__ATOMIC_RELEASE, "agent");
    atomicAdd(cnt, 1u);
    while (__hip_atomic_load(cnt, __ATOMIC_RELAXED, __HIP_MEMORY_SCOPE_AGENT) < target) __builtin_amdgcn_s_sleep(2);
    __builtin_amdgcn_fence(__ATOMIC_ACQUIRE, "agent");
    asm volatile("s_waitcnt vmcnt(0)" ::: "memory");
  }
  __syncthreads();
}
__device__ void phase_mix(const Params& p, int l, char* smem, int cslot) {
  __shared__ unsigned s_item;
  if (!(cslot & 4)) for (int it = blockIdx.x; it < 128; it += gridDim.x) scan_item(p, l, it, smem);
  cslot &= 3;
  const int n_na = 2048, n_ca = (l == 0 ? 128 : 0), n_gm = 1024, n_gc = (l == 0 ? 64 : 0), n_pl = 2048, n_pc = (l == 0 ? 128 : 0);
  const int total = n_na + n_ca + n_gm + n_gc + n_pl + n_pc;
  while (true) {
    if (threadIdx.x == 0) s_item = atomicAdd(p.ctr + cslot, 1u);
    __syncthreads();
    int it = (int)s_item;
    __syncthreads();
    if (it >= total) break;
    if (it < n_na) {
      int r = it & 63, h = (it >> 6) & 3, b = it >> 8;
      natten_item<8>(p, l, b, h, (size_t)b * SEQ + r * 64, r, smem);
      continue;
    }
    it -= n_na;
    if (it < n_ca) {
      int qt = it & 3, h = (it >> 2) & 3, b = it >> 4;
      natten_item<0>(p, l, b, h, (size_t)NLAT + b * CTXL + qt * 64, 0, smem);
      continue;
    }
    it -= n_ca;
    if (it < n_gm) {
      int g = it & 3, ch = (it >> 2) & 31, b = it >> 7;
      gmlp_item(p, l, (size_t)b * SEQ + ch * 128, g, smem);
      continue;
    }
    it -= n_gm;
    if (it < n_gc) {
      int g = it & 3, ch = (it >> 2) & 1, b = it >> 3;
      gmlp_item(p, l, (size_t)NLAT + b * CTXL + ch * 128, g, smem);
      continue;
    }
    it -= n_gc;
    if (it < n_pl) {
      int g = it & 3, tl = (it >> 2) & 63, b = it >> 8;
      pool_item(p, l, (size_t)b * SEQ, SEQ, tl * 64, g, smem);
      continue;
    }
    it -= n_pl;
    {
      int g = it & 3, tl = (it >> 2) & 3, b = it >> 4;
      pool_item(p, l, (size_t)NLAT + b * CTXL, CTXL, tl * 64, g, smem);
    }
  }
}

__device__ void phase_rwfin(const Params& p, int l) {
  const int t_ = tid_op();
  const int lane = t_ & 63;
  const int gw = blockIdx.x * 4 + (t_ >> 6), nw = gridDim.x * 4;
  const int nrow = (l == 0 ? NTOK : NLAT);
  const int hh = lane >> 4, c0 = lane * 4;
  float4 gg = *(const float4*)(p.rw_gn_g + l * 256 + c0);
  float4 gb = *(const float4*)(p.rw_gn_b + l * 256 + c0);
  for (int r = gw; r < nrow; r += nw) {
    float4 y0 = *(const float4*)(p.yscan + (size_t)r * 256 + c0);
    float4 y1 = *(const float4*)(p.yscan + ((size_t)NTOK + r) * 256 + c0);
    float o0 = y0.x + y1.x, o1 = y0.y + y1.y, o2 = y0.z + y1.z, o3 = y0.w + y1.w;
    float mu = red16_sum(o0 + o1 + o2 + o3) * (1.f / 64.f);
    float d0 = o0 - mu, d1 = o1 - mu, d2 = o2 - mu, d3 = o3 - mu;
    float var = red16_sum(d0 * d0 + d1 * d1 + d2 * d2 + d3 * d3) * (1.f / 64.f);
    float rs = rsqrtf(var + 64e-5f);
    float cf = p.coef[(size_t)r * 4 + hh] + p.coef[((size_t)NTOK + r) * 4 + hh];
    uint2 vm = *(const uint2*)(p.vmix + (size_t)r * 256 + c0);
    uint2 zg = *(const uint2*)(p.z + (size_t)r * ZW + Z_RWG + c0);
    float r0 = (d0 * rs * gg.x + gb.x + cf * bflo(vm.x)) * silu_(bflo(zg.x));
    float r1 = (d1 * rs * gg.y + gb.y + cf * bfhi(vm.x)) * silu_(bfhi(zg.x));
    float r2 = (d2 * rs * gg.z + gb.z + cf * bflo(vm.y)) * silu_(bflo(zg.y));
    float r3 = (d3 * rs * gg.w + gb.w + cf * bfhi(vm.y)) * silu_(bfhi(zg.y));
    *(uint2*)(p.br + (size_t)r * 1024 + 512 + c0) = make_uint2(pack2(r0, r1), pack2(r2, r3));
  }
}

__device__ __forceinline__ void gsync(cg::grid_group& grid) {
  asm volatile("s_waitcnt vmcnt(0)" ::: "memory");
  grid.sync();
}

#define XB_XCNT(j) (64 * (j))
#define XB_XSUB(j) (1024 + 64 * (j))
#define XB_XGEN(j) (2048 + 64 * (j))
#define XB_TOP 3072
#define XB_TOPGEN 3136
constexpr int XB_WORDS = 3200;
__device__ __forceinline__ unsigned xb_ld(unsigned* q) { return __hip_atomic_load(q, __ATOMIC_RELAXED, __HIP_MEMORY_SCOPE_AGENT); }
__device__ __forceinline__ unsigned xb_add(unsigned* q, unsigned v) { return __hip_atomic_fetch_add(q, v, __ATOMIC_RELAXED, __HIP_MEMORY_SCOPE_AGENT); }
#define XB_SPIN(cond) do { unsigned _sp = 0; while (cond) { __builtin_amdgcn_s_sleep(1); if (++_sp > (1u << 24)) break; } } while (0)
__device__ __forceinline__ void xsync(unsigned* bar, volatile unsigned* st) {
  asm volatile("s_waitcnt vmcnt(0)" ::: "memory");
  __syncthreads();
  if (threadIdx.x == 0) {
    __builtin_amdgcn_s_waitcnt(0);
    const unsigned nloc = st[0], nx = st[1], x = st[2];
    const unsigned old = xb_add(&bar[XB_XSUB(x)], 1u);
    const unsigned gen = old / nloc;
    if (old + 1u == (gen + 1u) * nloc) {
      __builtin_amdgcn_fence(__ATOMIC_RELEASE, "agent");
      asm volatile("s_waitcnt vmcnt(0)" ::: "memory");
      const unsigned og = xb_add(&bar[XB_TOP], 1u);
      const unsigned tg = og / nx;
      if (og + 1u == (tg + 1u) * nx) xb_add(&bar[XB_TOPGEN], 1u);
      else XB_SPIN(xb_ld(&bar[XB_TOPGEN]) == tg);
      __builtin_amdgcn_fence(__ATOMIC_ACQUIRE, "agent");
      xb_add(&bar[XB_XGEN(x)], 1u);
      asm volatile("s_waitcnt vmcnt(0)" ::: "memory");
    } else {
      XB_SPIN(xb_ld(&bar[XB_XGEN(x)]) == gen);
      __builtin_amdgcn_fence(__ATOMIC_ACQUIRE, "agent");
      asm volatile("s_waitcnt vmcnt(0)" ::: "memory");
    }
  }
  __syncthreads();
}
__global__ void __launch_bounds__(NTHR, 2) hybrid_mega(Params p) {
  extern __shared__ __attribute__((aligned(16))) char smem[];
  cg::grid_group grid = cg::this_grid();
  __shared__ unsigned xb_st[4];
  const unsigned my_xcc = (unsigned)__builtin_amdgcn_s_getreg((3 << 11) | 20) & 0xFu;
  if (threadIdx.x == 0) (void)xb_add(&p.xbar[XB_XCNT(my_xcc)], 1u);
  publish_cu(p);
  phase0(p, smem);
  if (p.xbar == nullptr) gsync(grid);
  if (threadIdx.x == 0) {
    unsigned mine = 0, cnt = 0, sum = 0, sp = 0;
    for (;;) {
      mine = 0; cnt = 0; sum = 0;
      for (unsigned j = 0; j < 16; j++) { const unsigned c = xb_ld(&p.xbar[XB_XCNT(j)]); sum += c; cnt += c > 0u ? 1u : 0u; mine = j == my_xcc ? c : mine; }
      if (sum == gridDim.x || ++sp > (1u << 22)) break;
      __builtin_amdgcn_s_sleep(1);
    }
    xb_st[0] = mine > 0u ? mine : 1u; xb_st[1] = cnt > 0u ? cnt : 1u; xb_st[2] = my_xcc;
  }
  __syncthreads();
  xsync(p.xbar, xb_st);
  if (blockIdx.x == 0) compute_roles(p, smem);
#pragma unroll 1
  for (int l = 0; l < 2; l++) {
    phase_norm(p, l, l == 0 ? p.x : p.out, l == 0 ? p.ctx : p.ctx1);
    xsync(p.xbar, xb_st);
    const bool overlap = (gridDim.x == 512) && (p.cuinfo[1024] == 0u);
    phase_g1(p, l, smem, overlap ? 1 : 0, -1, 0);
    xsync(p.xbar, xb_st);
    {
      if (overlap) {
        const unsigned role = p.cuinfo[512 + blockIdx.x];
        if (role < 128u) scan_item(p, l, (int)role, smem);
        else if (role >= ROLE_WORK && role < ROLE_WORK + 256u) {
          phase_g1(p, l, smem, 2, (int)(role - ROLE_WORK), 256);
          worker_barrier(p.ctr + 4 + l, 256u);
          phase_mix(p, l, smem, l | 4);
        }
      } else {
        for (int it = blockIdx.x; it < 128; it += gridDim.x) scan_item(p, l, it, smem);
      }
      xsync(p.xbar, xb_st);
      if (!overlap) phase_mix(p, l, smem, l | 4);
      phase_rwfin(p, l);
      xsync(p.xbar, xb_st);
    }
    phase_g2(p, l, smem);
    xsync(p.xbar, xb_st);
    if (DUP_MASK & 2) { phase_g2(p, l, smem); xsync(p.xbar, xb_st); }
    phase_g3(p, l, smem);
    xsync(p.xbar, xb_st);
    if ((DUP_MASK & 8) && l == 0) { phase_g3(p, l, smem); xsync(p.xbar, xb_st); }
  }
  phase_final(p);
}

extern "C" void kernel_launch(void* const* d_in, const int* in_sizes, int n_in, void* d_out, int out_size, void* d_ws,
                              size_t ws_size, hipStream_t stream) {
  static int grid_blocks = 0;
  if (!grid_blocks) {
    int dev = 0, cus = 0, per_cu = 0;
    hipGetDevice(&dev);
    hipDeviceGetAttribute(&cus, hipDeviceAttributeMultiprocessorCount, dev);
    hipFuncSetAttribute((const void*)hybrid_mega, hipFuncAttributeMaxDynamicSharedMemorySize, LDS_BYTES);
    hipOccupancyMaxActiveBlocksPerMultiprocessor(&per_cu, hybrid_mega, NTHR, LDS_BYTES);
    if (per_cu > 2) per_cu = 2;
    if (per_cu < 1) per_cu = 1;
    grid_blocks = cus * per_cu;
  }
  Params p{};
  const float* const* in = (const float* const*)d_in;
  p.x = in[0]; p.c = in[1]; p.ctx = in[2]; p.c_ctx = in[3]; p.ada_w = in[4]; p.ada_b = in[5]; p.norm_g = in[6]; p.w_in = in[7];
  p.gm_ln_g = in[8]; p.gm_ln_b = in[9]; p.gm_ws = in[10]; p.gm_bs = in[11]; p.na_rpb = in[12]; p.rw_mu = in[13]; p.rw_w0 = in[14];
  p.rw_w2 = in[15]; p.rw_a0 = in[16]; p.rw_a2 = in[17]; p.rw_kk = in[18]; p.rw_ka = in[19]; p.rw_rk = in[20]; p.rw_gn_g = in[21];
  p.rw_gn_b = in[22]; p.pl_w = in[23]; p.pl_scale = in[24]; p.w_br = in[25]; p.w_out = in[26]; p.final_g = in[27];
  p.out = (float*)d_out;
  char* w = (char*)d_ws;
  size_t off = 0;
  auto take = [&](size_t bytes) { char* r = w + off; off += (bytes + 255) & ~(size_t)255; return r; };
  p.ctr = (unsigned*)take(256);
  p.cuinfo = (unsigned*)take(8192);
  p.xbar = (unsigned*)take(XB_WORDS * 4);
  p.mod = (float*)take((size_t)2 * 9 * 3072 * 4);
  p.WtIn = (bf16_t*)take((size_t)2 * INC * 1024 * 2);
  p.WtBr = (bf16_t*)take((size_t)2 * 4 * 1024 * 256 * 2);
  p.WtOut = (bf16_t*)take((size_t)2 * 1024 * 1024 * 2);
  p.h = (bf16_t*)take((size_t)NTOK * 1024 * 2);
  p.z = (bf16_t*)take((size_t)NTOK * ZW * 2);
  p.zvT = (bf16_t*)take((size_t)NB * 256 * SEQ * 2);
  p.zvTc = (bf16_t*)take((size_t)NB * 256 * CTXL * 2);
  p.br = (bf16_t*)take((size_t)NTOK * 1024 * 2);
  p.yscan = (float*)take((size_t)2 * NTOK * 256 * 4);
  p.vmix = (bf16_t*)take((size_t)NTOK * 256 * 2);
  p.coef = (float*)take((size_t)2 * NTOK * 4 * 4);
  p.ctx1 = (float*)take((size_t)NCTX * 1024 * 4);
  if (off > ws_size) fprintf(stderr, "workspace too small: need %zu have %zu\n", off, ws_size);
  hipMemsetAsync(p.xbar, 0, XB_WORDS * 4, stream);
  void* args[] = {&p};
  hipError_t e = hipLaunchCooperativeKernel((const void*)hybrid_mega, dim3(grid_blocks), dim3(NTHR), args, LDS_BYTES, stream);
  if (e != hipSuccess) fprintf(stderr, "cooperative launch failed: %s (grid %d)\n", hipGetErrorString(e), grid_blocks);
}
```

```cpp
#include <hip/hip_runtime.h>
#include <hip/hip_cooperative_groups.h>
#include <cstdio>
namespace cg = cooperative_groups;

typedef unsigned short bf16_t;
using bf16x8 = __attribute__((ext_vector_type(8))) short;
using f32x4 = __attribute__((ext_vector_type(4))) float;
using f32x2 = __attribute__((ext_vector_type(2))) float;

constexpr int D = 1024;
constexpr int NB = 8;
constexpr int SEQ = 4096;
constexpr int CTXL = 256;
constexpr int NLAT = NB * SEQ;
constexpr int NCTX = NB * CTXL;
constexpr int NTOK = NLAT + NCTX;
constexpr int INC = 7552;
constexpr int ZW = 3200;
constexpr int Z_GMU = 0, Z_GMV = 256, Z_GMG = 512, Z_NAQ = 768, Z_NAK = 1024, Z_NAG = 1280;
constexpr int Z_RWR = 1536, Z_RWK = 1792, Z_RWV = 2048, Z_RWW = 2304, Z_RWA = 2368, Z_RWG = 2432, Z_PLP = 2688, Z_PLG = 2944;
constexpr int LDS_BYTES = 73728;
constexpr int NTHR = 256;
#ifndef DUP_MASK
#define DUP_MASK 0
#endif

struct Params {
  const float *x, *c, *ctx, *c_ctx, *ada_w, *ada_b, *norm_g, *w_in, *gm_ln_g, *gm_ln_b, *gm_ws, *gm_bs, *na_rpb,
      *rw_mu, *rw_w0, *rw_w2, *rw_a0, *rw_a2, *rw_kk, *rw_ka, *rw_rk, *rw_gn_g, *rw_gn_b, *pl_w, *pl_scale, *w_br, *w_out, *final_g;
  float* out;
  bf16_t *WtIn, *WtBr, *WtOut, *h, *z, *zvT, *zvTc, *br, *vmix;
  float *mod, *yscan, *coef, *ctx1;
  unsigned* ctr;
  unsigned* xbar;
  unsigned* cuinfo;
};

__device__ __forceinline__ bf16_t f2bf(float f) {
  unsigned u = __float_as_uint(f);
  u += 0x7fffu + ((u >> 16) & 1u);
  return (bf16_t)(u >> 16);
}
__device__ __forceinline__ float bf2f(unsigned v) { return __uint_as_float(v << 16); }
__device__ __forceinline__ unsigned pack2(float a, float b) { return (unsigned)f2bf(a) | ((unsigned)f2bf(b) << 16); }
__device__ __forceinline__ float bflo(unsigned w) { return __uint_as_float(w << 16); }
__device__ __forceinline__ float bfhi(unsigned w) { return __uint_as_float(w & 0xffff0000u); }
__device__ __forceinline__ float frcp(float x) { return __builtin_amdgcn_rcpf(x); }
__device__ __forceinline__ float sigm(float x) { return frcp(1.f + __expf(-x)); }
__device__ __forceinline__ float silu_(float x) { return x * frcp(1.f + __expf(-x)); }
__device__ __forceinline__ float gelu_(float x) {
  float u = 1.5957691216f * (x + 0.044715f * x * x * x);
  return x * frcp(1.f + __expf(-u));
}
template <int CTRL>
__device__ __forceinline__ float dppf(float v) {
  return __int_as_float(__builtin_amdgcn_update_dpp(0, __float_as_int(v), CTRL, 0xf, 0xf, false));
}
__device__ __forceinline__ float red16_sum(float v) {
  v += dppf<0xB1>(v); v += dppf<0x4E>(v); v += dppf<0x141>(v); v += dppf<0x140>(v); return v;
}
__device__ __forceinline__ void red16_sum2(float& a, float& b) {
  a += dppf<0xB1>(a); asm volatile("" : "+v"(a));
  b += dppf<0xB1>(b); asm volatile("" : "+v"(b));
  a += dppf<0x4E>(a); asm volatile("" : "+v"(a));
  b += dppf<0x4E>(b); asm volatile("" : "+v"(b));
  a += dppf<0x141>(a); asm volatile("" : "+v"(a));
  b += dppf<0x141>(b); asm volatile("" : "+v"(b));
  a += dppf<0x140>(a); asm volatile("" : "+v"(a));
  b += dppf<0x140>(b); asm volatile("" : "+v"(b));
}
__device__ __forceinline__ float red16_max(float v) {
  v = fmaxf(v, dppf<0xB1>(v)); v = fmaxf(v, dppf<0x4E>(v)); v = fmaxf(v, dppf<0x141>(v)); v = fmaxf(v, dppf<0x140>(v)); return v;
}
__device__ __forceinline__ float red8_sum(float v) {
  v += dppf<0xB1>(v); v += dppf<0x4E>(v); v += dppf<0x141>(v); return v;
}
__device__ __forceinline__ float wave_sum(float v) {
#pragma unroll
  for (int o = 32; o > 0; o >>= 1) v += __shfl_xor(v, o);
  return v;
}
__device__ __forceinline__ int tid_op() {
  int t = threadIdx.x;
  asm volatile("" : "+v"(t));
  return t;
}
__device__ __forceinline__ void lds_barrier() {
  asm volatile("s_waitcnt lgkmcnt(0)" ::: "memory");
  __builtin_amdgcn_s_barrier();
  asm volatile("" ::: "memory");
}
__device__ __forceinline__ f32x4 mfma16(bf16x8 a, bf16x8 b, f32x4 c) {
  return __builtin_amdgcn_mfma_f32_16x16x32_bf16(a, b, c, 0, 0, 0);
}
__device__ __forceinline__ void unpack8(uint4 v, float* f) {
  f[0] = bflo(v.x); f[1] = bfhi(v.x); f[2] = bflo(v.y); f[3] = bfhi(v.y);
  f[4] = bflo(v.z); f[5] = bfhi(v.z); f[6] = bflo(v.w); f[7] = bfhi(v.w);
}

__device__ void transpose_tile(const float* __restrict__ src, int N, bf16_t* __restrict__ dst, int K, int k0, int n0, float* tile) {
  const int t = tid_op();
  const int r = t >> 4, c4 = (t & 15) * 4;
#pragma unroll
  for (int i = 0; i < 4; i++) {
    int k = r + 16 * i;
    float4 v = *(const float4*)(src + (size_t)(k0 + k) * N + n0 + c4);
    tile[k * 65 + c4 + 0] = v.x; tile[k * 65 + c4 + 1] = v.y; tile[k * 65 + c4 + 2] = v.z; tile[k * 65 + c4 + 3] = v.w;
  }
  __syncthreads();
  const int n = t >> 2, ks = (t & 3) * 16;
  unsigned pk[8];
#pragma unroll
  for (int i = 0; i < 8; i++) pk[i] = pack2(tile[(ks + 2 * i) * 65 + n], tile[(ks + 2 * i + 1) * 65 + n]);
  uint4* dp = (uint4*)(dst + (size_t)(n0 + n) * K + k0 + ks);
  dp[0] = make_uint4(pk[0], pk[1], pk[2], pk[3]);
  dp[1] = make_uint4(pk[4], pk[5], pk[6], pk[7]);
  __syncthreads();
}

__device__ void mod_item(const Params& p, int l, int jc, char* smem) {
  float* sil = (float*)smem;
  float* red = sil + 9 * 1024;
  const int t = tid_op();
  for (int i = t; i < 9 * 1024; i += NTHR) {
    int r = i >> 10, k = i & 1023;
    float v = r < 8 ? p.c[r * 1024 + k] : p.c_ctx[k];
    sil[i] = silu_(v);
  }
  __syncthreads();
  const int col = t & 63, q = t >> 6;
  float acc[9];
#pragma unroll
  for (int r = 0; r < 9; r++) acc[r] = 0.f;
  const float* w = p.ada_w + (size_t)l * 1024 * 3072 + jc * 64 + col;
  for (int k = q * 256; k < q * 256 + 256; k++) {
    float wv = w[(size_t)k * 3072];
#pragma unroll
    for (int r = 0; r < 9; r++) acc[r] += sil[r * 1024 + k] * wv;
  }
#pragma unroll
  for (int r = 0; r < 9; r++) red[(q * 9 + r) * 64 + col] = acc[r];
  __syncthreads();
  if (t < 64) {
    float bb = p.ada_b[l * 3072 + jc * 64 + t];
#pragma unroll
    for (int r = 0; r < 9; r++) {
      float s = red[(0 * 9 + r) * 64 + t] + red[(1 * 9 + r) * 64 + t] + red[(2 * 9 + r) * 64 + t] + red[(3 * 9 + r) * 64 + t];
      p.mod[(l * 9 + r) * 3072 + jc * 64 + t] = s + bb;
    }
  }
  __syncthreads();
}

__device__ void phase0(const Params& p, char* smem) {
  if (blockIdx.x == 0 && threadIdx.x < 8) p.ctr[threadIdx.x] = 0u;
  constexpr int PER_L = 2400 + 48;
  for (int it = blockIdx.x; it < 2 * PER_L; it += gridDim.x) {
    int l = it / PER_L, r = it % PER_L;
    if (r < 1888) {
      int kt = r & 15, nt = r >> 4;
      transpose_tile(p.w_in + (size_t)l * 1024 * INC, INC, p.WtIn + (size_t)l * INC * 1024, 1024, kt * 64, nt * 64, (float*)smem);
    } else if (r < 2144) {
      int q = r - 1888; int i = q >> 6; int kt = q & 3, nt = (q >> 2) & 15;
      transpose_tile(p.w_br + ((size_t)l * 4 + i) * 256 * 1024, 1024, p.WtBr + ((size_t)l * 4 + i) * 1024 * 256, 256, kt * 64, nt * 64, (float*)smem);
    } else if (r < 2400) {
      int q = r - 2144; int kt = q & 15, nt = q >> 4;
      transpose_tile(p.w_out + (size_t)l * 1024 * 1024, 1024, p.WtOut + (size_t)l * 1024 * 1024, 1024, kt * 64, nt * 64, (float*)smem);
    } else {
      mod_item(p, l, r - 2400, smem);
    }
  }
}

__device__ void phase_norm(const Params& p, int l, const float* xsrc, const float* csrc) {
  const int t_ = tid_op();
  const int lane = t_ & 63;
  const int gw = blockIdx.x * 4 + (t_ >> 6), nw = gridDim.x * 4;
  const float* g = p.norm_g + l * 1024;
  for (int r = gw; r < NTOK; r += nw) {
    const float* src; int mb;
    if (r < NLAT) { src = xsrc + (size_t)r * 1024; mb = r >> 12; } else { src = csrc + (size_t)(r - NLAT) * 1024; mb = 8; }
    const float* md = p.mod + (l * 9 + mb) * 3072;
    float4 v[4]; float ss = 0.f;
#pragma unroll
    for (int i = 0; i < 4; i++) {
      v[i] = *(const float4*)(src + lane * 4 + 256 * i);
      ss += v[i].x * v[i].x + v[i].y * v[i].y + v[i].z * v[i].z + v[i].w * v[i].w;
    }
    ss = wave_sum(ss);
    float rs = rsqrtf(ss * (1.f / 1024.f) + 1e-6f);
#pragma unroll
    for (int i = 0; i < 4; i++) {
      int col = lane * 4 + 256 * i;
      float4 gg = *(const float4*)(g + col);
      float4 sh = *(const float4*)(md + col);
      float4 sc = *(const float4*)(md + 1024 + col);
      float a0 = v[i].x * rs * gg.x * (1.f + sc.x) + sh.x;
      float a1 = v[i].y * rs * gg.y * (1.f + sc.y) + sh.y;
      float a2 = v[i].z * rs * gg.z * (1.f + sc.z) + sh.z;
      float a3 = v[i].w * rs * gg.w * (1.f + sc.w) + sh.w;
      *(uint2*)(p.h + (size_t)r * 1024 + col) = make_uint2(pack2(a0, a1), pack2(a2, a3));
    }
  }
}

__device__ void phase_final(const Params& p) {
  const int t_ = tid_op();
  const int lane = t_ & 63;
  const int gw = blockIdx.x * 4 + (t_ >> 6), nw = gridDim.x * 4;
  for (int r = gw; r < NLAT; r += nw) {
    float* src = p.out + (size_t)r * 1024;
    float4 v[4]; float ss = 0.f;
#pragma unroll
    for (int i = 0; i < 4; i++) {
      v[i] = *(const float4*)(src + lane * 4 + 256 * i);
      ss += v[i].x * v[i].x + v[i].y * v[i].y + v[i].z * v[i].z + v[i].w * v[i].w;
    }
    ss = wave_sum(ss);
    float rs = rsqrtf(ss * (1.f / 1024.f) + 1e-6f);
#pragma unroll
    for (int i = 0; i < 4; i++) {
      int col = lane * 4 + 256 * i;
      float4 gg = *(const float4*)(p.final_g + col);
      float4 o = make_float4(v[i].x * rs * gg.x, v[i].y * rs * gg.y, v[i].z * rs * gg.z, v[i].w * rs * gg.w);
      *(float4*)(src + col) = o;
    }
  }
}

template <int NT, bool SWAP>
__device__ __forceinline__ void gemm_compute(const bf16_t* a_s, const bf16_t* b_s, int o0, f32x4 (&acc)[4][NT]) {
#pragma unroll
  for (int ks = 0; ks < 2; ks++) {
    const int off = ks == 0 ? o0 : (o0 ^ 32);
    bf16x8 af[4], bfr[NT];
#pragma unroll
    for (int mt = 0; mt < 4; mt++) af[mt] = *(const bf16x8*)(a_s + mt * 16 * 64 + off);
#pragma unroll
    for (int nt = 0; nt < NT; nt++) bfr[nt] = *(const bf16x8*)(b_s + nt * 16 * 64 + off);
#pragma unroll
    for (int mt = 0; mt < 4; mt++)
#pragma unroll
      for (int nt = 0; nt < NT; nt++)
        acc[mt][nt] = SWAP ? mfma16(bfr[nt], af[mt], acc[mt][nt]) : mfma16(af[mt], bfr[nt], acc[mt][nt]);
  }
}

template <int NT, bool SWAP, int DEEP = 2>
__device__ __forceinline__ void gemm_mainloop(const bf16_t* __restrict__ A, int lda, const bf16_t* __restrict__ Bm, int ldb,
                                              int nk, f32x4 (&acc)[4][NT], bf16_t* sm) {
  constexpr int ASZ = 128 * 64, BSZ = NT * 32 * 64;
  bf16_t* sA = sm;
  bf16_t* sB = sm + 2 * ASZ;
  const int t = tid_op(), lane = t & 63, wave = t >> 6, wm = wave >> 1, wn = wave & 1;
  const int lr = t >> 3, lc = (t & 7) * 8;
  const int lcs = ((t & 7) ^ ((lr >> 1) & 7)) * 8;
  const int fr = lane & 15, fq = lane >> 4;
  uint4 p0a0, p0a1, p0a2, p0a3, p0b0, p0b1, p0b2, p0b3;
  uint4 p1a0, p1a1, p1a2, p1a3, p1b0, p1b1, p1b2, p1b3;
  p0b2 = p0b3 = p1b2 = p1b3 = make_uint4(0, 0, 0, 0);
  const bf16_t* Ap = A + (size_t)lr * lda + lc;
  const bf16_t* Bp = Bm + (size_t)lr * ldb + lc;
#define GLD(P, R, I, KT) *(const uint4*)(P + (size_t)(32 * I) * R + (KT) * 64)
#define GLOAD(S, KT)                                                         \
  {                                                                          \
    S##a0 = GLD(Ap, lda, 0, KT); S##a1 = GLD(Ap, lda, 1, KT);                \
    S##a2 = GLD(Ap, lda, 2, KT); S##a3 = GLD(Ap, lda, 3, KT);                \
    S##b0 = GLD(Bp, ldb, 0, KT); S##b1 = GLD(Bp, ldb, 1, KT);                \
    if constexpr (NT == 4) { S##b2 = GLD(Bp, ldb, 2, KT); S##b3 = GLD(Bp, ldb, 3, KT); } \
  }
#define SST(BASE, I) *(uint4*)(BASE + (lr + 32 * I) * 64 + lcs)
#define SWRITE(S, BUF)                                                       \
  {                                                                          \
    SST(sA + (BUF) * ASZ, 0) = S##a0; SST(sA + (BUF) * ASZ, 1) = S##a1;      \
    SST(sA + (BUF) * ASZ, 2) = S##a2; SST(sA + (BUF) * ASZ, 3) = S##a3;      \
    SST(sB + (BUF) * BSZ, 0) = S##b0; SST(sB + (BUF) * BSZ, 1) = S##b1;      \
    if constexpr (NT == 4) { SST(sB + (BUF) * BSZ, 2) = S##b2; SST(sB + (BUF) * BSZ, 3) = S##b3; } \
  }
  const bf16_t* a_s0 = sA + (wm * 64 + fr) * 64;
  const bf16_t* b_s0 = sB + (wn * (NT * 16) + fr) * 64;
  const int o0 = (fq ^ ((fr >> 1) & 7)) * 8;
  if (DEEP == 2) {
    GLOAD(p0, 0);
    GLOAD(p1, 1);
    SWRITE(p0, 0);
    __syncthreads();
#pragma unroll 1
    for (int kt = 0; kt < nk; kt += 2) {
      const bool m2 = kt + 2 < nk;
      if (m2) GLOAD(p0, kt + 2);
      gemm_compute<NT, SWAP>(a_s0, b_s0, o0, acc);
      SWRITE(p1, 1);
      __syncthreads();
      if (m2) GLOAD(p1, kt + 3);
      gemm_compute<NT, SWAP>(a_s0 + ASZ, b_s0 + BSZ, o0, acc);
      if (m2) SWRITE(p0, 0);
      __syncthreads();
    }
  } else {
    GLOAD(p0, 0);
    SWRITE(p0, 0);
    __syncthreads();
#pragma unroll 1
    for (int kt = 0; kt < nk; kt += 2) {
      const bool m2 = kt + 2 < nk;
      GLOAD(p0, kt + 1);
      gemm_compute<NT, SWAP>(a_s0, b_s0, o0, acc);
      SWRITE(p0, 1);
      __syncthreads();
      if (m2) GLOAD(p0, kt + 2);
      gemm_compute<NT, SWAP>(a_s0 + ASZ, b_s0 + BSZ, o0, acc);
      if (m2) SWRITE(p0, 0);
      __syncthreads();
    }
  }
#undef GLOAD
#undef SWRITE
#undef GLD
#undef SST
}

template <int NT>
__device__ __forceinline__ void zero_acc(f32x4 (&acc)[4][NT]) {
#pragma unroll
  for (int i = 0; i < 4; i++)
#pragma unroll
    for (int j = 0; j < NT; j++) acc[i][j] = f32x4{0.f, 0.f, 0.f, 0.f};
}

struct TileIter {
  int total, TN, per_x, base, lim, nslot, slot;
  __device__ __forceinline__ void init(int TM, int TN_, int vb = -1, int nvb = 0) {
    TN = TN_; total = TM * TN_;
    const int nx = 8;
    if (vb < 0) { vb = blockIdx.x; nvb = gridDim.x; }
    per_x = (total + nx - 1) / nx;
    const int xcd = vb % nx;
    slot = vb / nx;
    nslot = (nvb + nx - 1) / nx;
    base = xcd * per_x;
    lim = min(total, base + per_x);
  }
  __device__ __forceinline__ bool get(int iter, int& m, int& n) const {
    const int T = base + iter * nslot + slot;
    if (T >= lim) return false;
    const int grp = T / (8 * TN), r = T % (8 * TN);
    m = grp * 8 + (r & 7); n = r >> 3;
    return true;
  }
};

__device__ void phase_g1(const Params& p, int l, char* smem, int part, int vb, int nvb) {
  const int t_ = tid_op(); const int lane = t_ & 63, wave = t_ >> 6, wm = wave >> 1, wn = wave & 1, fr = lane & 15, fq = lane >> 4;
  const bf16_t* W = p.WtIn + (size_t)l * INC * 1024;
  constexpr int NTILE_N = 27, NTILE_M = NTOK / 128;
  TileIter ti; ti.init(NTILE_M, part == 0 ? NTILE_N : part == 1 ? 7 : 20, vb, nvb);
  for (int iter = 0;; iter++) {
    int mtile, ntile;
    if (!ti.get(iter, mtile, ntile)) break;
    if (part == 1) ntile += 14; else if (part == 2) ntile = ntile < 14 ? ntile : ntile + 7;
    const int m0 = mtile * 128, n0 = ntile * 128;
    f32x4 acc[4][4];
    zero_acc<4>(acc);
    if (ntile == 10 || ntile == 11) {
      gemm_mainloop<4, false>(p.h + (size_t)m0 * 1024, 1024, W + (size_t)n0 * 1024, 1024, 16, acc, (bf16_t*)smem);
#pragma unroll
      for (int mt = 0; mt < 4; mt++)
#pragma unroll
        for (int nt = 0; nt < 4; nt++) {
          int m = m0 + wm * 64 + mt * 16 + fq * 4;
          int ch = n0 + wn * 64 + nt * 16 + fr - 1280;
          bf16_t* dst;
          if (m0 < NLAT) { int b = m0 >> 12; dst = p.zvT + ((size_t)(b * 256 + ch)) * 4096 + (m - b * 4096); }
          else { int mm = m - NLAT; int b = mm >> 8; dst = p.zvTc + ((size_t)(b * 256 + ch)) * 256 + (mm & 255); }
          *(uint2*)dst = make_uint2(pack2(acc[mt][nt][0], acc[mt][nt][1]), pack2(acc[mt][nt][2], acc[mt][nt][3]));
        }
    } else {
      gemm_mainloop<4, true>(p.h + (size_t)m0 * 1024, 1024, W + (size_t)n0 * 1024, 1024, 16, acc, (bf16_t*)smem);
      const int zoff = n0 < 1280 ? 0 : -256;
#pragma unroll
      for (int mt = 0; mt < 4; mt++)
#pragma unroll
        for (int nt = 0; nt < 4; nt++) {
          int m = m0 + wm * 64 + mt * 16 + fr;
          int n = n0 + wn * 64 + nt * 16 + fq * 4 + zoff;
          *(uint2*)(p.z + (size_t)m * ZW + n) = make_uint2(pack2(acc[mt][nt][0], acc[mt][nt][1]), pack2(acc[mt][nt][2], acc[mt][nt][3]));
        }
    }
  }
}

template <int NT>
__device__ __forceinline__ void g2_tile(const Params& p, int l, char* smem, int m0, int n0) {
  const int t_ = tid_op(); const int lane = t_ & 63, wave = t_ >> 6, wm = wave >> 1, wn = wave & 1, fr = lane & 15, fq = lane >> 4;
  const bf16_t* W = p.WtIn + (size_t)l * INC * 1024;
  const bf16_t* Wb = p.WtBr + (size_t)l * 4 * 1024 * 256;
  bf16_t* y = p.z;
#pragma unroll 1
  for (int i = 0; i < 4; i++) {
    f32x4 acc[4][NT];
    unsigned ppk[4][NT][2];
    zero_acc<NT>(acc);
    gemm_mainloop<NT, true, 1>(p.br + (size_t)m0 * 1024 + i * 256, 1024, Wb + ((size_t)i * 1024 + n0) * 256, 256, 4, acc, (bf16_t*)smem);
#pragma unroll
    for (int mt = 0; mt < 4; mt++)
#pragma unroll
      for (int nt = 0; nt < NT; nt++) {
        ppk[mt][nt][0] = pack2(acc[mt][nt][0], acc[mt][nt][1]);
        ppk[mt][nt][1] = pack2(acc[mt][nt][2], acc[mt][nt][3]);
      }
    zero_acc<NT>(acc);
    gemm_mainloop<NT, true, 1>(p.h + (size_t)m0 * 1024, 1024, W + (size_t)(3456 + i * 1024 + n0) * 1024, 1024, 16, acc, (bf16_t*)smem);
#pragma unroll
    for (int mt = 0; mt < 4; mt++)
#pragma unroll
      for (int nt = 0; nt < NT; nt++) {
        const int m = m0 + wm * 64 + mt * 16 + fr;
        const int n = n0 + wn * (NT * 16) + nt * 16 + fq * 4;
        uint2* yp = (uint2*)(y + (size_t)m * 1024 + n);
        uint2 yo = make_uint2(0u, 0u);
        if (i > 0) yo = *yp;
        float y0 = bflo(yo.x) + sigm(acc[mt][nt][0]) * bflo(ppk[mt][nt][0]);
        float y1 = bfhi(yo.x) + sigm(acc[mt][nt][1]) * bfhi(ppk[mt][nt][0]);
        float y2 = bflo(yo.y) + sigm(acc[mt][nt][2]) * bflo(ppk[mt][nt][1]);
        float y3 = bfhi(yo.y) + sigm(acc[mt][nt][3]) * bfhi(ppk[mt][nt][1]);
        *yp = make_uint2(pack2(y0, y1), pack2(y2, y3));
      }
  }
}
__device__ void phase_g2(const Params& p, int l, char* smem) {
  {
    TileIter ti; ti.init(NLAT / 128, 8);
    for (int iter = 0;; iter++) {
      int mtile, ntile;
      if (!ti.get(iter, mtile, ntile)) break;
      g2_tile<4>(p, l, smem, mtile * 128, ntile * 128);
    }
  }
  if (l == 0) {
    TileIter ti; ti.init(NCTX / 128, 16);
    for (int iter = 0;; iter++) {
      int mtile, ntile;
      if (!ti.get(iter, mtile, ntile)) break;
      g2_tile<2>(p, l, smem, NLAT + mtile * 128, ntile * 64);
    }
  }
}

__device__ void phase_g3(const Params& p, int l, char* smem) {
  const int t_ = tid_op(); const int lane = t_ & 63, wave = t_ >> 6, wm = wave >> 1, wn = wave & 1, fr = lane & 15, fq = lane >> 4;
  const bf16_t* W = p.WtOut + (size_t)l * 1024 * 1024;
  const bf16_t* y = p.z;
  const int ntm = (l == 0 ? NTOK : NLAT) / 128;
  TileIter ti; ti.init(ntm, 8);
  for (int iter = 0;; iter++) {
    int mtile, ntile;
    if (!ti.get(iter, mtile, ntile)) break;
    const int m0 = mtile * 128, n0 = ntile * 128;
    f32x4 acc[4][4];
    zero_acc<4>(acc);
    gemm_mainloop<4, true>(y + (size_t)m0 * 1024, 1024, W + (size_t)n0 * 1024, 1024, 16, acc, (bf16_t*)smem);
    const float* src; float* dst; int mb;
    if (m0 < NLAT) { src = (l == 0 ? p.x : p.out) + (size_t)m0 * 1024; dst = p.out + (size_t)m0 * 1024; mb = m0 >> 12; }
    else { src = p.ctx + (size_t)(m0 - NLAT) * 1024; dst = p.ctx1 + (size_t)(m0 - NLAT) * 1024; mb = 8; }
    const float* gate = p.mod + (l * 9 + mb) * 3072 + 2048;
#pragma unroll
    for (int mt = 0; mt < 4; mt++)
#pragma unroll
      for (int nt = 0; nt < 4; nt++) {
        int mr = wm * 64 + mt * 16 + fr;
        int n = n0 + wn * 64 + nt * 16 + fq * 4;
        float4 xv = *(const float4*)(src + (size_t)mr * 1024 + n);
        float4 gv = *(const float4*)(gate + n);
        float4 o = make_float4(xv.x + gv.x * acc[mt][nt][0], xv.y + gv.y * acc[mt][nt][1], xv.z + gv.z * acc[mt][nt][2], xv.w + gv.w * acc[mt][nt][3]);
        *(float4*)(dst + (size_t)mr * 1024 + n) = o;
      }
  }
}

__device__ void scan_item(const Params& p, int l, int item, char* smem) {
  const int rq = item & 1, d = (item >> 1) & 1, h = (item >> 2) & 3, b = item >> 4;
  const int t = tid_op(), lane = t & 63, wave = t >> 6, fr = lane & 15, fq = lane >> 4;
  float* Wd = (float*)smem;
  float* Av = Wd + 2048;
  float* Bv = Av + 2048;
  float* Kd = Bv + 2048;
  float* Rr = Kd + 2048;
  float* Vv = Rr + 2048;
  float* Pf = Vv + 1024;
  float* Yb = Pf;
  float* Qf = Pf + 2048;
  float* prm = Qf + 2048;
  bf16_t* wl = (bf16_t*)(prm + 320);
  bf16_t* al = wl + 32 * 72;

  for (int i = t; i < 320; i += NTHR) {
    int which = i >> 6, k = i & 63;
    float v;
    if (which == 0) v = p.rw_w0[(l * 2 + d) * 256 + h * 64 + k];
    else if (which == 1) v = p.rw_a0[(l * 2 + d) * 256 + h * 64 + k];
    else if (which == 2) v = p.rw_ka[l * 256 + h * 64 + k];
    else if (which == 3) v = p.rw_kk[l * 256 + h * 64 + k];
    else v = p.rw_rk[(l * 4 + h) * 64 + k];
    prm[i] = v;
  }
  bf16x8 w2f[2], a2f[2];
  {
    const int n = h * 64 + 16 * wave + fr;
    const float* w2 = p.rw_w2 + (size_t)(l * 2 + d) * 64 * 256 + n;
    const float* a2 = p.rw_a2 + (size_t)(l * 2 + d) * 64 * 256 + n;
#pragma unroll
    for (int ks = 0; ks < 2; ks++)
#pragma unroll
      for (int j = 0; j < 8; j++) {
        int kk = ks * 32 + fq * 8 + j;
        w2f[ks][j] = (short)f2bf(w2[kk * 256]);
        a2f[ks][j] = (short)f2bf(a2[kk * 256]);
      }
  }
  __syncthreads();

  f32x2 su0 = {0.f, 0.f}, su1 = {0.f, 0.f}, su2 = {0.f, 0.f}, su3 = {0.f, 0.f};
  const int kseg = lane & 15, rowl = wave * 8 + (lane >> 4) * 2;
  const int tt1 = t >> 3, oct = t & 7;
  constexpr int NCH_C = CTXL / 32, NCH_L = SEQ / 32, NCH = NCH_C + NCH_L;
  uint4 rcu[5], rpv[5], rnx[5];
  auto load_raw = [&](int gc) {
    const bool isc = gc < NCH_C;
    const int T = isc ? CTXL : SEQ;
    const int nch = isc ? NCH_C : NCH_L;
    const int ci = isc ? gc : gc - NCH_C;
    const int c = d ? nch - 1 - ci : ci;
    const size_t rowbase = isc ? (size_t)NLAT + b * CTXL : (size_t)b * SEQ;
    const int tok = c * 32 + tt1;
    const bf16_t* zr = p.z + (rowbase + tok) * ZW;
    const bool hp = tok > 0, hn = tok < T - 1;
#pragma unroll
    for (int g = 0; g < 5; g++) {
      const int colbase = g == 0 ? Z_RWR + h * 64 : g == 1 ? Z_RWK + h * 64 : g == 2 ? Z_RWV + h * 64 : g == 3 ? Z_RWW : Z_RWA;
      const int col = colbase + oct * 8;
      rcu[g] = *(const uint4*)(zr + col);
      rpv[g] = make_uint4(0, 0, 0, 0);
      rnx[g] = make_uint4(0, 0, 0, 0);
      if (hp) rpv[g] = *(const uint4*)(zr - ZW + col);
      if (hn) rnx[g] = *(const uint4*)(zr + ZW + col);
    }
  };
  float mureg[5][8];
#pragma unroll
  for (int g = 0; g < 5; g++) {
    const int colbase = g == 0 ? Z_RWR + h * 64 : g == 1 ? Z_RWK + h * 64 : g == 2 ? Z_RWV + h * 64 : g == 3 ? Z_RWW : Z_RWA;
    const float* mup = p.rw_mu + l * 896 + (colbase + oct * 8 - Z_RWR);
    float4 m0 = *(const float4*)mup, m1 = *(const float4*)(mup + 4);
    mureg[g][0] = m0.x; mureg[g][1] = m0.y; mureg[g][2] = m0.z; mureg[g][3] = m0.w;
    mureg[g][4] = m1.x; mureg[g][5] = m1.y; mureg[g][6] = m1.z; mureg[g][7] = m1.w;
  }
  load_raw(0);
  __builtin_amdgcn_s_setprio(2);
#pragma unroll 1
  for (int gc = 0; gc < NCH; gc++) {
    const bool isc = gc < NCH_C;
    const int nch = isc ? NCH_C : NCH_L;
    const int ci = isc ? gc : gc - NCH_C;
    const int c = d ? nch - 1 - ci : ci;
    const size_t rowbase = isc ? (size_t)NLAT + b * CTXL : (size_t)b * SEQ;
    const int t0 = c * 32;
    {
      const int tt = tt1;
      const int tok = t0 + tt;
#pragma unroll
      for (int g = 0; g < 5; g++) {
        const int colbase = g == 0 ? Z_RWR + h * 64 : g == 1 ? Z_RWK + h * 64 : g == 2 ? Z_RWV + h * 64 : g == 3 ? Z_RWW : Z_RWA;
        const int col = colbase + oct * 8;
        float fc[8], fp[8], fn[8], mix[8];
        unpack8(rcu[g], fc); unpack8(rpv[g], fp); unpack8(rnx[g], fn);
#pragma unroll
        for (int i = 0; i < 8; i++) mix[i] = fc[i] + (0.5f * (fp[i] + fn[i]) - fc[i]) * mureg[g][i];
        if (g == 0) {
          *(float4*)(Rr + tt * 64 + oct * 8) = make_float4(mix[0], mix[1], mix[2], mix[3]);
          *(float4*)(Rr + tt * 64 + oct * 8 + 4) = make_float4(mix[4], mix[5], mix[6], mix[7]);
        } else if (g == 1) {
          *(float4*)(Kd + tt * 64 + oct * 8) = make_float4(mix[0], mix[1], mix[2], mix[3]);
          *(float4*)(Kd + tt * 64 + oct * 8 + 4) = make_float4(mix[4], mix[5], mix[6], mix[7]);
        } else if (g == 2) {
          if ((oct >> 2) == rq) {
            *(float4*)(Vv + tt * 32 + (oct & 3) * 8) = make_float4(mix[0], mix[1], mix[2], mix[3]);
            *(float4*)(Vv + tt * 32 + (oct & 3) * 8 + 4) = make_float4(mix[4], mix[5], mix[6], mix[7]);
            if (d == 0) {
              *(uint4*)(p.vmix + (rowbase + tok) * 256 + h * 64 + oct * 8) =
                  make_uint4(pack2(mix[0], mix[1]), pack2(mix[2], mix[3]), pack2(mix[4], mix[5]), pack2(mix[6], mix[7]));
            }
          }
        } else if (g == 3) {
          float th[8];
#pragma unroll
          for (int i = 0; i < 8; i++) th[i] = 1.f - 2.f * frcp(1.f + __expf(2.f * mix[i]));
          *(uint4*)(wl + tt * 72 + oct * 8) = make_uint4(pack2(th[0], th[1]), pack2(th[2], th[3]), pack2(th[4], th[5]), pack2(th[6], th[7]));
        } else {
          *(uint4*)(al + tt * 72 + oct * 8) = make_uint4(pack2(mix[0], mix[1]), pack2(mix[2], mix[3]), pack2(mix[4], mix[5]), pack2(mix[6], mix[7]));
        }
      }
    }
    if (gc + 1 < NCH) load_raw(gc + 1);
    lds_barrier();
    {
#pragma unroll
      for (int mt = 0; mt < 2; mt++) {
        f32x4 ap = {0.f, 0.f, 0.f, 0.f}, aq = {0.f, 0.f, 0.f, 0.f};
#pragma unroll
        for (int ks = 0; ks < 2; ks++) {
          bf16x8 fa = *(const bf16x8*)(wl + (mt * 16 + fr) * 72 + ks * 32 + fq * 8);
          bf16x8 fb = *(const bf16x8*)(al + (mt * 16 + fr) * 72 + ks * 32 + fq * 8);
          ap = mfma16(fa, w2f[ks], ap);
          aq = mfma16(fb, a2f[ks], aq);
        }
#pragma unroll
        for (int j = 0; j < 4; j++) {
          Pf[(mt * 16 + fq * 4 + j) * 64 + wave * 16 + fr] = ap[j];
          Qf[(mt * 16 + fq * 4 + j) * 64 + wave * 16 + fr] = aq[j];
        }
      }
    }
    lds_barrier();
    {
      const int tt = tt1;
      float ss = 0.f, cf = 0.f;
      float kkr[8], aa[8], pv[8], qv[8], kv[8], rv[8], dec[8], kdv[8];
      *(float4*)(pv) = *(const float4*)(Pf + tt * 64 + oct * 8); *(float4*)(pv + 4) = *(const float4*)(Pf + tt * 64 + oct * 8 + 4);
      *(float4*)(qv) = *(const float4*)(Qf + tt * 64 + oct * 8); *(float4*)(qv + 4) = *(const float4*)(Qf + tt * 64 + oct * 8 + 4);
      *(float4*)(kv) = *(const float4*)(Kd + tt * 64 + oct * 8); *(float4*)(kv + 4) = *(const float4*)(Kd + tt * 64 + oct * 8 + 4);
      *(float4*)(rv) = *(const float4*)(Rr + tt * 64 + oct * 8); *(float4*)(rv + 4) = *(const float4*)(Rr + tt * 64 + oct * 8 + 4);
#pragma unroll
      for (int i = 0; i < 8; i++) {
        const int k = oct * 8 + i;
        float pp = prm[k] + pv[i];
        dec[i] = __expf(-0.6065306597f * sigm(pp));
        float a = sigm(prm[64 + k] + qv[i]);
        float kr = kv[i];
        kdv[i] = kr * (1.f + (a - 1.f) * prm[128 + k]);
        kkr[i] = kr * prm[192 + k];
        ss += kkr[i] * kkr[i];
        cf += rv[i] * kdv[i] * prm[256 + k];
        aa[i] = a;
      }
      ss = red8_sum(ss);
      cf = red8_sum(cf);
      float inv = frcp(fmaxf(__builtin_amdgcn_sqrtf(ss), 1e-12f));
      float av[8], bv[8];
#pragma unroll
      for (int i = 0; i < 8; i++) { float kk = kkr[i] * inv; av[i] = -kk; bv[i] = kk * aa[i]; }
      *(float4*)(Wd + tt * 64 + oct * 8) = *(float4*)(dec); *(float4*)(Wd + tt * 64 + oct * 8 + 4) = *(float4*)(dec + 4);
      *(float4*)(Kd + tt * 64 + oct * 8) = *(float4*)(kdv); *(float4*)(Kd + tt * 64 + oct * 8 + 4) = *(float4*)(kdv + 4);
      *(float4*)(Av + tt * 64 + oct * 8) = *(float4*)(av); *(float4*)(Av + tt * 64 + oct * 8 + 4) = *(float4*)(av + 4);
      *(float4*)(Bv + tt * 64 + oct * 8) = *(float4*)(bv); *(float4*)(Bv + tt * 64 + oct * 8 + 4) = *(float4*)(bv + 4);
      if (rq == 0 && oct == 0) p.coef[((size_t)d * NTOK + rowbase + t0 + tt) * 4 + h] = cf;
    }
    lds_barrier();
    {
      const int step = d ? -1 : 1;
      int tt = d ? 31 : 0;
      float4 w = *(const float4*)(Wd + tt * 64 + kseg * 4);
      float4 a = *(const float4*)(Av + tt * 64 + kseg * 4);
      float4 bb = *(const float4*)(Bv + tt * 64 + kseg * 4);
      float4 kd = *(const float4*)(Kd + tt * 64 + kseg * 4);
      float4 r = *(const float4*)(Rr + tt * 64 + kseg * 4);
      float2 v = *(const float2*)(Vv + tt * 32 + rowl);
      float ysel0 = 0.f, ysel1 = 0.f;
#pragma unroll 16
      for (int i = 0; i < 32; i++) {
        const int tn = (i < 31) ? tt + step : tt;
        float4 w2 = *(const float4*)(Wd + tn * 64 + kseg * 4);
        float4 a2 = *(const float4*)(Av + tn * 64 + kseg * 4);
        float4 b2 = *(const float4*)(Bv + tn * 64 + kseg * 4);
        float4 k2 = *(const float4*)(Kd + tn * 64 + kseg * 4);
        float4 r2 = *(const float4*)(Rr + tn * 64 + kseg * 4);
        float2 v2 = *(const float2*)(Vv + tn * 32 + rowl);
        f32x2 sau = (su0 * a.x + su1 * a.y) + (su2 * a.z + su3 * a.w);
        float sa = sau.x, ua = sau.y;
        red16_sum2(sa, ua);
        sau = f32x2{sa, ua};
        const f32x2 vv = f32x2{v.x, v.y};
        su0 = su0 * w.x + sau * bb.x + vv * kd.x;
        su1 = su1 * w.y + sau * bb.y + vv * kd.y;
        su2 = su2 * w.z + sau * bb.z + vv * kd.z;
        su3 = su3 * w.w + sau * bb.w + vv * kd.w;
        const f32x2 yy = (su0 * r.x + su1 * r.y) + (su2 * r.z + su3 * r.w);
        float y0 = yy.x, y1 = yy.y;
        red16_sum2(y0, y1);
        ysel0 = ((i & 15) == kseg) ? y0 : ysel0;
        ysel1 = ((i & 15) == kseg) ? y1 : ysel1;
        if ((i & 15) == 15) {
          const int si = (i - 15) + kseg;
          const int ts = d ? 31 - si : si;
          *(float2*)(Yb + ts * 32 + rowl) = make_float2(ysel0, ysel1);
        }
        w = w2; a = a2; bb = b2; kd = k2; r = r2; v = v2; tt = tn;
      }
    }
    lds_barrier();
    {
      const int tt = t >> 3, q4 = t & 7;
      float4 yv = *(const float4*)(Yb + tt * 32 + q4 * 4);
      *(uint2*)((bf16_t*)p.yscan + ((size_t)d * NTOK + rowbase + t0 + tt) * 256 + h * 64 + rq * 32 + q4 * 4) =
          make_uint2(pack2(yv.x, yv.y), pack2(yv.z, yv.w));
    }
  }
  __builtin_amdgcn_s_setprio(0);
  __syncthreads();
}

template <int nband>
__device__ void natten_item(const Params& p, int l, int b, int h, size_t qrow0, int r, char* smem) {
  const int t = tid_op(), lane = t & 63, wave = t >> 6, fr = lane & 15, fq = lane >> 4;
  float* rpb = (float*)smem;
  bf16_t* Ps = (bf16_t*)(smem + 2048) + wave * 16 * 72;
  for (int i = t; i < 465; i += NTHR) rpb[i] = p.na_rpb[(l * 4 + h) * 465 + i];
  __syncthreads();
  const int qloc = wave * 16;
  bf16x8 qf[2];
#pragma unroll
  for (int ks = 0; ks < 2; ks++) qf[ks] = *(const bf16x8*)(p.z + (qrow0 + qloc + fr) * ZW + Z_NAQ + h * 64 + ks * 32 + fq * 8);
  float mrow[4], lrow[4];
  f32x4 o[4];
#pragma unroll
  for (int j = 0; j < 4; j++) { mrow[j] = -1e30f; lrow[j] = 0.f; o[j] = f32x4{0.f, 0.f, 0.f, 0.f}; }
  const int rstart = min(max(r - 4, 0), 56);
  const int c0w = wave == 0 ? 0 : wave == 1 ? 8 : wave == 2 ? 24 : 32;
#define LDF(PTR) (*(const bf16x8*)(PTR))
  const bf16_t* kcp = p.z + ((size_t)NLAT + b * CTXL + fr) * ZW + Z_NAK + h * 64 + fq * 8;
  const bf16_t* vcp = p.zvTc + ((size_t)(b * 256 + h * 64 + fr)) * 256 + fq * 8;
  bf16x8 kc0 = LDF(kcp), kc1 = LDF(kcp + 32), kc2 = LDF(kcp + 16 * ZW), kc3 = LDF(kcp + 16 * ZW + 32);
  bf16x8 kc4 = LDF(kcp + 32 * ZW), kc5 = LDF(kcp + 32 * ZW + 32), kc6 = LDF(kcp + 48 * ZW), kc7 = LDF(kcp + 48 * ZW + 32);
  if (nband > 0) {
    const bf16_t* kp = p.z + ((size_t)b * SEQ + rstart * 64 + c0w + fr) * ZW + Z_NAK + h * 64 + fq * 8;
    const bf16_t* vp = p.zvT + ((size_t)(b * 256 + h * 64 + fr)) * 4096 + rstart * 64 + c0w + fq * 8;
    bf16x8 kb0 = LDF(kp), kb1 = LDF(kp + 32), kb2 = LDF(kp + 16 * ZW), kb3 = LDF(kp + 16 * ZW + 32);
    bf16x8 vb0 = LDF(vp), vb1 = LDF(vp + 16 * 4096), vb2 = LDF(vp + 32 * 4096), vb3 = LDF(vp + 48 * 4096);
#pragma unroll 1
    for (int kt = 0; kt < nband; kt++) {
      const int rr = rstart + kt;
      kp += 64 * ZW; vp += 64;
      bf16x8 kn0 = kb0, kn1 = kb1, kn2 = kb2, kn3 = kb3, vn0 = vb0, vn1 = vb1, vn2 = vb2, vn3 = vb3;
      if (kt + 1 < nband) {
        kn0 = LDF(kp); kn1 = LDF(kp + 32); kn2 = LDF(kp + 16 * ZW); kn3 = LDF(kp + 16 * ZW + 32);
        vn0 = LDF(vp); vn1 = LDF(vp + 16 * 4096); vn2 = LDF(vp + 32 * 4096); vn3 = LDF(vp + 48 * 4096);
      }
      f32x4 s[2];
      s[0] = mfma16(qf[0], kb0, f32x4{0.f, 0.f, 0.f, 0.f}); s[0] = mfma16(qf[1], kb1, s[0]);
      s[1] = mfma16(qf[0], kb2, f32x4{0.f, 0.f, 0.f, 0.f}); s[1] = mfma16(qf[1], kb3, s[1]);
      float pj[2][4];
#pragma unroll
      for (int j = 0; j < 4; j++) {
        const int q = qloc + fq * 4 + j;
        float mx = -1e30f;
#pragma unroll
        for (int nt = 0; nt < 2; nt++) {
          const int kc = c0w + nt * 16 + fr;
          const int cs = min(max(q - 8, 0), 48);
          const bool ok = (kc >= cs) && (kc < cs + 16);
          const int dc = min(max(kc - q, -15), 15);
          float bias = rpb[(rr - r + 7) * 31 + dc + 15];
          float val = ok ? s[nt][j] * 0.125f + bias : -1e30f;
          pj[nt][j] = val;
          mx = fmaxf(mx, val);
        }
        mx = red16_max(mx);
        const float mnew = fmaxf(mrow[j], mx);
        const float alpha = __expf(mrow[j] - mnew);
        float sum = 0.f;
#pragma unroll
        for (int nt = 0; nt < 2; nt++) { float e = __expf(pj[nt][j] - mnew); pj[nt][j] = e; sum += e; }
        sum = red16_sum(sum);
        lrow[j] = lrow[j] * alpha + sum;
        mrow[j] = mnew;
#pragma unroll
        for (int nt = 0; nt < 4; nt++) o[nt][j] *= alpha;
      }
#pragma unroll
      for (int nt = 0; nt < 2; nt++)
#pragma unroll
        for (int j = 0; j < 4; j++) Ps[(fq * 4 + j) * 72 + nt * 16 + fr] = f2bf(pj[nt][j]);
      __builtin_amdgcn_fence(__ATOMIC_RELEASE, "wavefront");
      __builtin_amdgcn_wave_barrier();
      __builtin_amdgcn_fence(__ATOMIC_ACQUIRE, "wavefront");
      bf16x8 pf = *(const bf16x8*)(Ps + fr * 72 + fq * 8);
      o[0] = mfma16(pf, vb0, o[0]); o[1] = mfma16(pf, vb1, o[1]); o[2] = mfma16(pf, vb2, o[2]); o[3] = mfma16(pf, vb3, o[3]);
      __builtin_amdgcn_fence(__ATOMIC_RELEASE, "wavefront");
      __builtin_amdgcn_wave_barrier();
      kb0 = kn0; kb1 = kn1; kb2 = kn2; kb3 = kn3; vb0 = vn0; vb1 = vn1; vb2 = vn2; vb3 = vn3;
    }
  }
#pragma unroll 1
  for (int cc = 0; cc < 4; cc++) {
    bf16x8 vfc[4][2];
#pragma unroll
    for (int nt = 0; nt < 4; nt++)
#pragma unroll
      for (int ks = 0; ks < 2; ks++) vfc[nt][ks] = *(const bf16x8*)(vcp + (size_t)(nt * 16) * 256 + ks * 32);
    vcp += 64;
    kcp += 64 * ZW;
    bf16x8 kn0 = kc0, kn1 = kc1, kn2 = kc2, kn3 = kc3, kn4 = kc4, kn5 = kc5, kn6 = kc6, kn7 = kc7;
    if (cc + 1 < 4) {
      kn0 = LDF(kcp); kn1 = LDF(kcp + 32); kn2 = LDF(kcp + 16 * ZW); kn3 = LDF(kcp + 16 * ZW + 32);
      kn4 = LDF(kcp + 32 * ZW); kn5 = LDF(kcp + 32 * ZW + 32); kn6 = LDF(kcp + 48 * ZW); kn7 = LDF(kcp + 48 * ZW + 32);
    }
    f32x4 s[4];
    s[0] = mfma16(qf[0], kc0, f32x4{0.f, 0.f, 0.f, 0.f}); s[0] = mfma16(qf[1], kc1, s[0]);
    s[1] = mfma16(qf[0], kc2, f32x4{0.f, 0.f, 0.f, 0.f}); s[1] = mfma16(qf[1], kc3, s[1]);
    s[2] = mfma16(qf[0], kc4, f32x4{0.f, 0.f, 0.f, 0.f}); s[2] = mfma16(qf[1], kc5, s[2]);
    s[3] = mfma16(qf[0], kc6, f32x4{0.f, 0.f, 0.f, 0.f}); s[3] = mfma16(qf[1], kc7, s[3]);
    float pj[4][4];
#pragma unroll
    for (int j = 0; j < 4; j++) {
      float mx = -1e30f;
#pragma unroll
      for (int nt = 0; nt < 4; nt++) { float val = s[nt][j] * 0.125f; pj[nt][j] = val; mx = fmaxf(mx, val); }
      mx = red16_max(mx);
      const float mnew = fmaxf(mrow[j], mx);
      const float alpha = __expf(mrow[j] - mnew);
      float sum = 0.f;
#pragma unroll
      for (int nt = 0; nt < 4; nt++) { float e = __expf(pj[nt][j] - mnew); pj[nt][j] = e; sum += e; }
      sum = red16_sum(sum);
      lrow[j] = lrow[j] * alpha + sum;
      mrow[j] = mnew;
#pragma unroll
      for (int nt = 0; nt < 4; nt++) o[nt][j] *= alpha;
    }
#pragma unroll
    for (int nt = 0; nt < 4; nt++)
#pragma unroll
      for (int j = 0; j < 4; j++) Ps[(fq * 4 + j) * 72 + nt * 16 + fr] = f2bf(pj[nt][j]);
    __builtin_amdgcn_fence(__ATOMIC_RELEASE, "wavefront");
    __builtin_amdgcn_wave_barrier();
    __builtin_amdgcn_fence(__ATOMIC_ACQUIRE, "wavefront");
    bf16x8 pf[2];
#pragma unroll
    for (int ks = 0; ks < 2; ks++) pf[ks] = *(const bf16x8*)(Ps + fr * 72 + ks * 32 + fq * 8);
#pragma unroll
    for (int nt = 0; nt < 4; nt++)
#pragma unroll
      for (int ks = 0; ks < 2; ks++) o[nt] = mfma16(pf[ks], vfc[nt][ks], o[nt]);
    __builtin_amdgcn_fence(__ATOMIC_RELEASE, "wavefront");
    __builtin_amdgcn_wave_barrier();
    kc0 = kn0; kc1 = kn1; kc2 = kn2; kc3 = kn3; kc4 = kn4; kc5 = kn5; kc6 = kn6; kc7 = kn7;
  }
#undef LDF
#pragma unroll
  for (int j = 0; j < 4; j++) {
    const size_t row = qrow0 + qloc + fq * 4 + j;
    const float inv = frcp(lrow[j]);
#pragma unroll
    for (int nt = 0; nt < 4; nt++) {
      const int dcol = nt * 16 + fr;
      float g = silu_(bf2f(p.z[row * ZW + Z_NAG + h * 64 + dcol]));
      p.br[row * 1024 + 256 + h * 64 + dcol] = f2bf(o[nt][j] * inv * g);
    }
  }
  __syncthreads();
}

__device__ void gmlp_item(const Params& p, int l, size_t row0, int g, char* smem) {
  const int t = tid_op(), lane = t & 63, wave = t >> 6, fr = lane & 15, fq = lane >> 4;
  bf16_t* Ws = (bf16_t*)smem;
  bf16_t* VhT = Ws + 128 * 136;
  const float* ws = p.gm_ws + (size_t)(l * 4 + g) * 128 * 128;
#pragma unroll
  for (int i = 0; i < 16; i++) {
    int e = (i * NTHR + t) * 4;
    int pr = e >> 7, q = e & 127;
    float4 v = *(const float4*)(ws + e);
    *(uint2*)(Ws + pr * 136 + q) = make_uint2(pack2(v.x, v.y), pack2(v.z, v.w));
  }
  {
    const int q = t >> 1, half = t & 1;
    const bf16_t* zr = p.z + (row0 + q) * ZW + Z_GMV + g * 64 + half * 32;
    float v[32];
#pragma unroll
    for (int i = 0; i < 4; i++) { uint4 u = *(const uint4*)(zr + i * 8); unpack8(u, v + i * 8); }
    float sum = 0.f;
#pragma unroll
    for (int i = 0; i < 32; i++) { v[i] = gelu_(v[i]); sum += v[i]; }
    sum += dppf<0xB1>(sum);
    const float mu = sum * (1.f / 64.f);
    float vs = 0.f;
#pragma unroll
    for (int i = 0; i < 32; i++) { float dd = v[i] - mu; vs += dd * dd; }
    vs += dppf<0xB1>(vs);
    const float rs = rsqrtf(vs * (1.f / 64.f) + 1e-6f);
    const float* lg = p.gm_ln_g + (l * 4 + g) * 64 + half * 32;
    const float* lb = p.gm_ln_b + (l * 4 + g) * 64 + half * 32;
#pragma unroll
    for (int i = 0; i < 32; i++) VhT[(half * 32 + i) * 136 + q] = f2bf((v[i] - mu) * rs * lg[i] + lb[i]);
  }
  __syncthreads();
  f32x4 acc[2][4];
#pragma unroll
  for (int mt = 0; mt < 2; mt++)
#pragma unroll
    for (int nt = 0; nt < 4; nt++) acc[mt][nt] = f32x4{0.f, 0.f, 0.f, 0.f};
#pragma unroll
  for (int ks = 0; ks < 4; ks++) {
    bf16x8 af[2], bfr[4];
#pragma unroll
    for (int mt = 0; mt < 2; mt++) af[mt] = *(const bf16x8*)(Ws + (wave * 32 + mt * 16 + fr) * 136 + ks * 32 + fq * 8);
#pragma unroll
    for (int nt = 0; nt < 4; nt++) bfr[nt] = *(const bf16x8*)(VhT + (nt * 16 + fr) * 136 + ks * 32 + fq * 8);
#pragma unroll
    for (int mt = 0; mt < 2; mt++)
#pragma unroll
      for (int nt = 0; nt < 4; nt++) acc[mt][nt] = mfma16(bfr[nt], af[mt], acc[mt][nt]);
  }
#pragma unroll
  for (int mt = 0; mt < 2; mt++) {
    const int pr = wave * 32 + mt * 16 + fr;
    const float bs = p.gm_bs[(l * 4 + g) * 128 + pr];
    const bf16_t* zr = p.z + (row0 + pr) * ZW;
#pragma unroll
    for (int nt = 0; nt < 4; nt++) {
      const int c = nt * 16 + fq * 4;
      uint2 uu = *(const uint2*)(zr + Z_GMU + g * 64 + c);
      uint2 gg = *(const uint2*)(zr + Z_GMG + g * 64 + c);
      float o0 = gelu_(bflo(uu.x)) * (acc[mt][nt][0] + bs) * silu_(bflo(gg.x));
      float o1 = gelu_(bfhi(uu.x)) * (acc[mt][nt][1] + bs) * silu_(bfhi(gg.x));
      float o2 = gelu_(bflo(uu.y)) * (acc[mt][nt][2] + bs) * silu_(bflo(gg.y));
      float o3 = gelu_(bfhi(uu.y)) * (acc[mt][nt][3] + bs) * silu_(bfhi(gg.y));
      *(uint2*)(p.br + (row0 + pr) * 1024 + g * 64 + c) = make_uint2(pack2(o0, o1), pack2(o2, o3));
    }
  }
  __syncthreads();
}

__device__ void pool_item(const Params& p, int l, size_t seqrow0, int T, int t0, int g, char* smem) {
  const int t = tid_op(), lane = t & 63, wave = t >> 6, fr = lane & 15, fq = lane >> 4;
  float* Pp = (float*)smem;
  bf16_t* Dd = (bf16_t*)(Pp + 80 * 64);
  bf16_t* WT = Dd + 64 * 72;
  const int hw = 1 << g;
  for (int i = t; i < 80 * 8; i += NTHR) {
    int rr = i >> 3, oc = i & 7;
    int tok = t0 - 8 + rr;
    float f[8];
    if (tok >= 0 && tok < T) { uint4 u = *(const uint4*)(p.z + (seqrow0 + tok) * ZW + Z_PLP + g * 64 + oc * 8); unpack8(u, f); }
    else {
#pragma unroll
      for (int k = 0; k < 8; k++) f[k] = 0.f;
    }
#pragma unroll
    for (int k = 0; k < 8; k++) Pp[rr * 64 + oc * 8 + k] = f[k];
  }
  {
    const float* w = p.pl_w + (size_t)(l * 4 + g) * 64 * 64;
#pragma unroll
    for (int i = 0; i < 16; i++) {
      int e = i * NTHR + t;
      int c = e >> 6, dd = e & 63;
      WT[dd * 72 + c] = f2bf(w[e]);
    }
  }
  __syncthreads();
  {
    const int c = t & 63, tq = t >> 6;
    float s = 0.f;
    for (int u = -hw; u < hw; u++) s += Pp[(tq * 16 + u + 8) * 64 + c];
    for (int i = 0; i < 16; i++) {
      const int tl = tq * 16 + i;
      const int tok = t0 + tl;
      const int lo = max(tok - hw, 0), hi = min(tok + hw, T);
      float dv = s * frcp((float)(hi - lo)) - Pp[(tl + 8) * 64 + c];
      Dd[tl * 72 + c] = f2bf(dv);
      s += Pp[(tl + hw + 8) * 64 + c] - Pp[(tl - hw + 8) * 64 + c];
    }
  }
  __syncthreads();
  f32x4 acc[4];
#pragma unroll
  for (int nt = 0; nt < 4; nt++) acc[nt] = f32x4{0.f, 0.f, 0.f, 0.f};
#pragma unroll
  for (int ks = 0; ks < 2; ks++) {
    bf16x8 af = *(const bf16x8*)(Dd + (wave * 16 + fr) * 72 + ks * 32 + fq * 8);
#pragma unroll
    for (int nt = 0; nt < 4; nt++) {
      bf16x8 bw = *(const bf16x8*)(WT + (nt * 16 + fr) * 72 + ks * 32 + fq * 8);
      acc[nt] = mfma16(bw, af, acc[nt]);
    }
  }
  {
    const size_t row = seqrow0 + t0 + wave * 16 + fr;
#pragma unroll
    for (int nt = 0; nt < 4; nt++) {
      const int dd = g * 64 + nt * 16 + fq * 4;
      float4 sc = *(const float4*)(p.pl_scale + l * 256 + dd);
      uint2 gg = *(const uint2*)(p.z + row * ZW + Z_PLG + dd);
      float o0 = acc[nt][0] * sc.x * silu_(bflo(gg.x));
      float o1 = acc[nt][1] * sc.y * silu_(bfhi(gg.x));
      float o2 = acc[nt][2] * sc.z * silu_(bflo(gg.y));
      float o3 = acc[nt][3] * sc.w * silu_(bfhi(gg.y));
      *(uint2*)(p.br + row * 1024 + 768 + dd) = make_uint2(pack2(o0, o1), pack2(o2, o3));
    }
  }
  __syncthreads();
}


constexpr unsigned ROLE_IDLE = 0xFFFF0001u, ROLE_WORK = 0x10000u;
__device__ void publish_cu(const Params& p) {
  if (threadIdx.x == 0 && gridDim.x == 512) {
    unsigned hw = __builtin_amdgcn_s_getreg(63492);
    unsigned xcc = __builtin_amdgcn_s_getreg(63508);
    p.cuinfo[blockIdx.x] = ((xcc & 0xfu) << 16) | (hw & 0xff00u);
  }
}
__device__ void compute_roles(const Params& p, char* smem) {
  const int t = tid_op();
  if (gridDim.x != 512) { if (t == 0) p.cuinfo[1024] = 1u; return; }
  unsigned* keys = (unsigned*)smem;
  unsigned* mate = keys + 512;
  unsigned* prim = mate + 512;
  for (int i = t; i < 512; i += NTHR) keys[i] = p.cuinfo[i];
  __syncthreads();
  int bad = 0;
  for (int i = t; i < 512; i += NTHR) {
    int cnt = 0, m = 0;
    for (int j = 0; j < 512; j++) if (j != i && keys[j] == keys[i]) { cnt++; m = j; }
    if (cnt != 1) bad = 1;
    mate[i] = (unsigned)m;
    prim[i] = (cnt == 1 && i < m) ? 1u : 0u;
  }
  bad = __syncthreads_or(bad);
  for (int i = t; i < 512; i += NTHR) {
    const int pi = prim[i] ? i : (int)mate[i];
    int rank = 0;
    for (int j = 0; j < pi; j++) rank += (int)prim[j];
    unsigned role;
    if (rank < 128) role = prim[i] ? (unsigned)rank : ROLE_IDLE;
    else role = ROLE_WORK + (unsigned)((rank - 128) * 2 + (prim[i] ? 0 : 1));
    p.cuinfo[512 + i] = role;
  }
  if (t == 0) p.cuinfo[1024] = bad ? 1u : 0u;
  __syncthreads();
}

__device__ void worker_barrier(unsigned* cnt, unsigned target) {
  asm volatile("s_waitcnt vmcnt(0)" ::: "memory");
  __syncthreads();
  if (threadIdx.x == 0) {
    __builtin_amdgcn_fence(__ATOMIC_RELEASE, "agent");
    atomicAdd(cnt, 1u);
    while (__hip_atomic_load(cnt, __ATOMIC_RELAXED, __HIP_MEMORY_SCOPE_AGENT) < target) __builtin_amdgcn_s_sleep(2);
    __builtin_amdgcn_fence(__ATOMIC_ACQUIRE, "agent");
    asm volatile("s_waitcnt vmcnt(0)" ::: "memory");
  }
  __syncthreads();
}
__device__ void phase_mix(const Params& p, int l, char* smem, int cslot) {
  __shared__ unsigned s_item;
  if (!(cslot & 4)) for (int it = blockIdx.x; it < 128; it += gridDim.x) scan_item(p, l, it, smem);
  cslot &= 3;
  const int n_na = 2048, n_ca = (l == 0 ? 128 : 0), n_gm = 1024, n_gc = (l == 0 ? 64 : 0), n_pl = 2048, n_pc = (l == 0 ? 128 : 0);
  const int total = n_na + n_ca + n_gm + n_gc + n_pl + n_pc;
  while (true) {
    if (threadIdx.x == 0) s_item = atomicAdd(p.ctr + cslot, 1u);
    __syncthreads();
    int it = (int)s_item;
    __syncthreads();
    if (it >= total) break;
    if (it < n_na) {
      int r = it & 63, h = (it >> 6) & 3, b = it >> 8;
      natten_item<8>(p, l, b, h, (size_t)b * SEQ + r * 64, r, smem);
      continue;
    }
    it -= n_na;
    if (it < n_ca) {
      int qt = it & 3, h = (it >> 2) & 3, b = it >> 4;
      natten_item<0>(p, l, b, h, (size_t)NLAT + b * CTXL + qt * 64, 0, smem);
      continue;
    }
    it -= n_ca;
    if (it < n_gm) {
      int g = it & 3, ch = (it >> 2) & 31, b = it >> 7;
      gmlp_item(p, l, (size_t)b * SEQ + ch * 128, g, smem);
      continue;
    }
    it -= n_gm;
    if (it < n_gc) {
      int g = it & 3, ch = (it >> 2) & 1, b = it >> 3;
      gmlp_item(p, l, (size_t)NLAT + b * CTXL + ch * 128, g, smem);
      continue;
    }
    it -= n_gc;
    if (it < n_pl) {
      int g = it & 3, tl = (it >> 2) & 63, b = it >> 8;
      pool_item(p, l, (size_t)b * SEQ, SEQ, tl * 64, g, smem);
      continue;
    }
    it -= n_pl;
    {
      int g = it & 3, tl = (it >> 2) & 3, b = it >> 4;
      pool_item(p, l, (size_t)NLAT + b * CTXL, CTXL, tl * 64, g, smem);
    }
  }
}

__device__ void phase_rwfin(const Params& p, int l) {
  const int t_ = tid_op();
  const int lane = t_ & 63;
  const int gw = blockIdx.x * 4 + (t_ >> 6), nw = gridDim.x * 4;
  const int nrow = (l == 0 ? NTOK : NLAT);
  const int hh = lane >> 4, c0 = lane * 4;
  float4 gg = *(const float4*)(p.rw_gn_g + l * 256 + c0);
  float4 gb = *(const float4*)(p.rw_gn_b + l * 256 + c0);
  for (int r = gw; r < nrow; r += nw) {
    const uint2 y0 = *(const uint2*)((const bf16_t*)p.yscan + (size_t)r * 256 + c0);
    const uint2 y1 = *(const uint2*)((const bf16_t*)p.yscan + ((size_t)NTOK + r) * 256 + c0);
    float o0 = bflo(y0.x) + bflo(y1.x), o1 = bfhi(y0.x) + bfhi(y1.x), o2 = bflo(y0.y) + bflo(y1.y), o3 = bfhi(y0.y) + bfhi(y1.y);
    float mu = red16_sum(o0 + o1 + o2 + o3) * (1.f / 64.f);
    float d0 = o0 - mu, d1 = o1 - mu, d2 = o2 - mu, d3 = o3 - mu;
    float var = red16_sum(d0 * d0 + d1 * d1 + d2 * d2 + d3 * d3) * (1.f / 64.f);
    float rs = rsqrtf(var + 64e-5f);
    float cf = p.coef[(size_t)r * 4 + hh] + p.coef[((size_t)NTOK + r) * 4 + hh];
    uint2 vm = *(const uint2*)(p.vmix + (size_t)r * 256 + c0);
    uint2 zg = *(const uint2*)(p.z + (size_t)r * ZW + Z_RWG + c0);
    float r0 = (d0 * rs * gg.x + gb.x + cf * bflo(vm.x)) * silu_(bflo(zg.x));
    float r1 = (d1 * rs * gg.y + gb.y + cf * bfhi(vm.x)) * silu_(bfhi(zg.x));
    float r2 = (d2 * rs * gg.z + gb.z + cf * bflo(vm.y)) * silu_(bflo(zg.y));
    float r3 = (d3 * rs * gg.w + gb.w + cf * bfhi(vm.y)) * silu_(bfhi(zg.y));
    *(uint2*)(p.br + (size_t)r * 1024 + 512 + c0) = make_uint2(pack2(r0, r1), pack2(r2, r3));
  }
}

__device__ __forceinline__ void gsync(cg::grid_group& grid) {
  asm volatile("s_waitcnt vmcnt(0)" ::: "memory");
  grid.sync();
}

#define XB_XCNT(j) (64 * (j))
#define XB_XSUB(j) (1024 + 64 * (j))
#define XB_XGEN(j) (2048 + 64 * (j))
#define XB_TOP 3072
#define XB_TOPGEN 3136
constexpr int XB_WORDS = 3200;
__device__ __forceinline__ unsigned xb_ld(unsigned* q) { return __hip_atomic_load(q, __ATOMIC_RELAXED, __HIP_MEMORY_SCOPE_AGENT); }
__device__ __forceinline__ unsigned xb_add(unsigned* q, unsigned v) { return __hip_atomic_fetch_add(q, v, __ATOMIC_RELAXED, __HIP_MEMORY_SCOPE_AGENT); }
#define XB_SPIN(cond) do { unsigned _sp = 0; while (cond) { __builtin_amdgcn_s_sleep(1); if (++_sp > (1u << 24)) break; } } while (0)
__device__ __forceinline__ void xsync(unsigned* bar, volatile unsigned* st) {
  asm volatile("s_waitcnt vmcnt(0)" ::: "memory");
  __syncthreads();
  if (threadIdx.x == 0) {
    __builtin_amdgcn_s_waitcnt(0);
    const unsigned nloc = st[0], nx = st[1], x = st[2];
    const unsigned old = xb_add(&bar[XB_XSUB(x)], 1u);
    const unsigned gen = old / nloc;
    if (old + 1u == (gen + 1u) * nloc) {
      __builtin_amdgcn_fence(__ATOMIC_RELEASE, "agent");
      asm volatile("s_waitcnt vmcnt(0)" ::: "memory");
      const unsigned og = xb_add(&bar[XB_TOP], 1u);
      const unsigned tg = og / nx;
      if (og + 1u == (tg + 1u) * nx) xb_add(&bar[XB_TOPGEN], 1u);
      else XB_SPIN(xb_ld(&bar[XB_TOPGEN]) == tg);
      __builtin_amdgcn_fence(__ATOMIC_ACQUIRE, "agent");
      xb_add(&bar[XB_XGEN(x)], 1u);
      asm volatile("s_waitcnt vmcnt(0)" ::: "memory");
    } else {
      XB_SPIN(xb_ld(&bar[XB_XGEN(x)]) == gen);
      __builtin_amdgcn_fence(__ATOMIC_ACQUIRE, "agent");
      asm volatile("s_waitcnt vmcnt(0)" ::: "memory");
    }
  }
  __syncthreads();
}
__global__ void __launch_bounds__(NTHR, 2) hybrid_mega(Params p) {
  extern __shared__ __attribute__((aligned(16))) char smem[];
  cg::grid_group grid = cg::this_grid();
  __shared__ unsigned xb_st[4];
  const unsigned my_xcc = (unsigned)__builtin_amdgcn_s_getreg((3 << 11) | 20) & 0xFu;
  if (threadIdx.x == 0) (void)xb_add(&p.xbar[XB_XCNT(my_xcc)], 1u);
  publish_cu(p);
  phase0(p, smem);
  if (p.xbar == nullptr) gsync(grid);
  if (threadIdx.x == 0) {
    unsigned mine = 0, cnt = 0, sum = 0, sp = 0;
    for (;;) {
      mine = 0; cnt = 0; sum = 0;
      for (unsigned j = 0; j < 16; j++) { const unsigned c = xb_ld(&p.xbar[XB_XCNT(j)]); sum += c; cnt += c > 0u ? 1u : 0u; mine = j == my_xcc ? c : mine; }
      if (sum == gridDim.x || ++sp > (1u << 22)) break;
      __builtin_amdgcn_s_sleep(1);
    }
    xb_st[0] = mine > 0u ? mine : 1u; xb_st[1] = cnt > 0u ? cnt : 1u; xb_st[2] = my_xcc;
  }
  __syncthreads();
  xsync(p.xbar, xb_st);
  if (blockIdx.x == 0) compute_roles(p, smem);
#pragma unroll 1
  for (int l = 0; l < 2; l++) {
    phase_norm(p, l, l == 0 ? p.x : p.out, l == 0 ? p.ctx : p.ctx1);
    xsync(p.xbar, xb_st);
    const bool overlap = (gridDim.x == 512) && (p.cuinfo[1024] == 0u);
    phase_g1(p, l, smem, overlap ? 1 : 0, -1, 0);
    xsync(p.xbar, xb_st);
    {
      if (overlap) {
        const unsigned role = p.cuinfo[512 + blockIdx.x];
        if (role < 128u) scan_item(p, l, (int)role, smem);
        else if (role >= ROLE_WORK && role < ROLE_WORK + 256u) {
          phase_g1(p, l, smem, 2, (int)(role - ROLE_WORK), 256);
          worker_barrier(p.ctr + 4 + l, 256u);
          phase_mix(p, l, smem, l | 4);
        }
      } else {
        for (int it = blockIdx.x; it < 128; it += gridDim.x) scan_item(p, l, it, smem);
      }
      xsync(p.xbar, xb_st);
      if (!overlap) phase_mix(p, l, smem, l | 4);
      phase_rwfin(p, l);
      xsync(p.xbar, xb_st);
    }
    phase_g2(p, l, smem);
    xsync(p.xbar, xb_st);
    if (DUP_MASK & 2) { phase_g2(p, l, smem); xsync(p.xbar, xb_st); }
    phase_g3(p, l, smem);
    xsync(p.xbar, xb_st);
    if ((DUP_MASK & 8) && l == 0) { phase_g3(p, l, smem); xsync(p.xbar, xb_st); }
  }
  phase_final(p);
}

extern "C" void kernel_launch(void* const* d_in, const int* in_sizes, int n_in, void* d_out, int out_size, void* d_ws,
                              size_t ws_size, hipStream_t stream) {
  static int grid_blocks = 0;
  if (!grid_blocks) {
    int dev = 0, cus = 0, per_cu = 0;
    hipGetDevice(&dev);
    hipDeviceGetAttribute(&cus, hipDeviceAttributeMultiprocessorCount, dev);
    hipFuncSetAttribute((const void*)hybrid_mega, hipFuncAttributeMaxDynamicSharedMemorySize, LDS_BYTES);
    hipOccupancyMaxActiveBlocksPerMultiprocessor(&per_cu, hybrid_mega, NTHR, LDS_BYTES);
    if (per_cu > 2) per_cu = 2;
    if (per_cu < 1) per_cu = 1;
    grid_blocks = cus * per_cu;
  }
  Params p{};
  const float* const* in = (const float* const*)d_in;
  p.x = in[0]; p.c = in[1]; p.ctx = in[2]; p.c_ctx = in[3]; p.ada_w = in[4]; p.ada_b = in[5]; p.norm_g = in[6]; p.w_in = in[7];
  p.gm_ln_g = in[8]; p.gm_ln_b = in[9]; p.gm_ws = in[10]; p.gm_bs = in[11]; p.na_rpb = in[12]; p.rw_mu = in[13]; p.rw_w0 = in[14];
  p.rw_w2 = in[15]; p.rw_a0 = in[16]; p.rw_a2 = in[17]; p.rw_kk = in[18]; p.rw_ka = in[19]; p.rw_rk = in[20]; p.rw_gn_g = in[21];
  p.rw_gn_b = in[22]; p.pl_w = in[23]; p.pl_scale = in[24]; p.w_br = in[25]; p.w_out = in[26]; p.final_g = in[27];
  p.out = (float*)d_out;
  char* w = (char*)d_ws;
  size_t off = 0;
  auto take = [&](size_t bytes) { char* r = w + off; off += (bytes + 255) & ~(size_t)255; return r; };
  p.ctr = (unsigned*)take(256);
  p.cuinfo = (unsigned*)take(8192);
  p.xbar = (unsigned*)take(XB_WORDS * 4);
  p.mod = (float*)take((size_t)2 * 9 * 3072 * 4);
  p.WtIn = (bf16_t*)take((size_t)2 * INC * 1024 * 2);
  p.WtBr = (bf16_t*)take((size_t)2 * 4 * 1024 * 256 * 2);
  p.WtOut = (bf16_t*)take((size_t)2 * 1024 * 1024 * 2);
  p.h = (bf16_t*)take((size_t)NTOK * 1024 * 2);
  p.z = (bf16_t*)take((size_t)NTOK * ZW * 2);
  p.zvT = (bf16_t*)take((size_t)NB * 256 * SEQ * 2);
  p.zvTc = (bf16_t*)take((size_t)NB * 256 * CTXL * 2);
  p.br = (bf16_t*)take((size_t)NTOK * 1024 * 2);
  p.yscan = (float*)take((size_t)2 * NTOK * 256 * 4);
  p.vmix = (bf16_t*)take((size_t)NTOK * 256 * 2);
  p.coef = (float*)take((size_t)2 * NTOK * 4 * 4);
  p.ctx1 = (float*)take((size_t)NCTX * 1024 * 4);
  if (off > ws_size) fprintf(stderr, "workspace too small: need %zu have %zu\n", off, ws_size);
  hipMemsetAsync(p.xbar, 0, XB_WORDS * 4, stream);
  void* args[] = {&p};
  hipError_t e = hipLaunchCooperativeKernel((const void*)hybrid_mega, dim3(grid_blocks), dim3(NTHR), args, LDS_BYTES, stream);
  if (e != hipSuccess) fprintf(stderr, "cooperative launch failed: %s (grid %d)\n", hipGetErrorString(e), grid_blocks);
}
```
